# Optimizing an MI355X kernel written in HIP

```python
import math
import jax, jax.numpy as jnp
from jax import lax
import numpy as np

D_MODEL = 2048
BATCH = 2
SEQ = 4096
DEPTH = 4

HEAD_DIM = 64
RWKV_HEADS = 12
ATTN_HEADS = 12
GMLP_GROUPS = 8
RWKV_WIDTH = RWKV_HEADS * HEAD_DIM
ATTN_WIDTH = ATTN_HEADS * HEAD_DIM
GMLP_WIDTH = GMLP_GROUPS * HEAD_DIM
MIX_WIDTH = RWKV_WIDTH + ATTN_WIDTH + GMLP_WIDTH
DECAY_LORA = 64
AICL_LORA = 64
GATE_LORA = 128
RWKV_COLS = 3 * RWKV_WIDTH + DECAY_LORA + AICL_LORA + GATE_LORA
ATTN_COLS = 3 * ATTN_WIDTH
GMLP_COLS = 2 * GMLP_WIDTH
IN_COLS = RWKV_COLS + ATTN_COLS + GMLP_COLS
DIL_PAIRS = ((128, 1), (512, 4), (2048, 16))
Q_BLOCK = 128
ROPE_THETA = 500000.0
ROT_DIM = HEAD_DIM // 4
GMLP_CHUNK = 128
D_FF = 5632
CONV_WIDTH = 3
NORM_EPS = 1e-6
GN_EPS = 1e-5
RWKV_LN_EPS = 64e-5
DECAY_SCALE = math.exp(-0.5)
NEG_INF = -1e30

kernel_name = "hybrid_rwkv7_dilated_attn_gmlp_trunk"


def rms_norm(x, g):
    xf = x.astype(jnp.float32)
    y = xf * lax.rsqrt(jnp.mean(xf * xf, axis=-1, keepdims=True) + NORM_EPS)
    return (y * g.astype(jnp.float32)).astype(x.dtype)


def group_norm(x, g, b, eps):
    xf = x.astype(jnp.float32)
    mu = jnp.mean(xf, axis=-1, keepdims=True)
    var = jnp.mean(jnp.square(xf - mu), axis=-1, keepdims=True)
    y = ((xf - mu) * lax.rsqrt(var + eps)).reshape(*x.shape[:-2], -1)
    return y * g.astype(jnp.float32) + b.astype(jnp.float32)


def token_shift(p, mu):
    prev = jnp.pad(p, ((0, 0), (1, 0), (0, 0)))[:, :-1]
    return p + (prev - p) * mu


def rope_partial(x, positions):
    half = ROT_DIM // 2
    inv = ROPE_THETA ** (-jnp.arange(0, ROT_DIM, 2, dtype=jnp.float32) / ROT_DIM)
    ang = positions.astype(jnp.float32)[..., None] * inv
    cos = jnp.cos(ang)[:, :, None, :]
    sin = jnp.sin(ang)[:, :, None, :]
    x1 = x[..., :half].astype(jnp.float32)
    x2 = x[..., half:ROT_DIM].astype(jnp.float32)
    rot = jnp.concatenate([x1 * cos - x2 * sin, x2 * cos + x1 * sin], axis=-1)
    return jnp.concatenate([rot.astype(x.dtype), x[..., ROT_DIM:]], axis=-1)


def rwkv7_mix(p, mu, w0, w2, a0, a2, g2, k_k, k_a, r_k, ln_g, ln_b):
    B, S, _ = p.shape
    H, N = RWKV_HEADS, HEAD_DIM
    f32 = jnp.float32
    p = token_shift(p, mu)
    cuts = [RWKV_WIDTH, 2 * RWKV_WIDTH, 3 * RWKV_WIDTH, 3 * RWKV_WIDTH + DECAY_LORA,
            3 * RWKV_WIDTH + DECAY_LORA + AICL_LORA]
    r, k, v, w_lo, a_lo, g_lo = jnp.split(p, cuts, axis=-1)
    decay = jnp.exp(-DECAY_SCALE * jax.nn.sigmoid((w0 + jnp.tanh(w_lo) @ w2).astype(f32)))
    a = jax.nn.sigmoid((a0 + a_lo @ a2).astype(f32))
    g = jax.nn.sigmoid(g_lo) @ g2
    kk = (k * k_k).reshape(B, S, H, N).astype(f32)
    kk = kk / jnp.maximum(jnp.sqrt(jnp.sum(kk * kk, axis=-1, keepdims=True)), 1e-12)
    k = k.astype(f32) * (1.0 + (a - 1.0) * k_a.astype(f32))
    heads = lambda t: t.reshape(B, S, H, N).astype(f32)
    r_h, w_h, k_h, v_h, a_h = heads(r), heads(decay), heads(k), heads(v), heads(a)

    def step(state, inp):
        r_t, w_t, k_t, v_t, kk_t, a_t = inp
        sk = jnp.einsum('bhvk,bhk->bhv', state, kk_t)
        state = (state * w_t[:, :, None, :]
                 - sk[..., None] * (kk_t * a_t)[:, :, None, :]
                 + v_t[..., None] * k_t[:, :, None, :])
        return state, jnp.einsum('bhvk,bhk->bhv', state, r_t)

    seq_first = lambda t: jnp.moveaxis(t, 1, 0)
    s0 = jnp.zeros((B, H, N, N), f32)
    _, y = lax.scan(step, s0, tuple(seq_first(t) for t in (r_h, w_h, k_h, v_h, kk, a_h)))
    y = jnp.moveaxis(y, 0, 1)
    y = group_norm(y, ln_g, ln_b, RWKV_LN_EPS)
    bonus = jnp.sum(r_h * k_h * r_k.astype(f32), axis=-1, keepdims=True) * v_h
    y = y + bonus.reshape(B, S, H * N)
    return (y * g.astype(f32)).astype(p.dtype)


def dilated_attention(qkv, positions, norm_g):
    B, S, _ = qkv.shape
    H, hd = ATTN_HEADS, HEAD_DIM
    f32 = jnp.float32
    q, k, v = [t.reshape(B, S, H, hd) for t in jnp.split(qkv, 3, axis=-1)]
    q = rope_partial(q, positions)
    k = rope_partial(k, positions)
    scale = HEAD_DIM ** -0.5
    n_blocks = S // Q_BLOCK

    def block(bi):
        start = bi * Q_BLOCK
        t = start + jnp.arange(Q_BLOCK)
        q_b = lax.dynamic_slice_in_dim(q, start, Q_BLOCK, axis=1).astype(f32)
        outs, lses = [], []
        for win, dil in DIL_PAIRS:
            offs = dil * jnp.arange(win // dil + 1)
            idx = t[:, None] - offs[None, :]
            valid = idx >= 0
            idx = jnp.maximum(idx, 0)
            k_g = k[:, idx].astype(f32)
            v_g = v[:, idx].astype(f32)
            s = jnp.einsum('bqhd,bqkhd->bhqk', q_b, k_g) * scale
            s = jnp.where(valid[None, None], s, NEG_INF)
            m = jnp.max(s, axis=-1, keepdims=True)
            pr = jnp.exp(s - m)
            l = jnp.sum(pr, axis=-1, keepdims=True)
            outs.append(jnp.einsum('bhqk,bqkhd->bhqd', pr, v_g) / l)
            lses.append(m + jnp.log(l))
        wts = jax.nn.softmax(jnp.stack(lses), axis=0)
        out = jnp.sum(wts * jnp.stack(outs), axis=0)
        return jnp.swapaxes(out, 1, 2).astype(qkv.dtype)

    o = lax.map(block, jnp.arange(n_blocks))
    o = jnp.moveaxis(o, 0, 1).reshape(B, S, H * hd)
    return rms_norm(o, norm_g)


def chunked_sgu(uv, ln_g, ln_b, ws, bs, norm_g):
    B, S, _ = uv.shape
    G, N, C = GMLP_GROUPS, GMLP_WIDTH // GMLP_GROUPS, GMLP_CHUNK
    z = jax.nn.gelu(uv)
    u, v = jnp.split(z, 2, axis=-1)
    v = group_norm(v.reshape(B, S, G, N), ln_g, ln_b, GN_EPS).astype(uv.dtype)
    v = v.reshape(B, S // C, C, G, N)
    w = jnp.where(jnp.tril(jnp.ones((C, C), dtype=bool))[None], ws, 0.0)
    v = jnp.einsum('gij,bcjgn->bcign', w, v) + bs.T[None, None, :, :, None]
    return rms_norm(u * v.reshape(B, S, GMLP_WIDTH), norm_g)


def conv_ffn(h, w_up, conv_w, conv_b, w_down):
    S = h.shape[1]
    up = h @ w_up
    padded = jnp.pad(up, ((0, 0), (CONV_WIDTH - 1, 0), (0, 0)))
    conv = conv_b + padded[:, 0:S] * conv_w[0]
    for j in range(1, CONV_WIDTH):
        conv = conv + padded[:, j:j + S] * conv_w[j]
    gate, val = jnp.split(conv, 2, axis=-1)
    return (jax.nn.gelu(gate, approximate=True) * val) @ w_down


def setup_inputs(seed: int = 0) -> dict:
    key = jax.random.key(seed)
    keys = jax.random.split(key, 32)
    counter = [0]

    def nxt():
        kk = keys[counter[0]]
        counter[0] += 1
        return kk

    f32 = jnp.float32
    nrm = lambda shape, scale: scale * jax.random.normal(nxt(), shape, f32)
    gain = lambda shape: 1.0 + nrm(shape, 0.05)
    L, D = DEPTH, D_MODEL
    return {
        "x": jax.random.normal(nxt(), (BATCH, SEQ, D), f32),
        "positions": jnp.broadcast_to(jnp.arange(SEQ, dtype=jnp.int32), (BATCH, SEQ)),
        "norm_mix_pre": gain((L, D)),
        "norm_mix_post": gain((L, D)),
        "norm_ffn_pre": gain((L, D)),
        "norm_ffn_post": gain((L, D)),
        "w_in": nrm((L, D, IN_COLS), D ** -0.5),
        "rwkv_mu": jax.random.uniform(nxt(), (L, RWKV_COLS), f32),
        "rwkv_w0": nrm((L, RWKV_WIDTH), 1.0),
        "rwkv_w2": nrm((L, DECAY_LORA, RWKV_WIDTH), DECAY_LORA ** -0.5),
        "rwkv_a0": nrm((L, RWKV_WIDTH), 0.5),
        "rwkv_a2": nrm((L, AICL_LORA, RWKV_WIDTH), AICL_LORA ** -0.5),
        "rwkv_g2": nrm((L, GATE_LORA, RWKV_WIDTH), GATE_LORA ** -0.5),
        "rwkv_k_k": 0.85 + nrm((L, RWKV_WIDTH), 0.05),
        "rwkv_k_a": gain((L, RWKV_WIDTH)),
        "rwkv_r_k": nrm((L, RWKV_HEADS, HEAD_DIM), 0.1),
        "rwkv_ln_g": gain((L, RWKV_WIDTH)),
        "rwkv_ln_b": nrm((L, RWKV_WIDTH), 0.02),
        "attn_norm_g": gain((L, ATTN_WIDTH)),
        "gmlp_ln_g": gain((L, GMLP_WIDTH)),
        "gmlp_ln_b": nrm((L, GMLP_WIDTH), 0.02),
        "gmlp_ws": nrm((L, GMLP_GROUPS, GMLP_CHUNK, GMLP_CHUNK), GMLP_CHUNK ** -0.5),
        "gmlp_bs": 1.0 + nrm((L, GMLP_GROUPS, GMLP_CHUNK), 0.1),
        "gmlp_norm_g": gain((L, GMLP_WIDTH)),
        "w_out": nrm((L, MIX_WIDTH, D), MIX_WIDTH ** -0.5),
        "ffn_up": nrm((L, D, 2 * D_FF), D ** -0.5),
        "ffn_conv_w": nrm((L, CONV_WIDTH, 2 * D_FF), CONV_WIDTH ** -0.5),
        "ffn_conv_b": nrm((L, 2 * D_FF), 0.02),
        "ffn_down": nrm((L, D_FF, D), D_FF ** -0.5),
    }


def reference(x, positions, norm_mix_pre, norm_mix_post, norm_ffn_pre, norm_ffn_post,
              w_in, rwkv_mu, rwkv_w0, rwkv_w2, rwkv_a0, rwkv_a2, rwkv_g2, rwkv_k_k,
              rwkv_k_a, rwkv_r_k, rwkv_ln_g, rwkv_ln_b, attn_norm_g, gmlp_ln_g, gmlp_ln_b,
              gmlp_ws, gmlp_bs, gmlp_norm_g, w_out, ffn_up, ffn_conv_w, ffn_conv_b, ffn_down):
    for l in range(DEPTH):
        hn = rms_norm(x, norm_mix_pre[l])
        proj = hn @ w_in[l]
        p_rwkv, p_attn, p_gmlp = jnp.split(proj, [RWKV_COLS, RWKV_COLS + ATTN_COLS], axis=-1)
        y_a = rwkv7_mix(p_rwkv, rwkv_mu[l], rwkv_w0[l], rwkv_w2[l], rwkv_a0[l], rwkv_a2[l],
                        rwkv_g2[l], rwkv_k_k[l], rwkv_k_a[l], rwkv_r_k[l],
                        rwkv_ln_g[l], rwkv_ln_b[l])
        y_b = dilated_attention(p_attn, positions, attn_norm_g[l])
        y_c = chunked_sgu(p_gmlp, gmlp_ln_g[l], gmlp_ln_b[l], gmlp_ws[l], gmlp_bs[l],
                          gmlp_norm_g[l])
        y = jnp.concatenate([y_a.astype(x.dtype), y_b.astype(x.dtype), y_c.astype(x.dtype)],
                            axis=-1)
        x = x + rms_norm(y @ w_out[l], norm_mix_post[l])
        hn = rms_norm(x, norm_ffn_pre[l])
        x = x + rms_norm(conv_ffn(hn, ffn_up[l], ffn_conv_w[l], ffn_conv_b[l], ffn_down[l]),
                         norm_ffn_post[l])
    return x
```

```cpp
#include <hip/hip_runtime.h>
#include <cstdio>
#include <cstdint>
namespace pg8 {
#define PG8_LAS __attribute__((address_space(3)))
#define PG8_GAS __attribute__((address_space(1)))
typedef unsigned short bf16_t;
typedef short bf16x8 __attribute__((ext_vector_type(8)));
typedef float f32x4 __attribute__((ext_vector_type(4)));
typedef unsigned u32x4 __attribute__((ext_vector_type(4)));
constexpr int BM = 256, BK = 64, HALF = 128, HTB = HALF * BK * 2  , STAGE_BYTES = 8 * HTB, NXCD = 8, WGM = 8;

__host__ __device__ __forceinline__ int lds_byte(int r, int c) { const int st = (r >> 4) * 2 + (c >> 5), rr = r & 15, cc = c & 31, ob = rr * 64 + cc * 2; return st * 1024 + (ob ^ (((ob >> 9) & 1) << 5)); }
__host__ __device__ __forceinline__ void stage_rc(int b, int& R, int& C) { const int st = b / 1024, sb = b % 1024, swz = sb ^ (((sb >> 9) & 1) << 5); R = (st >> 1) * 16 + swz / 64; C = (st & 1) * 32 + (swz % 64) / 2; }
__host__ __device__ __forceinline__ int perm32(int rho) { const int n = rho >> 4, i = rho & 15; return 8 * (i >> 2) + 4 * n + (i & 3); }

struct Unit { int pm, pn; };
struct Gemm { const PG8_GAS bf16_t* A; const PG8_GAS bf16_t* Bt; int M, N, K; };

struct StaticOrder {
    int nM, nN, nwg, G, c;
    __host__ __device__ void init(int M, int N, int G_, int c_) { nM = M / BM; nN = N / BM; nwg = nM * nN; G = G_; c = c_; }
    __host__ __device__ bool next(int i, Unit& u) const {
        const long L = (long)i * G + c; if (L >= nwg) return false;
        int wgid = (int)L; { const int q = nwg / NXCD, r = nwg % NXCD, xcd = wgid % NXCD, off = wgid / NXCD; wgid = (xcd < r ? xcd * (q + 1) : r * (q + 1) + (xcd - r) * q) + off; }
        const int nig = WGM * nN, gid = wgid / nig, fm = gid * WGM, gsz = (nM - fm) < WGM ? (nM - fm) : WGM;
        u.pm = fm + ((wgid % nig) % gsz); u.pn = (wgid % nig) / gsz; return true;
    }
    __device__ __forceinline__ void a_ready(const Unit&) const {}
    __device__ __forceinline__ void done(const Unit&) const {}
};

__device__ __forceinline__ unsigned cvt_pk_bf16(float lo, float hi) { unsigned r; asm volatile("v_cvt_pk_bf16_f32 %0, %1, %2" : "=v"(r) : "v"(lo), "v"(hi)); return r; }
typedef float f32x2 __attribute__((ext_vector_type(2)));
__device__ __forceinline__ f32x2 gelu_pk(f32x2 v) {
    const f32x2 av = __builtin_elementwise_abs(v), d = av * 0.2316418882f + 1.0f;
    f32x2 t; t.x = __builtin_amdgcn_rcpf(d.x); t.y = __builtin_amdgcn_rcpf(d.y);
    f32x2 q = t * 0.5307027145f + (-0.7265760135f); q = q * t + 0.7107068705f; q = q * t + (-0.142248368f); q = q * t + 0.127414796f; q = q * t;
    const f32x2 s = (v * v) * (-0.72134752044f);
    f32x2 e; e.x = __builtin_amdgcn_exp2f(s.x); e.y = __builtin_amdgcn_exp2f(s.y);
    const f32x2 m = v * (q * e), r = v - m;
    f32x2 o; o.x = v.x < 0.f ? m.x : r.x; o.y = v.y < 0.f ? m.y : r.y; return o;
}

template <int ACT  > struct EpiBf16 {
    static constexpr bool PERM = true, AFTER_DRAIN = false; static_assert(ACT == 0 || ACT == 1, "EpiBf16: ACT is 0 (none) or 1 (gelu_pk)");
    PG8_GAS bf16_t* O; int ldc; const PG8_GAS float* bias; int split_cols; size_t split_stride; float scale0;
    __device__ __forceinline__ void operator()(const f32x4 (&acc)[2][2][4][2], const Unit& u, int wr, int wc, int fr, int fq) const {
        const int row0 = u.pm * BM + wr * 64 + fr; int colt = u.pn * BM; PG8_GAS bf16_t* base = O;
        float sc = 1.f; if (split_cols) { const int t = colt / split_cols; base += (size_t)t * split_stride; colt -= t * split_cols; if (t == 0) sc = scale0; }
        const int col0 = colt + wc * 32 + 8 * fq, bcol0 = u.pn * BM + wc * 32 + 8 * fq;
        f32x4 bv[2][2];
#pragma unroll
        for (int bj = 0; bj < 2; ++bj)
#pragma unroll
            for (int n = 0; n < 2; ++n) bv[bj][n] = bias ? *(const PG8_GAS f32x4*)(bias + bcol0 + bj * HALF + 4 * n) : (f32x4){0.f, 0.f, 0.f, 0.f};
#pragma unroll
        for (int ai = 0; ai < 2; ++ai)
#pragma unroll
            for (int m = 0; m < 4; ++m) { PG8_GAS bf16_t* rowp = base + (size_t)(row0 + ai * HALF + m * 16) * ldc + col0;
#pragma unroll
                for (int bj = 0; bj < 2; ++bj) { f32x4 v0 = acc[ai][bj][m][0] + bv[bj][0], v1 = acc[ai][bj][m][1] + bv[bj][1];
                    if (ACT == 1) { f32x2 a = gelu_pk((f32x2){v0[0], v0[1]}), b = gelu_pk((f32x2){v0[2], v0[3]}), c = gelu_pk((f32x2){v1[0], v1[1]}), d = gelu_pk((f32x2){v1[2], v1[3]});
                        v0 = (f32x4){a.x, a.y, b.x, b.y}; v1 = (f32x4){c.x, c.y, d.x, d.y}; }
                    v0 = v0 * sc; v1 = v1 * sc; u32x4 w; w.x = cvt_pk_bf16(v0[0], v0[1]); w.y = cvt_pk_bf16(v0[2], v0[3]); w.z = cvt_pk_bf16(v1[0], v1[1]); w.w = cvt_pk_bf16(v1[2], v1[3]);
                    *(PG8_GAS u32x4*)(rowp + bj * HALF) = w; } }
    }
};
struct EpiF32 {
    static constexpr bool PERM = true, AFTER_DRAIN = false;
    PG8_GAS float* O; int ldc;
    __device__ __forceinline__ void operator()(const f32x4 (&acc)[2][2][4][2], const Unit& u, int wr, int wc, int fr, int fq) const {
        const int row0 = u.pm * BM + wr * 64 + fr, col0 = u.pn * BM + wc * 32 + 8 * fq;
#pragma unroll
        for (int ai = 0; ai < 2; ++ai)
#pragma unroll
            for (int m = 0; m < 4; ++m) { PG8_GAS float* rowp = O + (size_t)(row0 + ai * HALF + m * 16) * ldc + col0;
#pragma unroll
                for (int bj = 0; bj < 2; ++bj) { *(PG8_GAS f32x4*)(rowp + bj * HALF) = acc[ai][bj][m][0]; *(PG8_GAS f32x4*)(rowp + bj * HALF + 4) = acc[ai][bj][m][1]; } }
    }
};

template <class Epi, class Sched, bool ALIGN_EPI = false, bool SP2 = false>
__device__ __forceinline__ void gemm_phase(PG8_LAS unsigned char* lds, const Gemm g, const Sched& S, const Epi& E, const int tid) {
    const int wid = __builtin_amdgcn_readfirstlane(tid >> 6), lane = tid & 63, wr = wid >> 2, wc = wid & 3, fr = lane & 15, fq = lane >> 4;
    const int K = g.K, nt = K / BK;
    unsigned voffA[2], voffB[2];
#pragma unroll
    for (int i = 0; i < 2; ++i) { int R, C; stage_rc(tid * 16 + i * 8192, R, C); const int Rb = Epi::PERM ? ((R & ~31) + perm32(R & 31)) : R;
        voffA[i] = (unsigned)(R * K + C) * 2u; voffB[i] = (unsigned)(Rb * K + C) * 2u; }
    const size_t kstep = (size_t)(BK * 2);
    const size_t hstep = (size_t)HALF * K * 2;
    const size_t tstep = 2 * hstep;
    const unsigned ldsw = (unsigned)wid * 1024u;
    const int aoff = lds_byte(wr * 64 + fr, fq * 8), boff = lds_byte(wc * 32 + fr, fq * 8);
#define PG8_SA(b, h) (((b) * 2 + (h)) * HTB)
#define PG8_SB(b, h) ((4 + (b) * 2 + (h)) * HTB)
#define PG8_STAGE(bufoff, gbase, voff) do { _Pragma("unroll") for (int _i = 0; _i < 2; ++_i) \
        __builtin_amdgcn_global_load_lds((const PG8_GAS unsigned*)((const PG8_GAS char*)(gbase) + (voff)[_i]), (PG8_LAS unsigned*)(lds + (bufoff) + ldsw + _i * 8192), 16, 0, 0); } while (0)
#define PG8_LDA(dst, b, h) do { _Pragma("unroll") for (int m = 0; m < 4; ++m) _Pragma("unroll") for (int k = 0; k < 2; ++k) dst[m][k] = *(const PG8_LAS bf16x8*)(lds + PG8_SA(b, h) + aoff + m * 2048 + k * 1024); } while (0)
#define PG8_LDB(dst, b, h) do { _Pragma("unroll") for (int n = 0; n < 2; ++n) _Pragma("unroll") for (int k = 0; k < 2; ++k) dst[n][k] = *(const PG8_LAS bf16x8*)(lds + PG8_SB(b, h) + boff + n * 2048 + k * 1024); } while (0)
#define PG8_MMA(ai, bj, At, Bt) do { __builtin_amdgcn_s_setprio(1); _Pragma("unroll") for (int m = 0; m < 4; ++m) _Pragma("unroll") for (int n = 0; n < 2; ++n) _Pragma("unroll") for (int k = 0; k < 2; ++k) \
        acc[ai][bj][m][n] = __builtin_amdgcn_mfma_f32_16x16x32_bf16(Bt[n][k], At[m][k], acc[ai][bj][m][n], 0, 0, 0); __builtin_amdgcn_s_setprio(0); } while (0)
#define PG8_WAIT_V(n) asm volatile("s_waitcnt vmcnt(" #n ")" ::: "memory")
#define PG8_WAIT_L(n) asm volatile("s_waitcnt lgkmcnt(" #n ")" ::: "memory")
#define PG8_BAR __builtin_amdgcn_s_barrier()
#define PG8_SCHED __builtin_amdgcn_sched_barrier(0)
    Unit cur, nxt; int ui = 0;
    if (!S.next(0, cur)) return;
    f32x4 acc[2][2][4][2];
#pragma unroll
    for (int a = 0; a < 2; ++a)
#pragma unroll
        for (int b = 0; b < 2; ++b)
#pragma unroll
            for (int m = 0; m < 4; ++m)
#pragma unroll
                for (int n = 0; n < 2; ++n) acc[a][b][m][n] = (f32x4){0.f, 0.f, 0.f, 0.f};
    bf16x8 At[4][2], B0[2][2], B1[2][2];
    const PG8_GAS char* cA = (const PG8_GAS char*)g.A + (size_t)cur.pm * tstep; const PG8_GAS char* cB = (const PG8_GAS char*)g.Bt + (size_t)cur.pn * tstep;
    S.a_ready(cur);
    if constexpr (SP2) {
        PG8_STAGE(PG8_SB(0, 0), cB, voffB); PG8_STAGE(PG8_SB(0, 1), cB + hstep, voffB); PG8_STAGE(PG8_SA(0, 0), cA, voffA); PG8_STAGE(PG8_SA(0, 1), cA + hstep, voffA);
        if (wr == 1) PG8_BAR;
        PG8_WAIT_V(2); PG8_BAR;
        PG8_STAGE(PG8_SB(1, 0), cB + kstep, voffB); PG8_STAGE(PG8_SA(1, 0), cA + kstep, voffA); PG8_STAGE(PG8_SB(1, 1), cB + hstep + kstep, voffB);
        PG8_WAIT_V(6); PG8_BAR;
    } else {
        PG8_STAGE(PG8_SB(0, 0), cB, voffB); PG8_STAGE(PG8_SA(0, 0), cA, voffA); PG8_STAGE(PG8_SB(0, 1), cB + hstep, voffB); PG8_STAGE(PG8_SA(0, 1), cA + hstep, voffA);
        if (wr == 1) PG8_BAR;
        PG8_WAIT_V(4); PG8_BAR;
        PG8_STAGE(PG8_SB(1, 0), cB + kstep, voffB); PG8_STAGE(PG8_SA(1, 0), cA + kstep, voffA); PG8_STAGE(PG8_SB(1, 1), cB + hstep + kstep, voffB);
        PG8_WAIT_V(6); PG8_BAR;
    }
    for (;;) {
        const bool has_next = S.next(ui + 1, nxt);
        const PG8_GAS char* nA = has_next ? (const PG8_GAS char*)g.A + (size_t)nxt.pm * tstep : cA; const PG8_GAS char* nB = has_next ? (const PG8_GAS char*)g.Bt + (size_t)nxt.pn * tstep : cB;
        for (int t = 0; t < nt; t += 2) {
            const bool last = (t == nt - 2);
            const PG8_GAS char* a1 = cA + (size_t)(t + 1) * kstep;
            const PG8_GAS char* a2 = last ? nA : cA + (size_t)(t + 2) * kstep; const PG8_GAS char* b2 = last ? nB : cB + (size_t)(t + 2) * kstep;
            const PG8_GAS char* a3 = a2 + kstep; const PG8_GAS char* b3 = b2 + kstep;
            if (last && has_next) S.a_ready(nxt);
            if constexpr (SP2) {
            PG8_LDB(B0, 0, 0); PG8_LDB(B1, 0, 1); PG8_SCHED; PG8_LDA(At, 0, 0); PG8_STAGE(PG8_SA(1, 1), a1 + hstep, voffA);
            PG8_WAIT_V(8); PG8_WAIT_L(0); PG8_BAR; PG8_MMA(0, 0, At, B0); PG8_MMA(0, 1, At, B1); PG8_BAR; PG8_SCHED;
            PG8_LDA(At, 0, 1); PG8_STAGE(PG8_SB(0, 0), b2, voffB); PG8_STAGE(PG8_SB(0, 1), b2 + hstep, voffB); PG8_STAGE(PG8_SA(0, 0), a2, voffA);
            PG8_WAIT_V(8); PG8_WAIT_L(0); PG8_BAR; PG8_MMA(1, 0, At, B0); PG8_MMA(1, 1, At, B1); PG8_BAR; PG8_SCHED;
            PG8_LDB(B0, 1, 0); PG8_LDB(B1, 1, 1); PG8_SCHED; PG8_LDA(At, 1, 0); PG8_STAGE(PG8_SA(0, 1), a2 + hstep, voffA);
            PG8_WAIT_V(8); PG8_WAIT_L(0); PG8_BAR; PG8_MMA(0, 0, At, B0); PG8_MMA(0, 1, At, B1); PG8_BAR; PG8_SCHED;
            PG8_LDA(At, 1, 1); PG8_STAGE(PG8_SB(1, 0), b3, voffB); PG8_STAGE(PG8_SB(1, 1), b3 + hstep, voffB); PG8_STAGE(PG8_SA(1, 0), a3, voffA);
            PG8_WAIT_V(8); PG8_WAIT_L(0); PG8_BAR; PG8_MMA(1, 0, At, B0); PG8_MMA(1, 1, At, B1); PG8_BAR; PG8_SCHED;
            } else {
            PG8_LDB(B0, 0, 0); PG8_SCHED; PG8_LDA(At, 0, 0); PG8_STAGE(PG8_SA(1, 1), a1 + hstep, voffA);
            PG8_WAIT_L(8); PG8_BAR; PG8_WAIT_L(0); PG8_MMA(0, 0, At, B0); PG8_BAR; PG8_SCHED;
            PG8_LDB(B1, 0, 1); PG8_STAGE(PG8_SB(0, 0), b2, voffB);
            PG8_BAR; PG8_WAIT_L(0); PG8_MMA(0, 1, At, B1); PG8_BAR;
            PG8_LDA(At, 0, 1); PG8_STAGE(PG8_SA(0, 0), a2, voffA);
            PG8_BAR; PG8_WAIT_L(0); PG8_MMA(1, 0, At, B0); PG8_BAR; PG8_SCHED;
            PG8_STAGE(PG8_SB(0, 1), b2 + hstep, voffB);
            PG8_WAIT_V(6); PG8_BAR; PG8_MMA(1, 1, At, B1); PG8_BAR;
            PG8_LDB(B0, 1, 0); PG8_SCHED; PG8_LDA(At, 1, 0); PG8_STAGE(PG8_SA(0, 1), a2 + hstep, voffA);
            PG8_WAIT_L(8); PG8_BAR; PG8_WAIT_L(0); PG8_MMA(0, 0, At, B0); PG8_BAR; PG8_SCHED;
            PG8_LDB(B1, 1, 1); PG8_STAGE(PG8_SB(1, 0), b3, voffB);
            PG8_BAR; PG8_WAIT_L(0); PG8_MMA(0, 1, At, B1); PG8_BAR;
            PG8_LDA(At, 1, 1); PG8_STAGE(PG8_SA(1, 0), a3, voffA);
            PG8_BAR; PG8_WAIT_L(0); PG8_MMA(1, 0, At, B0); PG8_BAR; PG8_SCHED;
            PG8_STAGE(PG8_SB(1, 1), b3 + hstep, voffB);
            PG8_WAIT_V(6); PG8_BAR; PG8_MMA(1, 1, At, B1); PG8_BAR;
            }
        }
        if constexpr (ALIGN_EPI) { if (wr == 0) PG8_BAR; }
        if constexpr (!Epi::AFTER_DRAIN) { E(acc, cur, wr, wc, fr, fq); S.done(cur); }
        if (!has_next) break;
#pragma unroll
        for (int a = 0; a < 2; ++a)
#pragma unroll
            for (int b = 0; b < 2; ++b)
#pragma unroll
                for (int m = 0; m < 4; ++m)
#pragma unroll
                    for (int n = 0; n < 2; ++n) acc[a][b][m][n] = (f32x4){0.f, 0.f, 0.f, 0.f};
        cur = nxt; cA = nA; cB = nB; ++ui;
        if constexpr (ALIGN_EPI) { if (wr == 1) PG8_BAR; }
    }
    PG8_WAIT_V(0);
    if constexpr (!ALIGN_EPI) { if (wr == 0) PG8_BAR; }
    PG8_BAR;
    if constexpr (Epi::AFTER_DRAIN) { E.fused(acc, cur, wr, wc, fr, fq, lds, wid, lane); S.done(cur); }
#undef PG8_SA
#undef PG8_SB
#undef PG8_STAGE
#undef PG8_LDA
#undef PG8_LDB
#undef PG8_MMA
#undef PG8_WAIT_V
#undef PG8_WAIT_L
#undef PG8_BAR
#undef PG8_SCHED
}
}
#define GAS __attribute__((address_space(1)))
#define LAS __attribute__((address_space(3)))
typedef unsigned short bf16;
typedef unsigned v4u __attribute__((ext_vector_type(4)));
typedef float f32x4 __attribute__((ext_vector_type(4)));
typedef short bf16x8 __attribute__((ext_vector_type(8)));
typedef GAS unsigned gu32;
typedef GAS unsigned long long gu64;
#define RLX_AGENT __ATOMIC_RELAXED, __HIP_MEMORY_SCOPE_AGENT
#define LDS_WAIT() asm volatile("s_waitcnt lgkmcnt(0)" ::: "memory")
#define VM_WAIT() asm volatile("s_waitcnt vmcnt(0)" ::: "memory")
__device__ __forceinline__ unsigned long long rt() { return __builtin_amdgcn_s_memrealtime(); }
__device__ __forceinline__ unsigned f2bf(float f) { unsigned u = __builtin_bit_cast(unsigned, f); return (u + 0x7fffu + ((u >> 16) & 1u)) >> 16; }
__device__ __forceinline__ unsigned pk2(float lo, float hi) { return f2bf(lo) | (f2bf(hi) << 16); }

#define XB_TMO      128
#define XB_XCNT(j)  (256  + 64 * (j))
#define XB_XSUB(j)  (1280 + 64 * (j))
#define XB_XGEN(j)  (2304 + 64 * (j))
#define XB_TOP      3328
#define XB_TOPGEN   3392
#define XCD_BAR_WORDS 3456
#define XB_SPIN_CAP (1u << 18)

__device__ __forceinline__ unsigned xb_ld(unsigned* p)              { return __hip_atomic_load(p, __ATOMIC_RELAXED, __HIP_MEMORY_SCOPE_AGENT); }
__device__ __forceinline__ unsigned xb_add(unsigned* p, unsigned v) { return __hip_atomic_fetch_add(p, v, __ATOMIC_RELAXED, __HIP_MEMORY_SCOPE_AGENT); }
__device__ __forceinline__ unsigned xb_xcc_id() { return (unsigned)__builtin_amdgcn_s_getreg((3 << 11) | 20) & 0xFu; }
#define XB_SPIN(cond, bar) do { unsigned _sp = 0; while (cond) { __builtin_amdgcn_s_sleep(1); \
    if ((++_sp & 255u) == 0u) { if (xb_ld(&(bar)[XB_TMO])) break; if (_sp > XB_SPIN_CAP) { atomicAdd(&(bar)[XB_TMO], 1u); break; } } } } while (0)

struct XcdBarrier {
    unsigned* bar; unsigned x;
    volatile LAS unsigned* st;
};

__device__ __forceinline__ XcdBarrier xcd_barrier_post(unsigned* bar, volatile LAS unsigned* st, const int tid) {
    XcdBarrier b; b.bar = bar; b.x = xb_xcc_id(); b.st = st;
    if (tid == 0) (void)xb_add(&bar[XB_XCNT(b.x)], 1u);
    return b;
}
__device__ __forceinline__ void xcd_barrier_complete(unsigned* bar, unsigned x, unsigned& nloc, unsigned& nx) {
    const unsigned G = gridDim.x * gridDim.y * gridDim.z;
    unsigned sum, cnt, mine, sp = 0u;
    for (;;) {
        sum = 0u; cnt = 0u; mine = 0u;
#pragma unroll
        for (unsigned j = 0; j < 16; ++j) { const unsigned c = xb_ld(&bar[XB_XCNT(j)]); sum += c; cnt += (c > 0u) ? 1u : 0u; mine = (j == x) ? c : mine; }
        if (sum == G) break;
        __builtin_amdgcn_s_sleep(1);
        if ((++sp & 255u) == 0u) { if (xb_ld(&bar[XB_TMO])) break; if (sp > XB_SPIN_CAP) { atomicAdd(&bar[XB_TMO], 1u); break; } }
    }
    nloc = mine > 0u ? mine : 1u; nx = cnt > 0u ? cnt : 1u;
}

__device__ __forceinline__ void xcd_barrier(const XcdBarrier& b, const int tid) {
    asm volatile("s_waitcnt vmcnt(0)" ::: "memory");
    __syncthreads();
    if (tid == 0) {
        unsigned* bar = b.bar;
        __builtin_amdgcn_s_waitcnt(0);
        unsigned nloc = b.st[0], nx = b.st[1];
        if (nloc == 0u) { xcd_barrier_complete(bar, b.x, nloc, nx); b.st[0] = nloc; b.st[1] = nx; }
        const unsigned old = xb_add(&bar[XB_XSUB(b.x)], 1u);
        const unsigned gen = old / nloc;
        if (old + 1u == (gen + 1u) * nloc) {
            __builtin_amdgcn_fence(__ATOMIC_RELEASE, "agent");
            asm volatile("s_waitcnt vmcnt(0)" ::: "memory");
            const unsigned og = xb_add(&bar[XB_TOP], 1u);
            const unsigned tg = og / nx;
            if (og + 1u == (tg + 1u) * nx) xb_add(&bar[XB_TOPGEN], 1u);
            else XB_SPIN(xb_ld(&bar[XB_TOPGEN]) == tg, bar);
            __builtin_amdgcn_fence(__ATOMIC_ACQUIRE, "agent");
            xb_add(&bar[XB_XGEN(b.x)], 1u);
            asm volatile("s_waitcnt vmcnt(0)" ::: "memory");
        } else {
            XB_SPIN(xb_ld(&bar[XB_XGEN(b.x)]) == gen, bar);
            __builtin_amdgcn_fence(__ATOMIC_ACQUIRE, "agent");
            asm volatile("s_waitcnt vmcnt(0)" ::: "memory");
        }
    }
    __syncthreads();
}
constexpr int BATCH = 2, SEQ = 4096, DM = 2048, DEPTH = 4, MTOK = BATCH * SEQ;
constexpr int HD = 64, RH = 12, AH = 12, GGRP = 8, RWID = 768, AWID = 768, GWID = 512;
constexpr int RCOLS = 2560, ACOLS = 2304, GCOLS = 1024, INCOLS = 5888, DFF = 5632, UPN = 2 * DFF;
constexpr int QOFF = RCOLS, KOFF = RCOLS + AWID, VOFF = RCOLS + 2 * AWID, GOFF = RCOLS + ACOLS;
constexpr int TCH = 64, NCH = SEQ / TCH;
constexpr int NTASK_SCAN = BATCH * RH * NCH;
constexpr float NORM_EPS = 1e-6f, GN_EPS = 1e-5f, RWKV_LN_EPS = 64e-5f;
constexpr float DECAY_SCALE = 0.6065306597126334f;
constexpr int NWAVES = 8, NTHR = NWAVES * 64;

constexpr size_t MiB = 1u << 20;
constexpr size_t WS_CTL = 0, CTL_ZERO_BYTES = 1 * MiB;
constexpr size_t WS_WIN = 2 * MiB, WS_WOUT = 94 * MiB, WS_WUP = 126 * MiB, WS_WDN = 302 * MiB;
constexpr size_t WS_HN = 390 * MiB, WS_Y = 422 * MiB, WS_O = 454 * MiB;
constexpr size_t WS_REG = 518 * MiB;
constexpr size_t WS_PROJ = WS_REG;
constexpr size_t WS_RW = WS_REG + 92 * MiB;
constexpr size_t WS_CHK = WS_RW + 216 * MiB;
constexpr size_t WS_QKR = WS_CHK + 72 * MiB;
constexpr size_t WS_AO = WS_QKR + 24 * MiB;
constexpr size_t WS_SGU = WS_AO + 24 * MiB;
constexpr size_t WS_BON = WS_SGU + 32 * MiB;
constexpr size_t WS_END_MIX = WS_BON + 1 * MiB;
constexpr size_t WS_UP = WS_REG;
constexpr size_t WS_H = WS_REG + 176 * MiB;
constexpr size_t WS_END = WS_END_MIX;
static_assert(WS_H + 88 * MiB <= WS_END, "map");
constexpr int CW_BAR = 4096;

constexpr int RING_BYTES = 131072, LDSCTL_OFF = RING_BYTES, MISC_OFF = LDSCTL_OFF + 320, LDS_BYTES = 147456;

struct Params { const float* in[29]; float* out; unsigned char* ws; };

typedef const GAS float* gcf; typedef GAS float* gfp; typedef const GAS bf16* gcb; typedef GAS bf16* gbp; typedef const GAS int* gci;
__device__ __forceinline__ float bf2f(unsigned short u) { return __builtin_bit_cast(float, (unsigned)u << 16); }
__device__ __forceinline__ float bflo(unsigned u) { return __builtin_bit_cast(float, u << 16); }
__device__ __forceinline__ float bfhi(unsigned u) { return __builtin_bit_cast(float, u & 0xffff0000u); }
__device__ __forceinline__ float wave_sum(float v) {
#pragma unroll
    for (int o = 1; o < 64; o <<= 1) v += __shfl_xor(v, o);
    return v;
}
__device__ __forceinline__ float wave_max(float v) {
#pragma unroll
    for (int o = 1; o < 64; o <<= 1) v = fmaxf(v, __shfl_xor(v, o));
    return v;
}
__device__ __forceinline__ float sigmoidf_(float x) { return 1.f / (1.f + __expf(-x)); }
__device__ __forceinline__ float gelu_tanh(float x) { const float u = 0.7978845608028654f * (x + 0.044715f * x * x * x); return 0.5f * x * (1.f + tanhf(u)); }

__device__ __forceinline__ void p0_transpose_item(gcf W, int K, int N, gbp WT, int row_off, LAS float* scr, int item, int lane) {
    const int nblk = N / 32, kb = item / nblk, nb = item % nblk, k0 = 64 * kb, n0 = 32 * nb;
#pragma unroll 8
    for (int i = 0; i < 32; ++i) { const int kk = 2 * i + (lane >> 5); scr[kk * 33 + (lane & 31)] = W[(size_t)(k0 + kk) * N + n0 + (lane & 31)]; }
    LDS_WAIT(); asm volatile("" ::: "memory");
    const int c = lane & 7;
#pragma unroll
    for (int j = 0; j < 4; ++j) { const int n = (lane >> 3) + 8 * j; const LAS float* s = scr + (8 * c) * 33 + n;
        v4u o; o.x = pk2(s[0 * 33], s[1 * 33]); o.y = pk2(s[2 * 33], s[3 * 33]); o.z = pk2(s[4 * 33], s[5 * 33]); o.w = pk2(s[6 * 33], s[7 * 33]);
        *(GAS v4u*)(WT + (size_t)(row_off + n0 + n) * K + k0 + 8 * c) = o; }
    LDS_WAIT(); asm volatile("" ::: "memory");
}

__device__ __forceinline__ void rowpass(gcf xin, gcf delta, gcf gpost, gfp xout, gcf gnext, gbp hn, int gw, int ngw, int lane) {
    for (int m = gw; m < MTOK; m += ngw) {
        const GAS f32x4* xr = (const GAS f32x4*)(xin + (size_t)m * DM) + lane;
        f32x4 xv[8];
#pragma unroll
        for (int j = 0; j < 8; ++j) xv[j] = xr[64 * j];
        if (delta) {
            const GAS f32x4* dr = (const GAS f32x4*)(delta + (size_t)m * DM) + lane;
            f32x4 dv[8]; float ss = 0.f;
#pragma unroll
            for (int j = 0; j < 8; ++j) { dv[j] = dr[64 * j]; ss += dv[j].x * dv[j].x + dv[j].y * dv[j].y + dv[j].z * dv[j].z + dv[j].w * dv[j].w; }
            const float rstd = rsqrtf(wave_sum(ss) * (1.f / DM) + NORM_EPS);
            GAS f32x4* xo = (GAS f32x4*)(xout + (size_t)m * DM) + lane;
#pragma unroll
            for (int j = 0; j < 8; ++j) { const f32x4 g = ((const GAS f32x4*)gpost)[lane + 64 * j]; xv[j] = xv[j] + dv[j] * rstd * g; xo[64 * j] = xv[j]; }
        }
        if (gnext) {
            float ss = 0.f;
#pragma unroll
            for (int j = 0; j < 8; ++j) ss += xv[j].x * xv[j].x + xv[j].y * xv[j].y + xv[j].z * xv[j].z + xv[j].w * xv[j].w;
            const float rstd = rsqrtf(wave_sum(ss) * (1.f / DM) + NORM_EPS);
            GAS unsigned long long* o8 = (GAS unsigned long long*)(hn + (size_t)m * DM) + lane;
#pragma unroll
            for (int j = 0; j < 8; ++j) { const f32x4 g = ((const GAS f32x4*)gnext)[lane + 64 * j]; const f32x4 v = xv[j] * rstd * g;
                o8[64 * j] = (unsigned long long)pk2(v.x, v.y) | ((unsigned long long)pk2(v.z, v.w) << 32); }
        }
    }
}

struct PrepW { gcf mu, w0, w2, a0, a2, g2, kk_, ka_, rk, sgu_g, sgu_b; gci pos; };
__device__ __forceinline__ void prep_token(int tok, gcb PROJ, const PrepW& w, gfp RWb, gfp BON, gbp QKR, gfp SU, gfp SVN, LAS float* pp, int lane) {
    const int t = tok % SEQ;
    gcb prow = PROJ + (size_t)tok * INCOLS;
    constexpr size_t AS = (size_t)MTOK * RWID;
    gfp R = RWb; gfp Wd = RWb + AS; gfp K2 = RWb + 2 * AS; gfp V = RWb + 3 * AS; gfp KK = RWb + 4 * AS; gfp KKA = RWb + 5 * AS; gfp Gt = RWb + 6 * AS;
#pragma unroll 4
    for (int i = 0; i < 40; ++i) { const int c = lane + 64 * i; const float p = bf2f(prow[c]); const float q = t > 0 ? bf2f(prow[c - INCOLS]) : 0.f; pp[c] = p + (q - p) * w.mu[c]; }
    LAS float* lw = pp + 2560; LAS float* la = pp + 2624; LAS float* lg = pp + 2688;
    lw[lane] = tanhf(pp[2304 + lane]); la[lane] = pp[2368 + lane]; lg[lane] = sigmoidf_(pp[2432 + lane]); lg[64 + lane] = sigmoidf_(pp[2496 + lane]);
    float dw[12], da[12], dg[12];
#pragma unroll
    for (int i = 0; i < 12; ++i) { dw[i] = 0.f; da[i] = 0.f; dg[i] = 0.f; }
    for (int j = 0; j < 64; ++j) { const float xw = lw[j], xa = la[j];
#pragma unroll
        for (int i = 0; i < 12; ++i) { dw[i] += xw * w.w2[j * RWID + lane + 64 * i]; da[i] += xa * w.a2[j * RWID + lane + 64 * i]; } }
    for (int j = 0; j < 128; ++j) { const float xg = lg[j];
#pragma unroll
        for (int i = 0; i < 12; ++i) dg[i] += xg * w.g2[j * RWID + lane + 64 * i]; }
#pragma unroll
    for (int i = 0; i < 12; ++i) { const int n = lane + 64 * i;
        const float r = pp[n], k = pp[768 + n], v = pp[1536 + n];
        const float decay = __expf(-DECAY_SCALE * sigmoidf_(w.w0[n] + dw[i]));
        const float a = sigmoidf_(w.a0[n] + da[i]);
        const float kkr = k * w.kk_[n];
        const float ss = wave_sum(kkr * kkr);
        const float kk = kkr / fmaxf(sqrtf(ss), 1e-12f);
        const float k2 = k * (1.f + (a - 1.f) * w.ka_[n]);
        const float bon = wave_sum(r * k2 * w.rk[n]);
        const size_t o = (size_t)tok * RWID + n;
        R[o] = r; Wd[o] = decay; K2[o] = k2; V[o] = v; KK[o] = kk; KKA[o] = kk * a; Gt[o] = dg[i];
        if (lane == 0) BON[tok * 12 + i] = bon; }
    {
        float cs = 1.f, sn = 0.f;
        if (lane < 16) { const int f = lane & 7; const float inv = exp2f(-(float)f * (18.931568569324174f / 8.f)); const float ang = (float)w.pos[tok] * inv; cs = cosf(ang); sn = sinf(ang); }
#pragma unroll 4
        for (int i = 0; i < 24; ++i) { const int c = lane + 64 * i; float x = bf2f(prow[QOFF + c]);
            if (lane < 16) { const float oth = bf2f(prow[QOFF + c + (lane < 8 ? 8 : -8)]); x = lane < 8 ? x * cs - oth * sn : x * cs + oth * sn; }
            if (i < 12) x *= 0.125f;
            QKR[(size_t)tok * 1536 + c] = (bf16)f2bf(x); }
    }
#pragma unroll 4
    for (int i = 0; i < 16; ++i) { const int c = lane + 64 * i; const float z = gelu_tanh(bf2f(prow[GOFF + c]));
        if (i < 8) SU[(size_t)tok * GWID + c] = z;
        else { const int g = i - 8; const float mu = wave_sum(z) * (1.f / 64.f); const float d = z - mu; const float var = wave_sum(d * d) * (1.f / 64.f);
            SVN[(size_t)tok * GWID + g * 64 + lane] = d * rsqrtf(var + GN_EPS) * w.sgu_g[g * 64 + lane] + w.sgu_b[g * 64 + lane]; } }
}

template <bool IDN>
__device__ __forceinline__ void scan_chunk(int task, gcf RWb, gfp OUTV  , gfp OUTM  , LAS float* ops, int lane) {
    constexpr unsigned AS = (unsigned)MTOK * RWID;
    gcf R = RWb; gcf Wd = RWb + AS; gcf K2 = RWb + 2 * AS; gcf V = RWb + 3 * AS; gcf KK = RWb + 4 * AS; gcf KKA = RWb + 5 * AS;
    const int bh = task / NCH, c = task % NCH, b = bh / RH, h = bh % RH;
    const unsigned base = (unsigned)((b * SEQ + c * TCH) * RWID + h * 64 + lane);
    float st[64];
#pragma unroll
    for (int k = 0; k < 64; ++k) st[k] = (IDN && k == lane) ? 1.f : 0.f;
    float nw = Wd[base], nkk = KK[base], nka = KKA[base], nk = IDN ? 0.f : K2[base], nr = R[base], nv = IDN ? 0.f : V[base];
    for (int i = 0; i < TCH; ++i) {
        LAS float* ob = ops + (i & 1) * 320;
        ob[lane] = nw; ob[64 + lane] = nkk; ob[128 + lane] = nka; if (!IDN) ob[192 + lane] = nk; ob[256 + lane] = nr;
        const float vcur = nv;
        if (i + 1 < TCH) { const unsigned o = base + (unsigned)(i + 1) * RWID; nw = Wd[o]; nkk = KK[o]; nka = KKA[o]; nr = R[o]; if (!IDN) { nk = K2[o]; nv = V[o]; } }
        const LAS f32x4* o4 = (const LAS f32x4*)ob;
        float sk = 0.f;
#pragma unroll
        for (int k4 = 0; k4 < 16; ++k4) { const f32x4 q = o4[16 + k4];
            sk += st[4 * k4] * q.x + st[4 * k4 + 1] * q.y + st[4 * k4 + 2] * q.z + st[4 * k4 + 3] * q.w; }
        float y = 0.f;
#pragma unroll
        for (int k4 = 0; k4 < 16; ++k4) { const f32x4 w4 = o4[k4], a4 = o4[32 + k4], r4 = o4[64 + k4]; f32x4 kv = {0.f, 0.f, 0.f, 0.f}; if (!IDN) kv = o4[48 + k4];
#pragma unroll
            for (int j = 0; j < 4; ++j) { const int k = 4 * k4 + j;
                if (IDN) st[k] = st[k] * w4[j] - sk * a4[j]; else st[k] = st[k] * w4[j] - sk * a4[j] + vcur * kv[j];
                y += st[k] * r4[j]; } }
        OUTV[base + (unsigned)i * RWID] = y;
    }
    gfp om = OUTM + (unsigned)(task * 4096 + lane);
#pragma unroll
    for (int k = 0; k < 64; ++k) om[k * 64] = st[k];
}

__device__ __forceinline__ void scan_carry(int bh, gcf PT, gcf SLT, gfp SST, LAS float* lp  , LAS float* ln  , int lane) {
    float S[64];
#pragma unroll
    for (int k = 0; k < 64; ++k) S[k] = 0.f;
    for (int c = 0; c < NCH; ++c) {
        const size_t tb = (size_t)(bh * NCH + c) * 4096;
#pragma unroll
        for (int k = 0; k < 64; ++k) SST[tb + k * 64 + lane] = S[k];
        if (c == NCH - 1) break;
#pragma unroll
        for (int i = 0; i < 16; ++i) ((LAS f32x4*)lp)[i * 64 + lane] = ((const GAS f32x4*)(PT + tb))[i * 64 + lane];
        for (int kp = 0; kp < 64; ++kp) { float acc = SLT[tb + kp * 64 + lane];
#pragma unroll
            for (int k4 = 0; k4 < 16; ++k4) { const f32x4 q = ((const LAS f32x4*)lp)[kp * 16 + k4];
                acc += S[4 * k4] * q.x + S[4 * k4 + 1] * q.y + S[4 * k4 + 2] * q.z + S[4 * k4 + 3] * q.w; }
            ln[kp * 64 + lane] = acc; }
#pragma unroll
        for (int k = 0; k < 64; ++k) S[k] = ln[k * 64 + lane];
    }
}

__device__ __forceinline__ void scan_out(int task, gcf RWb, gcf YL, gcf Z, gcf SST, gcf BON, gcf ln_g, gcf ln_b, gbp Y, LAS float* zb, int lane) {
    constexpr size_t AS = (size_t)MTOK * RWID;
    gcf V = RWb + 3 * AS; gcf Gt = RWb + 6 * AS;
    const int bh = task / NCH, c = task % NCH, b = bh / RH, h = bh % RH;
    const int tok0 = b * SEQ + c * TCH; const int n = h * 64 + lane;
    float S[64];
#pragma unroll
    for (int k = 0; k < 64; ++k) S[k] = SST[(size_t)task * 4096 + k * 64 + lane];
    const float lg = ln_g[n], lb = ln_b[n];
    for (int i = 0; i < TCH; ++i) { const int tok = tok0 + i; const size_t o = (size_t)tok * RWID + n;
        zb[(i & 1) * 64 + lane] = Z[o];
        float y = YL[o];
#pragma unroll
        for (int k4 = 0; k4 < 16; ++k4) { const f32x4 q = ((const LAS f32x4*)(zb + (i & 1) * 64))[k4];
            y += S[4 * k4] * q.x + S[4 * k4 + 1] * q.y + S[4 * k4 + 2] * q.z + S[4 * k4 + 3] * q.w; }
        const float mu = wave_sum(y) * (1.f / 64.f); const float d = y - mu; const float var = wave_sum(d * d) * (1.f / 64.f);
        float yn = d * rsqrtf(var + RWKV_LN_EPS) * lg + lb;
        yn += BON[tok * 12 + h] * V[o];
        Y[(size_t)tok * DM + n] = (bf16)f2bf(yn * Gt[o]); }
}

__device__ __forceinline__ void attn_naive(int task, gcb QKR, gcb PROJ, gfp AO, LAS float* pb, int lane) {
    const int tok = task / AH, h = task % AH, b = tok / SEQ, t = tok % SEQ;
    float q[64];
    { const GAS v4u* qp = (const GAS v4u*)(QKR + (size_t)tok * 1536 + h * 64);
#pragma unroll
      for (int i = 0; i < 8; ++i) { const v4u u = qp[i]; q[8 * i] = bflo(u.x); q[8 * i + 1] = bfhi(u.x); q[8 * i + 2] = bflo(u.y); q[8 * i + 3] = bfhi(u.y); q[8 * i + 4] = bflo(u.z); q[8 * i + 5] = bfhi(u.z); q[8 * i + 6] = bflo(u.w); q[8 * i + 7] = bfhi(u.w); } }
    float outp[3], lse[3];
#pragma unroll
    for (int p = 0; p < 3; ++p) { const int d = p == 0 ? 1 : (p == 1 ? 4 : 16);
        float s[3]; bool val[3];
#pragma unroll
        for (int r = 0; r < 3; ++r) { const int jj = lane + 64 * r; const int tk = t - d * jj; val[r] = (jj <= 128) && (tk >= 0); s[r] = -1e30f;
            if (val[r]) { const GAS v4u* kp = (const GAS v4u*)(QKR + (size_t)(b * SEQ + tk) * 1536 + 768 + h * 64); float a = 0.f;
#pragma unroll
                for (int i = 0; i < 8; ++i) { const v4u u = kp[i]; a += q[8 * i] * bflo(u.x) + q[8 * i + 1] * bfhi(u.x) + q[8 * i + 2] * bflo(u.y) + q[8 * i + 3] * bfhi(u.y) + q[8 * i + 4] * bflo(u.z) + q[8 * i + 5] * bfhi(u.z) + q[8 * i + 6] * bflo(u.w) + q[8 * i + 7] * bfhi(u.w); }
                s[r] = a; } }
        const float m = wave_max(fmaxf(fmaxf(s[0], s[1]), s[2]));
        float psum = 0.f;
#pragma unroll
        for (int r = 0; r < 3; ++r) { const float pr = val[r] ? __expf(s[r] - m) : 0.f; psum += pr; pb[lane + 64 * r] = pr; }
        const float l = wave_sum(psum);
        int nk = t / d; nk = (nk > 128 ? 128 : nk) + 1;
        float acc = 0.f;
        gcb vp = PROJ + (size_t)(b * SEQ + t) * INCOLS + VOFF + h * 64 + lane;
        for (int jj = 0; jj < nk; ++jj) acc += pb[jj] * bf2f(vp[-(ptrdiff_t)jj * d * INCOLS]);
        outp[p] = acc / l; lse[p] = m + __logf(l); }
    const float mx = fmaxf(fmaxf(lse[0], lse[1]), lse[2]);
    const float w0 = __expf(lse[0] - mx), w1 = __expf(lse[1] - mx), w2 = __expf(lse[2] - mx);
    AO[(size_t)tok * AWID + h * 64 + lane] = (w0 * outp[0] + w1 * outp[1] + w2 * outp[2]) / (w0 + w1 + w2);
}

__device__ __forceinline__ void attn_norm_token(int tok, gcf AO, gcf g, gbp Y, int lane) {
    float v[12], ss = 0.f;
#pragma unroll
    for (int i = 0; i < 12; ++i) { v[i] = AO[(size_t)tok * AWID + lane + 64 * i]; ss += v[i] * v[i]; }
    const float rstd = rsqrtf(wave_sum(ss) * (1.f / AWID) + NORM_EPS);
#pragma unroll
    for (int i = 0; i < 12; ++i) Y[(size_t)tok * DM + RWID + lane + 64 * i] = (bf16)f2bf(v[i] * rstd * g[lane + 64 * i]);
}

__device__ __forceinline__ void sgu_token(int tok, gcf SU, gcf SVN, gcf ws  , gcf bs  , gcf ng, gbp Y, int lane) {
    const int i = tok % 128; const int tok0 = tok - i;
    float q[8], ss = 0.f;
#pragma unroll
    for (int g = 0; g < 8; ++g) { float acc = 0.f; gcf wr = ws + ((size_t)g * 128 + i) * 128; gcf vp = SVN + (size_t)tok0 * GWID + g * 64 + lane;
        for (int j = 0; j <= i; ++j) acc += wr[j] * vp[(size_t)j * GWID];
        const float vo = acc + bs[g * 128 + i]; q[g] = SU[(size_t)tok * GWID + g * 64 + lane] * vo; ss += q[g] * q[g]; }
    const float rstd = rsqrtf(wave_sum(ss) * (1.f / GWID) + NORM_EPS);
#pragma unroll
    for (int g = 0; g < 8; ++g) Y[(size_t)tok * DM + RWID + AWID + g * 64 + lane] = (bf16)f2bf(q[g] * rstd * ng[g * 64 + lane]);
}

__device__ __forceinline__ void conv_item(int item, gcb UP, gcf cw, gcf cb, gbp H) {
    const int tok = item / (DFF / 8), j8 = (item % (DFF / 8)) * 8, t = tok % SEQ;
    float gt[8], vl[8];
#pragma unroll
    for (int e = 0; e < 8; ++e) { gt[e] = cb[j8 + e]; vl[e] = cb[DFF + j8 + e]; }
#pragma unroll
    for (int tap = 0; tap < 3; ++tap) { const int dt = 2 - tap;
        if (t - dt >= 0) { gcb ur = UP + (size_t)(tok - dt) * UPN; const v4u ug = *(const GAS v4u*)(ur + j8), uv = *(const GAS v4u*)(ur + DFF + j8);
            gcf wg = cw + (size_t)tap * UPN + j8; gcf wv = wg + DFF;
            const unsigned a[4] = {ug.x, ug.y, ug.z, ug.w}, c[4] = {uv.x, uv.y, uv.z, uv.w};
#pragma unroll
            for (int e = 0; e < 4; ++e) { gt[2 * e] += bflo(a[e]) * wg[2 * e]; gt[2 * e + 1] += bfhi(a[e]) * wg[2 * e + 1]; vl[2 * e] += bflo(c[e]) * wv[2 * e]; vl[2 * e + 1] += bfhi(c[e]) * wv[2 * e + 1]; } } }
    v4u o; o.x = pk2(gelu_tanh(gt[0]) * vl[0], gelu_tanh(gt[1]) * vl[1]); o.y = pk2(gelu_tanh(gt[2]) * vl[2], gelu_tanh(gt[3]) * vl[3]);
    o.z = pk2(gelu_tanh(gt[4]) * vl[4], gelu_tanh(gt[5]) * vl[5]); o.w = pk2(gelu_tanh(gt[6]) * vl[6], gelu_tanh(gt[7]) * vl[7]);
    *(GAS v4u*)(H + (size_t)tok * DFF + j8) = o;
}

typedef const __attribute__((address_space(4))) unsigned long long* kargs_t;
__device__ __forceinline__ kargs_t kargs() { kargs_t ka = (kargs_t)__builtin_amdgcn_kernarg_segment_ptr(); asm volatile("" : "+s"(ka)); return ka; }
#define KIN(i) ((gcf)ka[i])
#define KOUT ((gfp)ka[29])
#define KWS ((GAS unsigned char*)ka[30])
constexpr size_t AS_ = (size_t)MTOK * RWID;
__device__ __forceinline__ int lane_id() { int l; asm volatile("v_mbcnt_lo_u32_b32 %0, -1, 0\n\tv_mbcnt_hi_u32_b32 %0, -1, %0" : "=v"(l)); return l; }
#define PH_IDS const int lane = lane_id(); const int tid = wave * 64 + lane; (void)tid
#define GBAR() do { const int lane_b = lane_id(); xcd_barrier(bar, wave * 64 + lane_b); } while (0)

__global__ void __launch_bounds__(NTHR, 2) mega_fwd(Params p) {
    extern __shared__ __attribute__((aligned(16))) unsigned char lds_raw[];
    LAS unsigned char* lds = (LAS unsigned char*)lds_raw;
    const int wave = __builtin_amdgcn_readfirstlane((int)threadIdx.x >> 6);
    const int G = gridDim.x, gw = blockIdx.x * NWAVES + wave, ngw = G * NWAVES;
    XcdBarrier bar;
    { PH_IDS; kargs_t ka = kargs();
      for (int u = tid; u < (LDS_BYTES - LDSCTL_OFF) / 4; u += NTHR) ((LAS unsigned*)(lds + LDSCTL_OFF))[u] = 0u;
      __syncthreads();
      bar = xcd_barrier_post((unsigned*)((GAS unsigned*)(KWS + WS_CTL) + CW_BAR), (volatile LAS unsigned*)(lds + MISC_OFF) + 8, tid); }

    {
        PH_IDS; kargs_t ka = kargs(); GAS unsigned char* ws = KWS;
        LAS float* scr = (LAS float* )(lds + wave * 16384);
        for (int l = 0; l < DEPTH; ++l) {
            for (int it = gw; it < (DM / 64) * (INCOLS / 32); it += ngw) p0_transpose_item(KIN(6) + (size_t)l * DM * INCOLS, DM, INCOLS, (gbp )(ws + WS_WIN) + (size_t)l * INCOLS * DM, 0, scr, it, lane);
            for (int it = gw; it < (DM / 64) * (DM / 32); it += ngw) p0_transpose_item(KIN(24) + (size_t)l * DM * DM, DM, DM, (gbp )(ws + WS_WOUT) + (size_t)l * DM * DM, 0, scr, it, lane);
            for (int it = gw; it < (DM / 64) * (UPN / 32); it += ngw) p0_transpose_item(KIN(25) + (size_t)l * DM * UPN, DM, UPN, (gbp )(ws + WS_WUP) + (size_t)l * UPN * DM, 0, scr, it, lane);
            for (int it = gw; it < (DFF / 64) * (DM / 32); it += ngw) p0_transpose_item(KIN(28) + (size_t)l * DFF * DM, DFF, DM, (gbp )(ws + WS_WDN) + (size_t)l * DM * DFF, 0, scr, it, lane);
        }
        rowpass(KIN(0), nullptr, nullptr, nullptr, KIN(2), (gbp )(ws + WS_HN), gw, ngw, lane);
    }
    GBAR();

    for (int l = 0; l < DEPTH; ++l) {
        { PH_IDS; kargs_t ka = kargs(); GAS unsigned char* ws = KWS;
          pg8::Gemm g{(gbp )(ws + WS_HN), (gbp )(ws + WS_WIN) + (size_t)l * INCOLS * DM, MTOK, INCOLS, DM}; pg8::StaticOrder S; S.init(MTOK, INCOLS, G, (int)blockIdx.x);
          pg8::EpiBf16<0> E{(gbp )(ws + WS_PROJ), INCOLS, nullptr, 0, 0, 1.f};
          pg8::gemm_phase<pg8::EpiBf16<0>, pg8::StaticOrder, true, true>(lds, g, S, E, tid); }
        GBAR();
        { PH_IDS; kargs_t ka = kargs(); GAS unsigned char* ws = KWS;
          PrepW w{KIN(7) + (size_t)l * RCOLS, KIN(8) + (size_t)l * RWID, KIN(9) + (size_t)l * 64 * RWID, KIN(10) + (size_t)l * RWID, KIN(11) + (size_t)l * 64 * RWID, KIN(12) + (size_t)l * 128 * RWID,
                  KIN(13) + (size_t)l * RWID, KIN(14) + (size_t)l * RWID, KIN(15) + (size_t)l * RWID, KIN(19) + (size_t)l * GWID, KIN(20) + (size_t)l * GWID, (gci)KIN(1)};
          LAS float* pp = (LAS float* )(lds + wave * 12288);
          gfp SU = (gfp )(ws + WS_SGU);
          for (int tok = gw; tok < MTOK; tok += ngw) prep_token(tok, (gbp )(ws + WS_PROJ), w, (gfp )(ws + WS_RW), (gfp )(ws + WS_BON), (gbp )(ws + WS_QKR), SU, SU + (size_t)MTOK * GWID, pp, lane); }
        GBAR();
        { PH_IDS; kargs_t ka = kargs(); GAS unsigned char* ws = KWS;
          LAS float* ops = (LAS float* )(lds + wave * 4096);
          gfp RWb = (gfp )(ws + WS_RW); gfp PT = (gfp )(ws + WS_CHK);
          for (int task = gw; task < 2 * NTASK_SCAN; task += ngw) { if (task < NTASK_SCAN) scan_chunk<false>(task, RWb, RWb + 7 * AS_, PT + (size_t)NTASK_SCAN * 4096, ops, lane); else scan_chunk<true>(task - NTASK_SCAN, RWb, RWb + 8 * AS_, PT, ops, lane); }
          for (int task = gw; task < MTOK * AH; task += ngw) attn_naive(task, (gbp )(ws + WS_QKR), (gbp )(ws + WS_PROJ), (gfp )(ws + WS_AO), ops, lane); }
        GBAR();
        { PH_IDS; kargs_t ka = kargs(); GAS unsigned char* ws = KWS;
          gfp PT = (gfp )(ws + WS_CHK); gfp SU = (gfp )(ws + WS_SGU);
          if (wave == 0 && blockIdx.x < BATCH * RH) scan_carry((int)blockIdx.x, PT, PT + (size_t)NTASK_SCAN * 4096, PT + 2 * (size_t)NTASK_SCAN * 4096, (LAS float* )lds, (LAS float* )(lds + 16384), lane);
          __syncthreads();
          for (int tok = gw; tok < MTOK; tok += ngw) { sgu_token(tok, SU, SU + (size_t)MTOK * GWID, KIN(21) + (size_t)l * 8 * 128 * 128, KIN(22) + (size_t)l * 8 * 128, KIN(23) + (size_t)l * GWID, (gbp )(ws + WS_Y), lane);
              attn_norm_token(tok, (gfp )(ws + WS_AO), KIN(18) + (size_t)l * AWID, (gbp )(ws + WS_Y), lane); } }
        GBAR();
        { PH_IDS; kargs_t ka = kargs(); GAS unsigned char* ws = KWS;
          LAS float* zb = (LAS float* )(lds + wave * 1024);
          gfp RWb = (gfp )(ws + WS_RW); gfp PT = (gfp )(ws + WS_CHK);
          for (int task = gw; task < NTASK_SCAN; task += ngw) scan_out(task, RWb, RWb + 7 * AS_, RWb + 8 * AS_, PT + 2 * (size_t)NTASK_SCAN * 4096, (gfp )(ws + WS_BON), KIN(16) + (size_t)l * RWID, KIN(17) + (size_t)l * RWID, (gbp )(ws + WS_Y), zb, lane); }
        GBAR();
        { PH_IDS; kargs_t ka = kargs(); GAS unsigned char* ws = KWS;
          pg8::Gemm g{(gbp )(ws + WS_Y), (gbp )(ws + WS_WOUT) + (size_t)l * DM * DM, MTOK, DM, DM}; pg8::StaticOrder S; S.init(MTOK, DM, G, (int)blockIdx.x);
          pg8::EpiF32 E{(gfp)(ws + WS_O), DM};
          pg8::gemm_phase<pg8::EpiF32, pg8::StaticOrder, true, true>(lds, g, S, E, tid); }
        GBAR();
        { PH_IDS; kargs_t ka = kargs(); GAS unsigned char* ws = KWS;
          rowpass(l == 0 ? KIN(0) : (gcf )KOUT, (gfp )(ws + WS_O), KIN(3) + (size_t)l * DM, KOUT, KIN(4) + (size_t)l * DM, (gbp )(ws + WS_HN), gw, ngw, lane); }
        GBAR();
        { PH_IDS; kargs_t ka = kargs(); GAS unsigned char* ws = KWS;
          pg8::Gemm g{(gbp )(ws + WS_HN), (gbp )(ws + WS_WUP) + (size_t)l * UPN * DM, MTOK, UPN, DM}; pg8::StaticOrder S; S.init(MTOK, UPN, G, (int)blockIdx.x);
          pg8::EpiBf16<0> E{(gbp )(ws + WS_UP), UPN, nullptr, 0, 0, 1.f};
          pg8::gemm_phase<pg8::EpiBf16<0>, pg8::StaticOrder, true, true>(lds, g, S, E, tid); }
        GBAR();
        { PH_IDS; kargs_t ka = kargs(); GAS unsigned char* ws = KWS;
          const int gtid = blockIdx.x * NTHR + tid, ngt = G * NTHR;
          for (int it = gtid; it < MTOK * (DFF / 8); it += ngt) conv_item(it, (gbp )(ws + WS_UP), KIN(26) + (size_t)l * 3 * UPN, KIN(27) + (size_t)l * UPN, (gbp )(ws + WS_H)); }
        GBAR();
        { PH_IDS; kargs_t ka = kargs(); GAS unsigned char* ws = KWS;
          pg8::Gemm g{(gbp )(ws + WS_H), (gbp )(ws + WS_WDN) + (size_t)l * DM * DFF, MTOK, DM, DFF}; pg8::StaticOrder S; S.init(MTOK, DM, G, (int)blockIdx.x);
          pg8::EpiF32 E{(gfp)(ws + WS_O), DM};
          pg8::gemm_phase<pg8::EpiF32, pg8::StaticOrder, true, true>(lds, g, S, E, tid); }
        GBAR();
        { PH_IDS; kargs_t ka = kargs(); GAS unsigned char* ws = KWS;
          rowpass(KOUT, (gfp )(ws + WS_O), KIN(5) + (size_t)l * DM, KOUT, l + 1 < DEPTH ? KIN(2) + (size_t)(l + 1) * DM : nullptr, (gbp )(ws + WS_HN), gw, ngw, lane); }
        if (l + 1 < DEPTH) GBAR();
    }
}

extern "C" void kernel_launch(void* const* d_in, const int* in_sizes, int n_in, void* d_out, int out_size, void* d_ws, size_t ws_size, hipStream_t stream) {
    static int grid = 0;
    if (grid == 0) {
        if (n_in != 29 || out_size != MTOK * DM || ws_size < WS_END) { fprintf(stderr, "kernel_launch: unexpected shapes (n_in %d out %d ws %zu need %zu)\n", n_in, out_size, ws_size, (size_t)WS_END); grid = -1; return; }
        int dev = 0, cus = 0, per_cu = 0;
        if (hipGetDevice(&dev) != hipSuccess || hipDeviceGetAttribute(&cus, hipDeviceAttributeMultiprocessorCount, dev) != hipSuccess) { grid = -1; return; }
        if (hipFuncSetAttribute((const void*)mega_fwd, hipFuncAttributeMaxDynamicSharedMemorySize, LDS_BYTES) != hipSuccess) { fprintf(stderr, "kernel_launch: hipFuncSetAttribute failed\n"); grid = -1; return; }
        if (hipOccupancyMaxActiveBlocksPerMultiprocessor(&per_cu, (const void*)mega_fwd, NTHR, LDS_BYTES) != hipSuccess || per_cu < 1) fprintf(stderr, "kernel_launch: occupancy query says %d\n", per_cu);
        (void)hipGetLastError();
        grid = cus;
    }
    if (grid < 0) return;
    if (hipMemsetAsync((char*)d_ws + WS_CTL, 0, CTL_ZERO_BYTES, stream) != hipSuccess) return;
    Params prm{};
    for (int i = 0; i < 29; ++i) prm.in[i] = (const float*)d_in[i];
    prm.out = (float*)d_out; prm.ws = (unsigned char*)d_ws;
    hipLaunchKernelGGL(mega_fwd, dim3(grid), dim3(NTHR), LDS_BYTES, stream, prm);
}
```

```cpp
#include <hip/hip_runtime.h>
#include <cstdio>
#include <cstdint>
namespace pg8 {
#define PG8_LAS __attribute__((address_space(3)))
#define PG8_GAS __attribute__((address_space(1)))
typedef unsigned short bf16_t;
typedef short bf16x8 __attribute__((ext_vector_type(8)));
typedef float f32x4 __attribute__((ext_vector_type(4)));
typedef unsigned u32x4 __attribute__((ext_vector_type(4)));
constexpr int BM = 256, BK = 64, HALF = 128, HTB = HALF * BK * 2  , STAGE_BYTES = 8 * HTB, NXCD = 8, WGM = 8;

__host__ __device__ __forceinline__ int lds_byte(int r, int c) { const int st = (r >> 4) * 2 + (c >> 5), rr = r & 15, cc = c & 31, ob = rr * 64 + cc * 2; return st * 1024 + (ob ^ (((ob >> 9) & 1) << 5)); }
__host__ __device__ __forceinline__ void stage_rc(int b, int& R, int& C) { const int st = b / 1024, sb = b % 1024, swz = sb ^ (((sb >> 9) & 1) << 5); R = (st >> 1) * 16 + swz / 64; C = (st & 1) * 32 + (swz % 64) / 2; }
__host__ __device__ __forceinline__ int perm32(int rho) { const int n = rho >> 4, i = rho & 15; return 8 * (i >> 2) + 4 * n + (i & 3); }

struct Unit { int pm, pn; };
struct Gemm { const PG8_GAS bf16_t* A; const PG8_GAS bf16_t* Bt; int M, N, K; };

struct StaticOrder {
    int nM, nN, nwg, G, c;
    __host__ __device__ void init(int M, int N, int G_, int c_) { nM = M / BM; nN = N / BM; nwg = nM * nN; G = G_; c = c_; }
    __host__ __device__ bool next(int i, Unit& u) const {
        const long L = (long)i * G + c; if (L >= nwg) return false;
        int wgid = (int)L; { const int q = nwg / NXCD, r = nwg % NXCD, xcd = wgid % NXCD, off = wgid / NXCD; wgid = (xcd < r ? xcd * (q + 1) : r * (q + 1) + (xcd - r) * q) + off; }
        const int nig = WGM * nN, gid = wgid / nig, fm = gid * WGM, gsz = (nM - fm) < WGM ? (nM - fm) : WGM;
        u.pm = fm + ((wgid % nig) % gsz); u.pn = (wgid % nig) / gsz; return true;
    }
    __device__ __forceinline__ void a_ready(const Unit&) const {}
    __device__ __forceinline__ void done(const Unit&) const {}
};

__device__ __forceinline__ unsigned cvt_pk_bf16(float lo, float hi) { unsigned r; asm volatile("v_cvt_pk_bf16_f32 %0, %1, %2" : "=v"(r) : "v"(lo), "v"(hi)); return r; }
typedef float f32x2 __attribute__((ext_vector_type(2)));
__device__ __forceinline__ f32x2 gelu_pk(f32x2 v) {
    const f32x2 av = __builtin_elementwise_abs(v), d = av * 0.2316418882f + 1.0f;
    f32x2 t; t.x = __builtin_amdgcn_rcpf(d.x); t.y = __builtin_amdgcn_rcpf(d.y);
    f32x2 q = t * 0.5307027145f + (-0.7265760135f); q = q * t + 0.7107068705f; q = q * t + (-0.142248368f); q = q * t + 0.127414796f; q = q * t;
    const f32x2 s = (v * v) * (-0.72134752044f);
    f32x2 e; e.x = __builtin_amdgcn_exp2f(s.x); e.y = __builtin_amdgcn_exp2f(s.y);
    const f32x2 m = v * (q * e), r = v - m;
    f32x2 o; o.x = v.x < 0.f ? m.x : r.x; o.y = v.y < 0.f ? m.y : r.y; return o;
}

template <int ACT  > struct EpiBf16 {
    static constexpr bool PERM = true, AFTER_DRAIN = false; static_assert(ACT == 0 || ACT == 1, "EpiBf16: ACT is 0 (none) or 1 (gelu_pk)");
    PG8_GAS bf16_t* O; int ldc; const PG8_GAS float* bias; int split_cols; size_t split_stride; float scale0;
    __device__ __forceinline__ void operator()(const f32x4 (&acc)[2][2][4][2], const Unit& u, int wr, int wc, int fr, int fq) const {
        const int row0 = u.pm * BM + wr * 64 + fr; int colt = u.pn * BM; PG8_GAS bf16_t* base = O;
        float sc = 1.f; if (split_cols) { const int t = colt / split_cols; base += (size_t)t * split_stride; colt -= t * split_cols; if (t == 0) sc = scale0; }
        const int col0 = colt + wc * 32 + 8 * fq, bcol0 = u.pn * BM + wc * 32 + 8 * fq;
        f32x4 bv[2][2];
#pragma unroll
        for (int bj = 0; bj < 2; ++bj)
#pragma unroll
            for (int n = 0; n < 2; ++n) bv[bj][n] = bias ? *(const PG8_GAS f32x4*)(bias + bcol0 + bj * HALF + 4 * n) : (f32x4){0.f, 0.f, 0.f, 0.f};
#pragma unroll
        for (int ai = 0; ai < 2; ++ai)
#pragma unroll
            for (int m = 0; m < 4; ++m) { PG8_GAS bf16_t* rowp = base + (size_t)(row0 + ai * HALF + m * 16) * ldc + col0;
#pragma unroll
                for (int bj = 0; bj < 2; ++bj) { f32x4 v0 = acc[ai][bj][m][0] + bv[bj][0], v1 = acc[ai][bj][m][1] + bv[bj][1];
                    if (ACT == 1) { f32x2 a = gelu_pk((f32x2){v0[0], v0[1]}), b = gelu_pk((f32x2){v0[2], v0[3]}), c = gelu_pk((f32x2){v1[0], v1[1]}), d = gelu_pk((f32x2){v1[2], v1[3]});
                        v0 = (f32x4){a.x, a.y, b.x, b.y}; v1 = (f32x4){c.x, c.y, d.x, d.y}; }
                    v0 = v0 * sc; v1 = v1 * sc; u32x4 w; w.x = cvt_pk_bf16(v0[0], v0[1]); w.y = cvt_pk_bf16(v0[2], v0[3]); w.z = cvt_pk_bf16(v1[0], v1[1]); w.w = cvt_pk_bf16(v1[2], v1[3]);
                    *(PG8_GAS u32x4*)(rowp + bj * HALF) = w; } }
    }
};
struct EpiF32 {
    static constexpr bool PERM = true, AFTER_DRAIN = false;
    PG8_GAS float* O; int ldc;
    __device__ __forceinline__ void operator()(const f32x4 (&acc)[2][2][4][2], const Unit& u, int wr, int wc, int fr, int fq) const {
        const int row0 = u.pm * BM + wr * 64 + fr, col0 = u.pn * BM + wc * 32 + 8 * fq;
#pragma unroll
        for (int ai = 0; ai < 2; ++ai)
#pragma unroll
            for (int m = 0; m < 4; ++m) { PG8_GAS float* rowp = O + (size_t)(row0 + ai * HALF + m * 16) * ldc + col0;
#pragma unroll
                for (int bj = 0; bj < 2; ++bj) { *(PG8_GAS f32x4*)(rowp + bj * HALF) = acc[ai][bj][m][0]; *(PG8_GAS f32x4*)(rowp + bj * HALF + 4) = acc[ai][bj][m][1]; } }
    }
};

template <class Epi, class Sched, bool ALIGN_EPI = false, bool SP2 = false>
__device__ __forceinline__ void gemm_phase(PG8_LAS unsigned char* lds, const Gemm g, const Sched& S, const Epi& E, const int tid) {
    const int wid = __builtin_amdgcn_readfirstlane(tid >> 6), lane = tid & 63, wr = wid >> 2, wc = wid & 3, fr = lane & 15, fq = lane >> 4;
    const int K = g.K, nt = K / BK;
    unsigned voffA[2], voffB[2];
#pragma unroll
    for (int i = 0; i < 2; ++i) { int R, C; stage_rc(tid * 16 + i * 8192, R, C); const int Rb = Epi::PERM ? ((R & ~31) + perm32(R & 31)) : R;
        voffA[i] = (unsigned)(R * K + C) * 2u; voffB[i] = (unsigned)(Rb * K + C) * 2u; }
    const size_t kstep = (size_t)(BK * 2);
    const size_t hstep = (size_t)HALF * K * 2;
    const size_t tstep = 2 * hstep;
    const unsigned ldsw = (unsigned)wid * 1024u;
    const int aoff = lds_byte(wr * 64 + fr, fq * 8), boff = lds_byte(wc * 32 + fr, fq * 8);
#define PG8_SA(b, h) (((b) * 2 + (h)) * HTB)
#define PG8_SB(b, h) ((4 + (b) * 2 + (h)) * HTB)
#define PG8_STAGE(bufoff, gbase, voff) do { _Pragma("unroll") for (int _i = 0; _i < 2; ++_i) \
        __builtin_amdgcn_global_load_lds((const PG8_GAS unsigned*)((const PG8_GAS char*)(gbase) + (voff)[_i]), (PG8_LAS unsigned*)(lds + (bufoff) + ldsw + _i * 8192), 16, 0, 0); } while (0)
#define PG8_LDA(dst, b, h) do { _Pragma("unroll") for (int m = 0; m < 4; ++m) _Pragma("unroll") for (int k = 0; k < 2; ++k) dst[m][k] = *(const PG8_LAS bf16x8*)(lds + PG8_SA(b, h) + aoff + m * 2048 + k * 1024); } while (0)
#define PG8_LDB(dst, b, h) do { _Pragma("unroll") for (int n = 0; n < 2; ++n) _Pragma("unroll") for (int k = 0; k < 2; ++k) dst[n][k] = *(const PG8_LAS bf16x8*)(lds + PG8_SB(b, h) + boff + n * 2048 + k * 1024); } while (0)
#define PG8_MMA(ai, bj, At, Bt) do { __builtin_amdgcn_s_setprio(1); _Pragma("unroll") for (int m = 0; m < 4; ++m) _Pragma("unroll") for (int n = 0; n < 2; ++n) _Pragma("unroll") for (int k = 0; k < 2; ++k) \
        acc[ai][bj][m][n] = __builtin_amdgcn_mfma_f32_16x16x32_bf16(Bt[n][k], At[m][k], acc[ai][bj][m][n], 0, 0, 0); __builtin_amdgcn_s_setprio(0); } while (0)
#define PG8_WAIT_V(n) asm volatile("s_waitcnt vmcnt(" #n ")" ::: "memory")
#define PG8_WAIT_L(n) asm volatile("s_waitcnt lgkmcnt(" #n ")" ::: "memory")
#define PG8_BAR __builtin_amdgcn_s_barrier()
#define PG8_SCHED __builtin_amdgcn_sched_barrier(0)
    Unit cur, nxt; int ui = 0;
    if (!S.next(0, cur)) return;
    f32x4 acc[2][2][4][2];
#pragma unroll
    for (int a = 0; a < 2; ++a)
#pragma unroll
        for (int b = 0; b < 2; ++b)
#pragma unroll
            for (int m = 0; m < 4; ++m)
#pragma unroll
                for (int n = 0; n < 2; ++n) acc[a][b][m][n] = (f32x4){0.f, 0.f, 0.f, 0.f};
    bf16x8 At[4][2], B0[2][2], B1[2][2];
    const PG8_GAS char* cA = (const PG8_GAS char*)g.A + (size_t)cur.pm * tstep; const PG8_GAS char* cB = (const PG8_GAS char*)g.Bt + (size_t)cur.pn * tstep;
    S.a_ready(cur);
    if constexpr (SP2) {
        PG8_STAGE(PG8_SB(0, 0), cB, voffB); PG8_STAGE(PG8_SB(0, 1), cB + hstep, voffB); PG8_STAGE(PG8_SA(0, 0), cA, voffA); PG8_STAGE(PG8_SA(0, 1), cA + hstep, voffA);
        if (wr == 1) PG8_BAR;
        PG8_WAIT_V(2); PG8_BAR;
        PG8_STAGE(PG8_SB(1, 0), cB + kstep, voffB); PG8_STAGE(PG8_SA(1, 0), cA + kstep, voffA); PG8_STAGE(PG8_SB(1, 1), cB + hstep + kstep, voffB);
        PG8_WAIT_V(6); PG8_BAR;
    } else {
        PG8_STAGE(PG8_SB(0, 0), cB, voffB); PG8_STAGE(PG8_SA(0, 0), cA, voffA); PG8_STAGE(PG8_SB(0, 1), cB + hstep, voffB); PG8_STAGE(PG8_SA(0, 1), cA + hstep, voffA);
        if (wr == 1) PG8_BAR;
        PG8_WAIT_V(4); PG8_BAR;
        PG8_STAGE(PG8_SB(1, 0), cB + kstep, voffB); PG8_STAGE(PG8_SA(1, 0), cA + kstep, voffA); PG8_STAGE(PG8_SB(1, 1), cB + hstep + kstep, voffB);
        PG8_WAIT_V(6); PG8_BAR;
    }
    for (;;) {
        const bool has_next = S.next(ui + 1, nxt);
        const PG8_GAS char* nA = has_next ? (const PG8_GAS char*)g.A + (size_t)nxt.pm * tstep : cA; const PG8_GAS char* nB = has_next ? (const PG8_GAS char*)g.Bt + (size_t)nxt.pn * tstep : cB;
        for (int t = 0; t < nt; t += 2) {
            const bool last = (t == nt - 2);
            const PG8_GAS char* a1 = cA + (size_t)(t + 1) * kstep;
            const PG8_GAS char* a2 = last ? nA : cA + (size_t)(t + 2) * kstep; const PG8_GAS char* b2 = last ? nB : cB + (size_t)(t + 2) * kstep;
            const PG8_GAS char* a3 = a2 + kstep; const PG8_GAS char* b3 = b2 + kstep;
            if (last && has_next) S.a_ready(nxt);
            if constexpr (SP2) {
            PG8_LDB(B0, 0, 0); PG8_LDB(B1, 0, 1); PG8_SCHED; PG8_LDA(At, 0, 0); PG8_STAGE(PG8_SA(1, 1), a1 + hstep, voffA);
            PG8_WAIT_V(8); PG8_WAIT_L(0); PG8_BAR; PG8_MMA(0, 0, At, B0); PG8_MMA(0, 1, At, B1); PG8_BAR; PG8_SCHED;
            PG8_LDA(At, 0, 1); PG8_STAGE(PG8_SB(0, 0), b2, voffB); PG8_STAGE(PG8_SB(0, 1), b2 + hstep, voffB); PG8_STAGE(PG8_SA(0, 0), a2, voffA);
            PG8_WAIT_V(8); PG8_WAIT_L(0); PG8_BAR; PG8_MMA(1, 0, At, B0); PG8_MMA(1, 1, At, B1); PG8_BAR; PG8_SCHED;
            PG8_LDB(B0, 1, 0); PG8_LDB(B1, 1, 1); PG8_SCHED; PG8_LDA(At, 1, 0); PG8_STAGE(PG8_SA(0, 1), a2 + hstep, voffA);
            PG8_WAIT_V(8); PG8_WAIT_L(0); PG8_BAR; PG8_MMA(0, 0, At, B0); PG8_MMA(0, 1, At, B1); PG8_BAR; PG8_SCHED;
            PG8_LDA(At, 1, 1); PG8_STAGE(PG8_SB(1, 0), b3, voffB); PG8_STAGE(PG8_SB(1, 1), b3 + hstep, voffB); PG8_STAGE(PG8_SA(1, 0), a3, voffA);
            PG8_WAIT_V(8); PG8_WAIT_L(0); PG8_BAR; PG8_MMA(1, 0, At, B0); PG8_MMA(1, 1, At, B1); PG8_BAR; PG8_SCHED;
            } else {
            PG8_LDB(B0, 0, 0); PG8_SCHED; PG8_LDA(At, 0, 0); PG8_STAGE(PG8_SA(1, 1), a1 + hstep, voffA);
            PG8_WAIT_L(8); PG8_BAR; PG8_WAIT_L(0); PG8_MMA(0, 0, At, B0); PG8_BAR; PG8_SCHED;
            PG8_LDB(B1, 0, 1); PG8_STAGE(PG8_SB(0, 0), b2, voffB);
            PG8_BAR; PG8_WAIT_L(0); PG8_MMA(0, 1, At, B1); PG8_BAR;
            PG8_LDA(At, 0, 1); PG8_STAGE(PG8_SA(0, 0), a2, voffA);
            PG8_BAR; PG8_WAIT_L(0); PG8_MMA(1, 0, At, B0); PG8_BAR; PG8_SCHED;
            PG8_STAGE(PG8_SB(0, 1), b2 + hstep, voffB);
            PG8_WAIT_V(6); PG8_BAR; PG8_MMA(1, 1, At, B1); PG8_BAR;
            PG8_LDB(B0, 1, 0); PG8_SCHED; PG8_LDA(At, 1, 0); PG8_STAGE(PG8_SA(0, 1), a2 + hstep, voffA);
            PG8_WAIT_L(8); PG8_BAR; PG8_WAIT_L(0); PG8_MMA(0, 0, At, B0); PG8_BAR; PG8_SCHED;
            PG8_LDB(B1, 1, 1); PG8_STAGE(PG8_SB(1, 0), b3, voffB);
            PG8_BAR; PG8_WAIT_L(0); PG8_MMA(0, 1, At, B1); PG8_BAR;
            PG8_LDA(At, 1, 1); PG8_STAGE(PG8_SA(1, 0), a3, voffA);
            PG8_BAR; PG8_WAIT_L(0); PG8_MMA(1, 0, At, B0); PG8_BAR; PG8_SCHED;
            PG8_STAGE(PG8_SB(1, 1), b3 + hstep, voffB);
            PG8_WAIT_V(6); PG8_BAR; PG8_MMA(1, 1, At, B1); PG8_BAR;
            }
        }
        if constexpr (ALIGN_EPI) { if (wr == 0) PG8_BAR; }
        if constexpr (!Epi::AFTER_DRAIN) { E(acc, cur, wr, wc, fr, fq); S.done(cur); }
        if (!has_next) break;
#pragma unroll
        for (int a = 0; a < 2; ++a)
#pragma unroll
            for (int b = 0; b < 2; ++b)
#pragma unroll
                for (int m = 0; m < 4; ++m)
#pragma unroll
                    for (int n = 0; n < 2; ++n) acc[a][b][m][n] = (f32x4){0.f, 0.f, 0.f, 0.f};
        cur = nxt; cA = nA; cB = nB; ++ui;
        if constexpr (ALIGN_EPI) { if (wr == 1) PG8_BAR; }
    }
    PG8_WAIT_V(0);
    if constexpr (!ALIGN_EPI) { if (wr == 0) PG8_BAR; }
    PG8_BAR;
    if constexpr (Epi::AFTER_DRAIN) { E.fused(acc, cur, wr, wc, fr, fq, lds, wid, lane); S.done(cur); }
#undef PG8_SA
#undef PG8_SB
#undef PG8_STAGE
#undef PG8_LDA
#undef PG8_LDB
#undef PG8_MMA
#undef PG8_WAIT_V
#undef PG8_WAIT_L
#undef PG8_BAR
#undef PG8_SCHED
}
}
#define GAS __attribute__((address_space(1)))
#define LAS __attribute__((address_space(3)))
typedef unsigned short bf16;
typedef unsigned v4u __attribute__((ext_vector_type(4)));
typedef float f32x4 __attribute__((ext_vector_type(4)));
typedef short bf16x8 __attribute__((ext_vector_type(8)));
typedef GAS unsigned gu32;
typedef GAS unsigned long long gu64;
#define RLX_AGENT __ATOMIC_RELAXED, __HIP_MEMORY_SCOPE_AGENT
#define LDS_WAIT() asm volatile("s_waitcnt lgkmcnt(0)" ::: "memory")
#define VM_WAIT() asm volatile("s_waitcnt vmcnt(0)" ::: "memory")
__device__ __forceinline__ unsigned long long rt() { return __builtin_amdgcn_s_memrealtime(); }
__device__ __forceinline__ unsigned f2bf(float f) { unsigned u = __builtin_bit_cast(unsigned, f); return (u + 0x7fffu + ((u >> 16) & 1u)) >> 16; }
__device__ __forceinline__ unsigned pk2(float lo, float hi) { return f2bf(lo) | (f2bf(hi) << 16); }

#define XB_TMO      128
#define XB_XCNT(j)  (256  + 64 * (j))
#define XB_XSUB(j)  (1280 + 64 * (j))
#define XB_XGEN(j)  (2304 + 64 * (j))
#define XB_TOP      3328
#define XB_TOPGEN   3392
#define XCD_BAR_WORDS 3456
#define XB_SPIN_CAP (1u << 18)

__device__ __forceinline__ unsigned xb_ld(unsigned* p)              { return __hip_atomic_load(p, __ATOMIC_RELAXED, __HIP_MEMORY_SCOPE_AGENT); }
__device__ __forceinline__ unsigned xb_add(unsigned* p, unsigned v) { return __hip_atomic_fetch_add(p, v, __ATOMIC_RELAXED, __HIP_MEMORY_SCOPE_AGENT); }
__device__ __forceinline__ unsigned xb_xcc_id() { return (unsigned)__builtin_amdgcn_s_getreg((3 << 11) | 20) & 0xFu; }
#define XB_SPIN(cond, bar) do { unsigned _sp = 0; while (cond) { __builtin_amdgcn_s_sleep(1); \
    if ((++_sp & 255u) == 0u) { if (xb_ld(&(bar)[XB_TMO])) break; if (_sp > XB_SPIN_CAP) { atomicAdd(&(bar)[XB_TMO], 1u); break; } } } } while (0)

struct XcdBarrier {
    unsigned* bar; unsigned x;
    volatile LAS unsigned* st;
};

__device__ __forceinline__ XcdBarrier xcd_barrier_post(unsigned* bar, volatile LAS unsigned* st, const int tid) {
    XcdBarrier b; b.bar = bar; b.x = xb_xcc_id(); b.st = st;
    if (tid == 0) (void)xb_add(&bar[XB_XCNT(b.x)], 1u);
    return b;
}
__device__ __forceinline__ void xcd_barrier_complete(unsigned* bar, unsigned x, unsigned& nloc, unsigned& nx) {
    const unsigned G = gridDim.x * gridDim.y * gridDim.z;
    unsigned sum, cnt, mine, sp = 0u;
    for (;;) {
        sum = 0u; cnt = 0u; mine = 0u;
#pragma unroll
        for (unsigned j = 0; j < 16; ++j) { const unsigned c = xb_ld(&bar[XB_XCNT(j)]); sum += c; cnt += (c > 0u) ? 1u : 0u; mine = (j == x) ? c : mine; }
        if (sum == G) break;
        __builtin_amdgcn_s_sleep(1);
        if ((++sp & 255u) == 0u) { if (xb_ld(&bar[XB_TMO])) break; if (sp > XB_SPIN_CAP) { atomicAdd(&bar[XB_TMO], 1u); break; } }
    }
    nloc = mine > 0u ? mine : 1u; nx = cnt > 0u ? cnt : 1u;
}

__device__ __forceinline__ void xcd_barrier(const XcdBarrier& b, const int tid) {
    asm volatile("s_waitcnt vmcnt(0)" ::: "memory");
    __syncthreads();
    if (tid == 0) {
        unsigned* bar = b.bar;
        __builtin_amdgcn_s_waitcnt(0);
        unsigned nloc = b.st[0], nx = b.st[1];
        if (nloc == 0u) { xcd_barrier_complete(bar, b.x, nloc, nx); b.st[0] = nloc; b.st[1] = nx; }
        const unsigned old = xb_add(&bar[XB_XSUB(b.x)], 1u);
        const unsigned gen = old / nloc;
        if (old + 1u == (gen + 1u) * nloc) {
            __builtin_amdgcn_fence(__ATOMIC_RELEASE, "agent");
            asm volatile("s_waitcnt vmcnt(0)" ::: "memory");
            const unsigned og = xb_add(&bar[XB_TOP], 1u);
            const unsigned tg = og / nx;
            if (og + 1u == (tg + 1u) * nx) xb_add(&bar[XB_TOPGEN], 1u);
            else XB_SPIN(xb_ld(&bar[XB_TOPGEN]) == tg, bar);
            __builtin_amdgcn_fence(__ATOMIC_ACQUIRE, "agent");
            xb_add(&bar[XB_XGEN(b.x)], 1u);
            asm volatile("s_waitcnt vmcnt(0)" ::: "memory");
        } else {
            XB_SPIN(xb_ld(&bar[XB_XGEN(b.x)]) == gen, bar);
            __builtin_amdgcn_fence(__ATOMIC_ACQUIRE, "agent");
            asm volatile("s_waitcnt vmcnt(0)" ::: "memory");
        }
    }
    __syncthreads();
}
constexpr int BATCH = 2, SEQ = 4096, DM = 2048, DEPTH = 4, MTOK = BATCH * SEQ;
constexpr int HD = 64, RH = 12, AH = 12, GGRP = 8, RWID = 768, AWID = 768, GWID = 512;
constexpr int RCOLS = 2560, ACOLS = 2304, GCOLS = 1024, INCOLS = 5888, DFF = 5632, UPN = 2 * DFF;
constexpr int QOFF = RCOLS, KOFF = RCOLS + AWID, VOFF = RCOLS + 2 * AWID, GOFF = RCOLS + ACOLS;
constexpr int TCH = 64, NCH = SEQ / TCH;
constexpr int NTASK_SCAN = BATCH * RH * NCH;
constexpr float NORM_EPS = 1e-6f, GN_EPS = 1e-5f, RWKV_LN_EPS = 64e-5f;
constexpr float DECAY_SCALE = 0.6065306597126334f;
constexpr int NWAVES = 8, NTHR = NWAVES * 64;

constexpr size_t MiB = 1u << 20;
constexpr size_t WS_CTL = 0, CTL_ZERO_BYTES = 1 * MiB;
constexpr size_t WS_WIN = 2 * MiB, WS_WOUT = 94 * MiB, WS_WUP = 126 * MiB, WS_WDN = 302 * MiB;
constexpr size_t WS_HN = 390 * MiB, WS_Y = 422 * MiB, WS_O = 454 * MiB;
constexpr size_t WS_REG = 518 * MiB;
constexpr size_t WS_PROJ = WS_REG;
constexpr size_t WS_RW = WS_REG + 92 * MiB;
constexpr size_t WS_CHK = WS_RW + 216 * MiB;
constexpr size_t WS_QKR = WS_CHK + 72 * MiB;
constexpr size_t WS_AO = WS_QKR + 24 * MiB;
constexpr size_t WS_LSE = WS_AO + 72 * MiB;
constexpr size_t WS_SGU = WS_LSE + 2 * MiB;
constexpr size_t WS_BON = WS_SGU + 32 * MiB;
constexpr size_t WS_END_MIX = WS_BON + 1 * MiB;
constexpr size_t WS_UP = WS_REG;
constexpr size_t WS_H = WS_REG + 176 * MiB;
constexpr size_t WS_END = WS_END_MIX;
static_assert(WS_H + 88 * MiB <= WS_END, "map");
constexpr int CW_BAR = 4096, CW_ATT = 8192;

constexpr int RING_BYTES = 131072, LDSCTL_OFF = RING_BYTES, MISC_OFF = LDSCTL_OFF + 320, LDS_BYTES = 147456;

struct Params { const float* in[29]; float* out; unsigned char* ws; };

typedef const GAS float* gcf; typedef GAS float* gfp; typedef const GAS bf16* gcb; typedef GAS bf16* gbp; typedef const GAS int* gci;
__device__ __forceinline__ float bf2f(unsigned short u) { return __builtin_bit_cast(float, (unsigned)u << 16); }
__device__ __forceinline__ float bflo(unsigned u) { return __builtin_bit_cast(float, u << 16); }
__device__ __forceinline__ float bfhi(unsigned u) { return __builtin_bit_cast(float, u & 0xffff0000u); }
__device__ __forceinline__ float wave_sum(float v) {
#pragma unroll
    for (int o = 1; o < 64; o <<= 1) v += __shfl_xor(v, o);
    return v;
}
__device__ __forceinline__ float wave_max(float v) {
#pragma unroll
    for (int o = 1; o < 64; o <<= 1) v = fmaxf(v, __shfl_xor(v, o));
    return v;
}
__device__ __forceinline__ float sigmoidf_(float x) { return 1.f / (1.f + __expf(-x)); }
__device__ __forceinline__ float gelu_tanh(float x) { const float u = 0.7978845608028654f * (x + 0.044715f * x * x * x); return 0.5f * x * (1.f + tanhf(u)); }

typedef float f32x16 __attribute__((ext_vector_type(16)));
typedef float f32x2_t __attribute__((ext_vector_type(2))); typedef __bf16 bf16x2_t __attribute__((ext_vector_type(2)));
typedef short s16x4 __attribute__((ext_vector_type(4)));
__device__ __forceinline__ unsigned cvtpk(float lo, float hi) { f32x2_t v = {lo, hi}; bf16x2_t b = __builtin_convertvector(v, bf16x2_t); return __builtin_bit_cast(unsigned, b); }
__device__ __forceinline__ bf16x8 pack8(float a0, float a1, float a2, float a3, float a4, float a5, float a6, float a7) { v4u p; p.x = cvtpk(a0, a1); p.y = cvtpk(a2, a3); p.z = cvtpk(a4, a5); p.w = cvtpk(a6, a7); return __builtin_bit_cast(bf16x8, p); }
#define MFMA32(a, b, c) __builtin_amdgcn_mfma_f32_32x32x16_bf16((a), (b), (c), 0, 0, 0)
__device__ __forceinline__ int crow(int reg, int h) { return (reg & 3) + 8 * (reg >> 2) + 4 * h; }

__device__ __forceinline__ void p0_transpose_item(gcf W, int K, int N, gbp WT, int row_off, LAS float* scr, int item, int lane) {
    const int nblk = N / 32, kb = item / nblk, nb = item % nblk, k0 = 64 * kb, n0 = 32 * nb;
#pragma unroll 8
    for (int i = 0; i < 32; ++i) { const int kk = 2 * i + (lane >> 5); scr[kk * 33 + (lane & 31)] = W[(size_t)(k0 + kk) * N + n0 + (lane & 31)]; }
    LDS_WAIT(); asm volatile("" ::: "memory");
    const int c = lane & 7;
#pragma unroll
    for (int j = 0; j < 4; ++j) { const int n = (lane >> 3) + 8 * j; const LAS float* s = scr + (8 * c) * 33 + n;
        v4u o; o.x = pk2(s[0 * 33], s[1 * 33]); o.y = pk2(s[2 * 33], s[3 * 33]); o.z = pk2(s[4 * 33], s[5 * 33]); o.w = pk2(s[6 * 33], s[7 * 33]);
        *(GAS v4u*)(WT + (size_t)(row_off + n0 + n) * K + k0 + 8 * c) = o; }
    LDS_WAIT(); asm volatile("" ::: "memory");
}

__device__ __forceinline__ void rowpass(gcf xin, gcf delta, gcf gpost, gfp xout, gcf gnext, gbp hn, int gw, int ngw, int lane) {
    for (int m = gw; m < MTOK; m += ngw) {
        const GAS f32x4* xr = (const GAS f32x4*)(xin + (size_t)m * DM) + lane;
        f32x4 xv[8];
#pragma unroll
        for (int j = 0; j < 8; ++j) xv[j] = xr[64 * j];
        if (delta) {
            const GAS f32x4* dr = (const GAS f32x4*)(delta + (size_t)m * DM) + lane;
            f32x4 dv[8]; float ss = 0.f;
#pragma unroll
            for (int j = 0; j < 8; ++j) { dv[j] = dr[64 * j]; ss += dv[j].x * dv[j].x + dv[j].y * dv[j].y + dv[j].z * dv[j].z + dv[j].w * dv[j].w; }
            const float rstd = rsqrtf(wave_sum(ss) * (1.f / DM) + NORM_EPS);
            GAS f32x4* xo = (GAS f32x4*)(xout + (size_t)m * DM) + lane;
#pragma unroll
            for (int j = 0; j < 8; ++j) { const f32x4 g = ((const GAS f32x4*)gpost)[lane + 64 * j]; xv[j] = xv[j] + dv[j] * rstd * g; xo[64 * j] = xv[j]; }
        }
        if (gnext) {
            float ss = 0.f;
#pragma unroll
            for (int j = 0; j < 8; ++j) ss += xv[j].x * xv[j].x + xv[j].y * xv[j].y + xv[j].z * xv[j].z + xv[j].w * xv[j].w;
            const float rstd = rsqrtf(wave_sum(ss) * (1.f / DM) + NORM_EPS);
            GAS unsigned long long* o8 = (GAS unsigned long long*)(hn + (size_t)m * DM) + lane;
#pragma unroll
            for (int j = 0; j < 8; ++j) { const f32x4 g = ((const GAS f32x4*)gnext)[lane + 64 * j]; const f32x4 v = xv[j] * rstd * g;
                o8[64 * j] = (unsigned long long)pk2(v.x, v.y) | ((unsigned long long)pk2(v.z, v.w) << 32); }
        }
    }
}

struct PrepW { gcf mu, w0, w2, a0, a2, g2, kk_, ka_, rk, sgu_g, sgu_b; gci pos; };
__device__ __forceinline__ void prep_token(int tok, gcb PROJ, const PrepW& w, gfp RWb, gfp BON, gbp QKR, gfp SU, gfp SVN, LAS float* pp, int lane) {
    const int t = tok % SEQ;
    gcb prow = PROJ + (size_t)tok * INCOLS;
    constexpr size_t AS = (size_t)MTOK * RWID;
    gfp R = RWb; gfp Wd = RWb + AS; gfp K2 = RWb + 2 * AS; gfp V = RWb + 3 * AS; gfp KK = RWb + 4 * AS; gfp KKA = RWb + 5 * AS; gfp Gt = RWb + 6 * AS;
#pragma unroll 4
    for (int i = 0; i < 40; ++i) { const int c = lane + 64 * i; const float p = bf2f(prow[c]); const float q = t > 0 ? bf2f(prow[c - INCOLS]) : 0.f; pp[c] = p + (q - p) * w.mu[c]; }
    LAS float* lw = pp + 2560; LAS float* la = pp + 2624; LAS float* lg = pp + 2688;
    lw[lane] = tanhf(pp[2304 + lane]); la[lane] = pp[2368 + lane]; lg[lane] = sigmoidf_(pp[2432 + lane]); lg[64 + lane] = sigmoidf_(pp[2496 + lane]);
    float dw[12], da[12], dg[12];
#pragma unroll
    for (int i = 0; i < 12; ++i) { dw[i] = 0.f; da[i] = 0.f; dg[i] = 0.f; }
    for (int j = 0; j < 64; ++j) { const float xw = lw[j], xa = la[j];
#pragma unroll
        for (int i = 0; i < 12; ++i) { dw[i] += xw * w.w2[j * RWID + lane + 64 * i]; da[i] += xa * w.a2[j * RWID + lane + 64 * i]; } }
    for (int j = 0; j < 128; ++j) { const float xg = lg[j];
#pragma unroll
        for (int i = 0; i < 12; ++i) dg[i] += xg * w.g2[j * RWID + lane + 64 * i]; }
#pragma unroll
    for (int i = 0; i < 12; ++i) { const int n = lane + 64 * i;
        const float r = pp[n], k = pp[768 + n], v = pp[1536 + n];
        const float decay = __expf(-DECAY_SCALE * sigmoidf_(w.w0[n] + dw[i]));
        const float a = sigmoidf_(w.a0[n] + da[i]);
        const float kkr = k * w.kk_[n];
        const float ss = wave_sum(kkr * kkr);
        const float kk = kkr / fmaxf(sqrtf(ss), 1e-12f);
        const float k2 = k * (1.f + (a - 1.f) * w.ka_[n]);
        const float bon = wave_sum(r * k2 * w.rk[n]);
        const size_t o = (size_t)tok * RWID + n;
        R[o] = r; Wd[o] = decay; K2[o] = k2; V[o] = v; KK[o] = kk; KKA[o] = kk * a; Gt[o] = dg[i];
        if (lane == 0) BON[tok * 12 + i] = bon; }
    {
        float cs = 1.f, sn = 0.f;
        if (lane < 16) { const int f = lane & 7; const float inv = exp2f(-(float)f * (18.931568569324174f / 8.f)); const float ang = (float)w.pos[tok] * inv; cs = cosf(ang); sn = sinf(ang); }
#pragma unroll 4
        for (int i = 0; i < 24; ++i) { const int c = lane + 64 * i; float x = bf2f(prow[QOFF + c]);
            if (lane < 16) { const float oth = bf2f(prow[QOFF + c + (lane < 8 ? 8 : -8)]); x = lane < 8 ? x * cs - oth * sn : x * cs + oth * sn; }
            if (i < 12) x *= 0.18033688011112042f;
            QKR[(size_t)tok * 1536 + c] = (bf16)f2bf(x); }
    }
#pragma unroll 4
    for (int i = 0; i < 16; ++i) { const int c = lane + 64 * i; const float z = gelu_tanh(bf2f(prow[GOFF + c]));
        if (i < 8) SU[(size_t)tok * GWID + c] = z;
        else { const int g = i - 8; const float mu = wave_sum(z) * (1.f / 64.f); const float d = z - mu; const float var = wave_sum(d * d) * (1.f / 64.f);
            SVN[(size_t)tok * GWID + g * 64 + lane] = d * rsqrtf(var + GN_EPS) * w.sgu_g[g * 64 + lane] + w.sgu_b[g * 64 + lane]; } }
}

template <bool IDN>
__device__ __forceinline__ void scan_chunk(int task, gcf RWb, gfp OUTV  , gfp OUTM  , LAS float* ops, int lane) {
    constexpr unsigned AS = (unsigned)MTOK * RWID;
    gcf R = RWb; gcf Wd = RWb + AS; gcf K2 = RWb + 2 * AS; gcf V = RWb + 3 * AS; gcf KK = RWb + 4 * AS; gcf KKA = RWb + 5 * AS;
    const int bh = task / NCH, c = task % NCH, b = bh / RH, h = bh % RH;
    const unsigned base = (unsigned)((b * SEQ + c * TCH) * RWID + h * 64 + lane);
    float st[64];
#pragma unroll
    for (int k = 0; k < 64; ++k) st[k] = (IDN && k == lane) ? 1.f : 0.f;
    float nw = Wd[base], nkk = KK[base], nka = KKA[base], nk = IDN ? 0.f : K2[base], nr = R[base], nv = IDN ? 0.f : V[base];
    for (int i = 0; i < TCH; ++i) {
        LAS float* ob = ops + (i & 1) * 320;
        ob[lane] = nw; ob[64 + lane] = nkk; ob[128 + lane] = nka; if (!IDN) ob[192 + lane] = nk; ob[256 + lane] = nr;
        const float vcur = nv;
        if (i + 1 < TCH) { const unsigned o = base + (unsigned)(i + 1) * RWID; nw = Wd[o]; nkk = KK[o]; nka = KKA[o]; nr = R[o]; if (!IDN) { nk = K2[o]; nv = V[o]; } }
        const LAS f32x4* o4 = (const LAS f32x4*)ob;
        float sk = 0.f;
#pragma unroll
        for (int k4 = 0; k4 < 16; ++k4) { const f32x4 q = o4[16 + k4];
            sk += st[4 * k4] * q.x + st[4 * k4 + 1] * q.y + st[4 * k4 + 2] * q.z + st[4 * k4 + 3] * q.w; }
        float y = 0.f;
#pragma unroll
        for (int k4 = 0; k4 < 16; ++k4) { const f32x4 w4 = o4[k4], a4 = o4[32 + k4], r4 = o4[64 + k4]; f32x4 kv = {0.f, 0.f, 0.f, 0.f}; if (!IDN) kv = o4[48 + k4];
#pragma unroll
            for (int j = 0; j < 4; ++j) { const int k = 4 * k4 + j;
                if (IDN) st[k] = st[k] * w4[j] - sk * a4[j]; else st[k] = st[k] * w4[j] - sk * a4[j] + vcur * kv[j];
                y += st[k] * r4[j]; } }
        OUTV[base + (unsigned)i * RWID] = y;
    }
    if (IDN) { gbp om = (gbp)OUTM + (unsigned)(task * 4096 + lane);
#pragma unroll
        for (int k = 0; k < 64; ++k) om[k * 64] = (bf16)f2bf(st[k]); }
    else { gfp om = OUTM + (unsigned)(task * 4096 + lane);
#pragma unroll
        for (int k = 0; k < 64; ++k) om[k * 64] = st[k]; }
}

__device__ __forceinline__ void scan_carry_mfma(int bh, int vt, gcb PT, gcf SLT, gfp SST, int lane) {
    const int r = lane & 31, h = lane >> 5;
    f32x16 acc[2];
#pragma unroll
    for (int i = 0; i < 16; ++i) { acc[0][i] = 0.f; acc[1][i] = 0.f; }
    s16x4 pa[2][2][2][2]; f32x16 sl[2];
    {   const unsigned tb = (unsigned)(bh * NCH) * 4096u;
#pragma unroll
        for (int mt = 0; mt < 2; ++mt) {
#pragma unroll
            for (int kt = 0; kt < 2; ++kt)
#pragma unroll
                for (int sx = 0; sx < 2; ++sx) { gcb pr = PT + tb + (unsigned)((32 * mt + r) * 64 + 32 * kt + 16 * sx + 4 * h); pa[mt][kt][sx][0] = *(const GAS s16x4*)pr; pa[mt][kt][sx][1] = *(const GAS s16x4*)(pr + 8); }
#pragma unroll
            for (int i = 0; i < 16; ++i) sl[mt][i] = SLT[tb + (unsigned)((32 * mt + crow(i, h)) * 64 + 32 * vt + r)]; } }
    for (int c = 0; c < NCH; ++c) {
        const unsigned tb = (unsigned)(bh * NCH + c) * 4096u;
#pragma unroll
        for (int mt = 0; mt < 2; ++mt)
#pragma unroll
            for (int g = 0; g < 4; ++g) { const f32x4 v = {acc[mt][4 * g], acc[mt][4 * g + 1], acc[mt][4 * g + 2], acc[mt][4 * g + 3]};
                *(GAS f32x4*)(SST + tb + (unsigned)((32 * vt + r) * 64 + 32 * mt + 8 * g + 4 * h)) = v; }
        if (c == NCH - 1) break;
        bf16x8 bfr[2][2], afr[2][2][2];
#pragma unroll
        for (int kt = 0; kt < 2; ++kt)
#pragma unroll
            for (int sx = 0; sx < 2; ++sx) bfr[kt][sx] = pack8(acc[kt][8 * sx], acc[kt][8 * sx + 1], acc[kt][8 * sx + 2], acc[kt][8 * sx + 3], acc[kt][8 * sx + 4], acc[kt][8 * sx + 5], acc[kt][8 * sx + 6], acc[kt][8 * sx + 7]);
#pragma unroll
        for (int mt = 0; mt < 2; ++mt) { acc[mt] = sl[mt];
#pragma unroll
            for (int kt = 0; kt < 2; ++kt)
#pragma unroll
                for (int sx = 0; sx < 2; ++sx) afr[mt][kt][sx] = __builtin_shufflevector(pa[mt][kt][sx][0], pa[mt][kt][sx][1], 0, 1, 2, 3, 4, 5, 6, 7); }
        if (c + 1 < NCH - 1) { const unsigned tn = tb + 4096u;
#pragma unroll
            for (int mt = 0; mt < 2; ++mt) {
#pragma unroll
                for (int kt = 0; kt < 2; ++kt)
#pragma unroll
                    for (int sx = 0; sx < 2; ++sx) { gcb pr = PT + tn + (unsigned)((32 * mt + r) * 64 + 32 * kt + 16 * sx + 4 * h); pa[mt][kt][sx][0] = *(const GAS s16x4*)pr; pa[mt][kt][sx][1] = *(const GAS s16x4*)(pr + 8); }
#pragma unroll
                for (int i = 0; i < 16; ++i) sl[mt][i] = SLT[tn + (unsigned)((32 * mt + crow(i, h)) * 64 + 32 * vt + r)]; } }
#pragma unroll
        for (int mt = 0; mt < 2; ++mt)
#pragma unroll
            for (int kt = 0; kt < 2; ++kt)
#pragma unroll
                for (int sx = 0; sx < 2; ++sx) acc[mt] = MFMA32(afr[mt][kt][sx], bfr[kt][sx], acc[mt]);
    }
}

__device__ __forceinline__ void scan_out(int task, gcf RWb, gcf YL, gcf Z, gcf SST, gcf BON, gcf ln_g, gcf ln_b, gbp Y, LAS float* zb, int lane) {
    constexpr size_t AS = (size_t)MTOK * RWID;
    gcf V = RWb + 3 * AS; gcf Gt = RWb + 6 * AS;
    const int bh = task / NCH, c = task % NCH, b = bh / RH, h = bh % RH;
    const int tok0 = b * SEQ + c * TCH; const int n = h * 64 + lane;
    float S[64];
#pragma unroll
    for (int k4 = 0; k4 < 16; ++k4) { const f32x4 q = *(const GAS f32x4*)(SST + (unsigned)(task * 4096 + lane * 64 + 4 * k4)); S[4 * k4] = q.x; S[4 * k4 + 1] = q.y; S[4 * k4 + 2] = q.z; S[4 * k4 + 3] = q.w; }
    const float lg = ln_g[n], lb = ln_b[n];
    for (int i = 0; i < TCH; ++i) { const int tok = tok0 + i; const size_t o = (size_t)tok * RWID + n;
        zb[(i & 1) * 64 + lane] = Z[o];
        float y = YL[o];
#pragma unroll
        for (int k4 = 0; k4 < 16; ++k4) { const f32x4 q = ((const LAS f32x4*)(zb + (i & 1) * 64))[k4];
            y += S[4 * k4] * q.x + S[4 * k4 + 1] * q.y + S[4 * k4 + 2] * q.z + S[4 * k4 + 3] * q.w; }
        const float mu = wave_sum(y) * (1.f / 64.f); const float d = y - mu; const float var = wave_sum(d * d) * (1.f / 64.f);
        float yn = d * rsqrtf(var + RWKV_LN_EPS) * lg + lb;
        yn += BON[tok * 12 + h] * V[o];
        Y[(size_t)tok * DM + n] = (bf16)f2bf(yn * Gt[o]); }
}

constexpr int ATT_UNITS_PER_BH = 48, ATT_UNITS = BATCH * AH * ATT_UNITS_PER_BH, ATT_KROW = 144, ATT_VROW = 776, ATT_VOFF = 384 * ATT_KROW;
__device__ __forceinline__ void attn_unit(int unit, gcb QKR, gcb PROJ, gfp AOP, gfp LSE, LAS unsigned char* lds, int tid, int wave, int lane) {
    const int bh = unit / ATT_UNITS_PER_BH, uu = unit % ATT_UNITS_PER_BH, b = bh / AH, h = bh % AH;
    int p, d, rho, qb;
    if (uu < 16) { p = 0; d = 1; rho = 0; qb = uu; } else if (uu < 32) { p = 1; d = 4; rho = (uu - 16) >> 2; qb = (uu - 16) & 3; } else { p = 2; d = 16; rho = uu - 32; qb = 0; }
    const int i0 = qb * 256;
    LAS unsigned char* Kl = lds; LAS unsigned char* Vl = lds + ATT_VOFF;
#pragma unroll
    for (int it = 0; it < 6; ++it) { const int idx = tid + 512 * it, key = idx % 384, piece = idx / 384; const int ki = i0 - 128 + key;
        v4u kv = {0u, 0u, 0u, 0u}, vv = {0u, 0u, 0u, 0u};
        if (ki >= 0) { const unsigned tokk = (unsigned)(b * SEQ + rho + d * ki);
            kv = *(const GAS v4u*)(QKR + tokk * 1536u + 768u + (unsigned)(h * 64 + piece * 8));
            vv = *(const GAS v4u*)(PROJ + (size_t)tokk * INCOLS + VOFF + h * 64 + piece * 8); }
        *(LAS v4u*)(Kl + key * ATT_KROW + piece * 16) = kv;
        LAS unsigned short* vd = (LAS unsigned short*)(Vl + (piece * 8) * ATT_VROW + key * 2);
        vd[0 * (ATT_VROW / 2)] = (unsigned short)(vv.x & 0xffffu); vd[1 * (ATT_VROW / 2)] = (unsigned short)(vv.x >> 16);
        vd[2 * (ATT_VROW / 2)] = (unsigned short)(vv.y & 0xffffu); vd[3 * (ATT_VROW / 2)] = (unsigned short)(vv.y >> 16);
        vd[4 * (ATT_VROW / 2)] = (unsigned short)(vv.z & 0xffffu); vd[5 * (ATT_VROW / 2)] = (unsigned short)(vv.z >> 16);
        vd[6 * (ATT_VROW / 2)] = (unsigned short)(vv.w & 0xffffu); vd[7 * (ATT_VROW / 2)] = (unsigned short)(vv.w >> 16); }
    __syncthreads();
    const int r = lane & 31, hh = lane >> 5;
    const int iq0 = i0 + 32 * wave;
    const unsigned tokq = (unsigned)(b * SEQ + rho + d * (iq0 + r));
    bf16x8 qf[4];
#pragma unroll
    for (int sx = 0; sx < 4; ++sx) qf[sx] = *(const GAS bf16x8*)(QKR + tokq * 1536u + (unsigned)(h * 64 + 16 * sx + 8 * hh));
    float m = -1e30f, l = 0.f;
    f32x16 o[2];
#pragma unroll
    for (int i = 0; i < 16; ++i) { o[0][i] = 0.f; o[1][i] = 0.f; }
#pragma unroll
    for (int j = 0; j < 5; ++j) {
        const int kk0 = 32 * wave + 32 * j, kabs0 = iq0 - 128 + 32 * j;
        if (kabs0 + 31 < 0) continue;
        f32x16 st;
#pragma unroll
        for (int i = 0; i < 16; ++i) st[i] = 0.f;
#pragma unroll
        for (int sx = 0; sx < 4; ++sx) { const bf16x8 a = *(const LAS bf16x8*)(Kl + (kk0 + r) * ATT_KROW + (16 * sx + 8 * hh) * 2); st = MFMA32(a, qf[sx], st); }
        bool ok[16]; float tmax = -1e30f;
#pragma unroll
        for (int i = 0; i < 16; ++i) { const int row = crow(i, hh); ok[i] = (kabs0 + row >= 0) && (j != 0 || row >= r) && (j != 4 || row <= r); tmax = fmaxf(tmax, ok[i] ? st[i] : -1e30f); }
        tmax = fmaxf(tmax, __shfl_xor(tmax, 32));
        const float mnew = fmaxf(m, tmax), alpha = exp2f(m - mnew);
        float pr[16], ps = 0.f;
#pragma unroll
        for (int i = 0; i < 16; ++i) { pr[i] = ok[i] ? exp2f(st[i] - mnew) : 0.f; ps += pr[i]; }
        l = l * alpha + ps; m = mnew;
#pragma unroll
        for (int i = 0; i < 16; ++i) { o[0][i] *= alpha; o[1][i] *= alpha; }
#pragma unroll
        for (int s2 = 0; s2 < 2; ++s2) { const bf16x8 bfrag = pack8(pr[8 * s2], pr[8 * s2 + 1], pr[8 * s2 + 2], pr[8 * s2 + 3], pr[8 * s2 + 4], pr[8 * s2 + 5], pr[8 * s2 + 6], pr[8 * s2 + 7]);
#pragma unroll
            for (int mt = 0; mt < 2; ++mt) { const LAS unsigned char* ap = Vl + (32 * mt + r) * ATT_VROW + (kk0 + 16 * s2 + 4 * hh) * 2;
                const s16x4 lo = *(const LAS s16x4*)ap, hi = *(const LAS s16x4*)(ap + 16);
                const bf16x8 a = __builtin_shufflevector(lo, hi, 0, 1, 2, 3, 4, 5, 6, 7);
                o[mt] = MFMA32(a, bfrag, o[mt]); } }
    }
    const float ltot = l + __shfl_xor(l, 32), inv = 1.f / ltot;
    gfp op = AOP + (size_t)p * MTOK * AWID + (size_t)tokq * AWID + h * 64;
#pragma unroll
    for (int mt = 0; mt < 2; ++mt)
#pragma unroll
        for (int g = 0; g < 4; ++g) { const f32x4 v = {o[mt][4 * g] * inv, o[mt][4 * g + 1] * inv, o[mt][4 * g + 2] * inv, o[mt][4 * g + 3] * inv};
            *(GAS f32x4*)(op + 32 * mt + 8 * g + 4 * hh) = v; }
    if (hh == 0) LSE[(size_t)p * MTOK * AH + tokq * AH + h] = (m + log2f(ltot)) * 0.6931471805599453f;
    __syncthreads();
}

__device__ __forceinline__ void attn_norm_token(int tok, gcf AOP, gcf LSE, gcf g, gbp Y, int lane) {
    float v[12], ss = 0.f;
#pragma unroll
    for (int i = 0; i < 12; ++i) { const float l0 = LSE[(size_t)tok * AH + i], l1 = LSE[(size_t)MTOK * AH + (size_t)tok * AH + i], l2 = LSE[2 * (size_t)MTOK * AH + (size_t)tok * AH + i];
        const float mx = fmaxf(fmaxf(l0, l1), l2), w0 = __expf(l0 - mx), w1 = __expf(l1 - mx), w2 = __expf(l2 - mx);
        const size_t o = (size_t)tok * AWID + lane + 64 * i;
        v[i] = (w0 * AOP[o] + w1 * AOP[(size_t)MTOK * AWID + o] + w2 * AOP[2 * (size_t)MTOK * AWID + o]) / (w0 + w1 + w2); ss += v[i] * v[i]; }
    const float rstd = rsqrtf(wave_sum(ss) * (1.f / AWID) + NORM_EPS);
#pragma unroll
    for (int i = 0; i < 12; ++i) Y[(size_t)tok * DM + RWID + lane + 64 * i] = (bf16)f2bf(v[i] * rstd * g[lane + 64 * i]);
}

__device__ __forceinline__ void sgu_token(int tok, gcf SU, gcf SVN, gcf ws  , gcf bs  , gcf ng, gbp Y, int lane) {
    const int i = tok % 128; const int tok0 = tok - i;
    float q[8], ss = 0.f;
#pragma unroll
    for (int g = 0; g < 8; ++g) { float acc = 0.f; gcf wr = ws + ((size_t)g * 128 + i) * 128; gcf vp = SVN + (size_t)tok0 * GWID + g * 64 + lane;
        for (int j = 0; j <= i; ++j) acc += wr[j] * vp[(size_t)j * GWID];
        const float vo = acc + bs[g * 128 + i]; q[g] = SU[(size_t)tok * GWID + g * 64 + lane] * vo; ss += q[g] * q[g]; }
    const float rstd = rsqrtf(wave_sum(ss) * (1.f / GWID) + NORM_EPS);
#pragma unroll
    for (int g = 0; g < 8; ++g) Y[(size_t)tok * DM + RWID + AWID + g * 64 + lane] = (bf16)f2bf(q[g] * rstd * ng[g * 64 + lane]);
}

__device__ __forceinline__ void conv_item(int item, gcb UP, gcf cw, gcf cb, gbp H) {
    const int tok = item / (DFF / 8), j8 = (item % (DFF / 8)) * 8, t = tok % SEQ;
    float gt[8], vl[8];
#pragma unroll
    for (int e = 0; e < 8; ++e) { gt[e] = cb[j8 + e]; vl[e] = cb[DFF + j8 + e]; }
#pragma unroll
    for (int tap = 0; tap < 3; ++tap) { const int dt = 2 - tap;
        if (t - dt >= 0) { gcb ur = UP + (size_t)(tok - dt) * UPN; const v4u ug = *(const GAS v4u*)(ur + j8), uv = *(const GAS v4u*)(ur + DFF + j8);
            gcf wg = cw + (size_t)tap * UPN + j8; gcf wv = wg + DFF;
            const unsigned a[4] = {ug.x, ug.y, ug.z, ug.w}, c[4] = {uv.x, uv.y, uv.z, uv.w};
#pragma unroll
            for (int e = 0; e < 4; ++e) { gt[2 * e] += bflo(a[e]) * wg[2 * e]; gt[2 * e + 1] += bfhi(a[e]) * wg[2 * e + 1]; vl[2 * e] += bflo(c[e]) * wv[2 * e]; vl[2 * e + 1] += bfhi(c[e]) * wv[2 * e + 1]; } } }
    v4u o; o.x = pk2(gelu_tanh(gt[0]) * vl[0], gelu_tanh(gt[1]) * vl[1]); o.y = pk2(gelu_tanh(gt[2]) * vl[2], gelu_tanh(gt[3]) * vl[3]);
    o.z = pk2(gelu_tanh(gt[4]) * vl[4], gelu_tanh(gt[5]) * vl[5]); o.w = pk2(gelu_tanh(gt[6]) * vl[6], gelu_tanh(gt[7]) * vl[7]);
    *(GAS v4u*)(H + (size_t)tok * DFF + j8) = o;
}

typedef const __attribute__((address_space(4))) unsigned long long* kargs_t;
__device__ __forceinline__ kargs_t kargs() { kargs_t ka = (kargs_t)__builtin_amdgcn_kernarg_segment_ptr(); asm volatile("" : "+s"(ka)); return ka; }
#define KIN(i) ((gcf)ka[i])
#define KOUT ((gfp)ka[29])
#define KWS ((GAS unsigned char*)ka[30])
constexpr size_t AS_ = (size_t)MTOK * RWID;
__device__ __forceinline__ int lane_id() { int l; asm volatile("v_mbcnt_lo_u32_b32 %0, -1, 0\n\tv_mbcnt_hi_u32_b32 %0, -1, %0" : "=v"(l)); return l; }
#define PH_IDS const int lane = lane_id(); const int tid = wave * 64 + lane; (void)tid
#define GBAR() do { const int lane_b = lane_id(); xcd_barrier(bar, wave * 64 + lane_b); } while (0)

__global__ void __launch_bounds__(NTHR, 2) mega_fwd(Params p) {
    extern __shared__ __attribute__((aligned(16))) unsigned char lds_raw[];
    LAS unsigned char* lds = (LAS unsigned char*)lds_raw;
    const int wave = __builtin_amdgcn_readfirstlane((int)threadIdx.x >> 6);
    const int G = gridDim.x, gw = blockIdx.x * NWAVES + wave, ngw = G * NWAVES;
    XcdBarrier bar;
    { PH_IDS; kargs_t ka = kargs();
      for (int u = tid; u < (LDS_BYTES - LDSCTL_OFF) / 4; u += NTHR) ((LAS unsigned*)(lds + LDSCTL_OFF))[u] = 0u;
      __syncthreads();
      bar = xcd_barrier_post((unsigned*)((GAS unsigned*)(KWS + WS_CTL) + CW_BAR), (volatile LAS unsigned*)(lds + MISC_OFF) + 8, tid); }

    {
        PH_IDS; kargs_t ka = kargs(); GAS unsigned char* ws = KWS;
        LAS float* scr = (LAS float* )(lds + wave * 16384);
        for (int l = 0; l < DEPTH; ++l) {
            for (int it = gw; it < (DM / 64) * (INCOLS / 32); it += ngw) p0_transpose_item(KIN(6) + (size_t)l * DM * INCOLS, DM, INCOLS, (gbp )(ws + WS_WIN) + (size_t)l * INCOLS * DM, 0, scr, it, lane);
            for (int it = gw; it < (DM / 64) * (DM / 32); it += ngw) p0_transpose_item(KIN(24) + (size_t)l * DM * DM, DM, DM, (gbp )(ws + WS_WOUT) + (size_t)l * DM * DM, 0, scr, it, lane);
            for (int it = gw; it < (DM / 64) * (UPN / 32); it += ngw) p0_transpose_item(KIN(25) + (size_t)l * DM * UPN, DM, UPN, (gbp )(ws + WS_WUP) + (size_t)l * UPN * DM, 0, scr, it, lane);
            for (int it = gw; it < (DFF / 64) * (DM / 32); it += ngw) p0_transpose_item(KIN(28) + (size_t)l * DFF * DM, DFF, DM, (gbp )(ws + WS_WDN) + (size_t)l * DM * DFF, 0, scr, it, lane);
        }
        rowpass(KIN(0), nullptr, nullptr, nullptr, KIN(2), (gbp )(ws + WS_HN), gw, ngw, lane);
    }
    GBAR();

    for (int l = 0; l < DEPTH; ++l) {
        { PH_IDS; kargs_t ka = kargs(); GAS unsigned char* ws = KWS;
          pg8::Gemm g{(gbp )(ws + WS_HN), (gbp )(ws + WS_WIN) + (size_t)l * INCOLS * DM, MTOK, INCOLS, DM}; pg8::StaticOrder S; S.init(MTOK, INCOLS, G, (int)blockIdx.x);
          pg8::EpiBf16<0> E{(gbp )(ws + WS_PROJ), INCOLS, nullptr, 0, 0, 1.f};
          pg8::gemm_phase<pg8::EpiBf16<0>, pg8::StaticOrder, true, true>(lds, g, S, E, tid); }
        GBAR();
        { PH_IDS; kargs_t ka = kargs(); GAS unsigned char* ws = KWS;
          PrepW w{KIN(7) + (size_t)l * RCOLS, KIN(8) + (size_t)l * RWID, KIN(9) + (size_t)l * 64 * RWID, KIN(10) + (size_t)l * RWID, KIN(11) + (size_t)l * 64 * RWID, KIN(12) + (size_t)l * 128 * RWID,
                  KIN(13) + (size_t)l * RWID, KIN(14) + (size_t)l * RWID, KIN(15) + (size_t)l * RWID, KIN(19) + (size_t)l * GWID, KIN(20) + (size_t)l * GWID, (gci)KIN(1)};
          LAS float* pp = (LAS float* )(lds + wave * 12288);
          gfp SU = (gfp )(ws + WS_SGU);
          for (int tok = gw; tok < MTOK; tok += ngw) prep_token(tok, (gbp )(ws + WS_PROJ), w, (gfp )(ws + WS_RW), (gfp )(ws + WS_BON), (gbp )(ws + WS_QKR), SU, SU + (size_t)MTOK * GWID, pp, lane); }
        GBAR();
        { PH_IDS; kargs_t ka = kargs(); GAS unsigned char* ws = KWS;
          LAS float* ops = (LAS float*)(lds + wave * 4096);
          gfp RWb = (gfp)(ws + WS_RW); gfp PT = (gfp)(ws + WS_CHK);
          for (int task = gw; task < 2 * NTASK_SCAN; task += ngw) { if (task < NTASK_SCAN) scan_chunk<false>(task, RWb, RWb + 7 * AS_, PT + (size_t)NTASK_SCAN * 4096, ops, lane); else scan_chunk<true>(task - NTASK_SCAN, RWb, RWb + 8 * AS_, PT, ops, lane); } }
        GBAR();
        { PH_IDS; kargs_t ka = kargs(); GAS unsigned char* ws = KWS;
          gfp PT = (gfp)(ws + WS_CHK); gfp SU = (gfp)(ws + WS_SGU);
          if (wave < 2 && blockIdx.x < BATCH * RH) scan_carry_mfma((int)blockIdx.x, wave, (gcb)PT, PT + (size_t)NTASK_SCAN * 4096, PT + 2 * (size_t)NTASK_SCAN * 4096, lane);
          volatile LAS unsigned* MISC = (volatile LAS unsigned*)(lds + MISC_OFF);
          gu32* ctr = (gu32*)(ws + WS_CTL) + CW_ATT + 64 * l;
          for (;;) {
              if (tid == 0) MISC[16] = __hip_atomic_fetch_add(ctr, 1u, __ATOMIC_RELAXED, __HIP_MEMORY_SCOPE_AGENT);
              __syncthreads();
              const int u = (int)MISC[16];
              if (u >= ATT_UNITS) break;
              attn_unit(u, (gcb)(ws + WS_QKR), (gcb)(ws + WS_PROJ), (gfp)(ws + WS_AO), (gfp)(ws + WS_LSE), lds, tid, wave, lane);
          }
          for (int tok = gw; tok < MTOK; tok += ngw) sgu_token(tok, SU, SU + (size_t)MTOK * GWID, KIN(21) + (size_t)l * 8 * 128 * 128, KIN(22) + (size_t)l * 8 * 128, KIN(23) + (size_t)l * GWID, (gbp)(ws + WS_Y), lane); }
        GBAR();
        { PH_IDS; kargs_t ka = kargs(); GAS unsigned char* ws = KWS;
          LAS float* zb = (LAS float*)(lds + wave * 1024);
          gfp RWb = (gfp)(ws + WS_RW); gfp PT = (gfp)(ws + WS_CHK);
          for (int task = gw; task < NTASK_SCAN; task += ngw) scan_out(task, RWb, RWb + 7 * AS_, RWb + 8 * AS_, PT + 2 * (size_t)NTASK_SCAN * 4096, (gfp)(ws + WS_BON), KIN(16) + (size_t)l * RWID, KIN(17) + (size_t)l * RWID, (gbp)(ws + WS_Y), zb, lane);
          for (int tok = gw; tok < MTOK; tok += ngw) attn_norm_token(tok, (gcf)(ws + WS_AO), (gcf)(ws + WS_LSE), KIN(18) + (size_t)l * AWID, (gbp)(ws + WS_Y), lane); }
        GBAR();
        { PH_IDS; kargs_t ka = kargs(); GAS unsigned char* ws = KWS;
          pg8::Gemm g{(gbp )(ws + WS_Y), (gbp )(ws + WS_WOUT) + (size_t)l * DM * DM, MTOK, DM, DM}; pg8::StaticOrder S; S.init(MTOK, DM, G, (int)blockIdx.x);
          pg8::EpiF32 E{(gfp)(ws + WS_O), DM};
          pg8::gemm_phase<pg8::EpiF32, pg8::StaticOrder, true, true>(lds, g, S, E, tid); }
        GBAR();
        { PH_IDS; kargs_t ka = kargs(); GAS unsigned char* ws = KWS;
          rowpass(l == 0 ? KIN(0) : (gcf )KOUT, (gfp )(ws + WS_O), KIN(3) + (size_t)l * DM, KOUT, KIN(4) + (size_t)l * DM, (gbp )(ws + WS_HN), gw, ngw, lane); }
        GBAR();
        { PH_IDS; kargs_t ka = kargs(); GAS unsigned char* ws = KWS;
          pg8::Gemm g{(gbp )(ws + WS_HN), (gbp )(ws + WS_WUP) + (size_t)l * UPN * DM, MTOK, UPN, DM}; pg8::StaticOrder S; S.init(MTOK, UPN, G, (int)blockIdx.x);
          pg8::EpiBf16<0> E{(gbp )(ws + WS_UP), UPN, nullptr, 0, 0, 1.f};
          pg8::gemm_phase<pg8::EpiBf16<0>, pg8::StaticOrder, true, true>(lds, g, S, E, tid); }
        GBAR();
        { PH_IDS; kargs_t ka = kargs(); GAS unsigned char* ws = KWS;
          const int gtid = blockIdx.x * NTHR + tid, ngt = G * NTHR;
          for (int it = gtid; it < MTOK * (DFF / 8); it += ngt) conv_item(it, (gbp )(ws + WS_UP), KIN(26) + (size_t)l * 3 * UPN, KIN(27) + (size_t)l * UPN, (gbp )(ws + WS_H)); }
        GBAR();
        { PH_IDS; kargs_t ka = kargs(); GAS unsigned char* ws = KWS;
          pg8::Gemm g{(gbp )(ws + WS_H), (gbp )(ws + WS_WDN) + (size_t)l * DM * DFF, MTOK, DM, DFF}; pg8::StaticOrder S; S.init(MTOK, DM, G, (int)blockIdx.x);
          pg8::EpiF32 E{(gfp)(ws + WS_O), DM};
          pg8::gemm_phase<pg8::EpiF32, pg8::StaticOrder, true, true>(lds, g, S, E, tid); }
        GBAR();
        { PH_IDS; kargs_t ka = kargs(); GAS unsigned char* ws = KWS;
          rowpass(KOUT, (gfp )(ws + WS_O), KIN(5) + (size_t)l * DM, KOUT, l + 1 < DEPTH ? KIN(2) + (size_t)(l + 1) * DM : nullptr, (gbp )(ws + WS_HN), gw, ngw, lane); }
        if (l + 1 < DEPTH) GBAR();
    }
}

extern "C" void kernel_launch(void* const* d_in, const int* in_sizes, int n_in, void* d_out, int out_size, void* d_ws, size_t ws_size, hipStream_t stream) {
    static int grid = 0;
    if (grid == 0) {
        if (n_in != 29 || out_size != MTOK * DM || ws_size < WS_END) { fprintf(stderr, "kernel_launch: unexpected shapes (n_in %d out %d ws %zu need %zu)\n", n_in, out_size, ws_size, (size_t)WS_END); grid = -1; return; }
        int dev = 0, cus = 0, per_cu = 0;
        if (hipGetDevice(&dev) != hipSuccess || hipDeviceGetAttribute(&cus, hipDeviceAttributeMultiprocessorCount, dev) != hipSuccess) { grid = -1; return; }
        if (hipFuncSetAttribute((const void*)mega_fwd, hipFuncAttributeMaxDynamicSharedMemorySize, LDS_BYTES) != hipSuccess) { fprintf(stderr, "kernel_launch: hipFuncSetAttribute failed\n"); grid = -1; return; }
        if (hipOccupancyMaxActiveBlocksPerMultiprocessor(&per_cu, (const void*)mega_fwd, NTHR, LDS_BYTES) != hipSuccess || per_cu < 1) fprintf(stderr, "kernel_launch: occupancy query says %d\n", per_cu);
        (void)hipGetLastError();
        grid = cus;
    }
    if (grid < 0) return;
    if (hipMemsetAsync((char*)d_ws + WS_CTL, 0, CTL_ZERO_BYTES, stream) != hipSuccess) return;
    Params prm{};
    for (int i = 0; i < 29; ++i) prm.in[i] = (const float*)d_in[i];
    prm.out = (float*)d_out; prm.ws = (unsigned char*)d_ws;
    hipLaunchKernelGGL(mega_fwd, dim3(grid), dim3(NTHR), LDS_BYTES, stream, prm);
}
```

```cpp
#include <hip/hip_runtime.h>
#include <cstdio>
#include <cstdint>
namespace pg8 {
#define PG8_LAS __attribute__((address_space(3)))
#define PG8_GAS __attribute__((address_space(1)))
typedef unsigned short bf16_t;
typedef short bf16x8 __attribute__((ext_vector_type(8)));
typedef float f32x4 __attribute__((ext_vector_type(4)));
typedef unsigned u32x4 __attribute__((ext_vector_type(4)));
constexpr int BM = 256, BK = 64, HALF = 128, HTB = HALF * BK * 2  , STAGE_BYTES = 8 * HTB, NXCD = 8, WGM = 8;

__host__ __device__ __forceinline__ int lds_byte(int r, int c) { const int st = (r >> 4) * 2 + (c >> 5), rr = r & 15, cc = c & 31, ob = rr * 64 + cc * 2; return st * 1024 + (ob ^ (((ob >> 9) & 1) << 5)); }
__host__ __device__ __forceinline__ void stage_rc(int b, int& R, int& C) { const int st = b / 1024, sb = b % 1024, swz = sb ^ (((sb >> 9) & 1) << 5); R = (st >> 1) * 16 + swz / 64; C = (st & 1) * 32 + (swz % 64) / 2; }
__host__ __device__ __forceinline__ int perm32(int rho) { const int n = rho >> 4, i = rho & 15; return 8 * (i >> 2) + 4 * n + (i & 3); }

struct Unit { int pm, pn; };
struct Gemm { const PG8_GAS bf16_t* A; const PG8_GAS bf16_t* Bt; int M, N, K; };

struct StaticOrder {
    int nM, nN, nwg, G, c;
    __host__ __device__ void init(int M, int N, int G_, int c_) { nM = M / BM; nN = N / BM; nwg = nM * nN; G = G_; c = c_; }
    __host__ __device__ bool next(int i, Unit& u) const {
        const long L = (long)i * G + c; if (L >= nwg) return false;
        int wgid = (int)L; { const int q = nwg / NXCD, r = nwg % NXCD, xcd = wgid % NXCD, off = wgid / NXCD; wgid = (xcd < r ? xcd * (q + 1) : r * (q + 1) + (xcd - r) * q) + off; }
        const int nig = WGM * nN, gid = wgid / nig, fm = gid * WGM, gsz = (nM - fm) < WGM ? (nM - fm) : WGM;
        u.pm = fm + ((wgid % nig) % gsz); u.pn = (wgid % nig) / gsz; return true;
    }
    __device__ __forceinline__ void a_ready(const Unit&) const {}
    __device__ __forceinline__ void done(const Unit&) const {}
};

__device__ __forceinline__ unsigned cvt_pk_bf16(float lo, float hi) { unsigned r; asm volatile("v_cvt_pk_bf16_f32 %0, %1, %2" : "=v"(r) : "v"(lo), "v"(hi)); return r; }
typedef float f32x2 __attribute__((ext_vector_type(2)));
__device__ __forceinline__ f32x2 gelu_pk(f32x2 v) {
    const f32x2 av = __builtin_elementwise_abs(v), d = av * 0.2316418882f + 1.0f;
    f32x2 t; t.x = __builtin_amdgcn_rcpf(d.x); t.y = __builtin_amdgcn_rcpf(d.y);
    f32x2 q = t * 0.5307027145f + (-0.7265760135f); q = q * t + 0.7107068705f; q = q * t + (-0.142248368f); q = q * t + 0.127414796f; q = q * t;
    const f32x2 s = (v * v) * (-0.72134752044f);
    f32x2 e; e.x = __builtin_amdgcn_exp2f(s.x); e.y = __builtin_amdgcn_exp2f(s.y);
    const f32x2 m = v * (q * e), r = v - m;
    f32x2 o; o.x = v.x < 0.f ? m.x : r.x; o.y = v.y < 0.f ? m.y : r.y; return o;
}

template <int ACT  > struct EpiBf16 {
    static constexpr bool PERM = true, AFTER_DRAIN = false; static_assert(ACT == 0 || ACT == 1, "EpiBf16: ACT is 0 (none) or 1 (gelu_pk)");
    PG8_GAS bf16_t* O; int ldc; const PG8_GAS float* bias; int split_cols; size_t split_stride; float scale0;
    __device__ __forceinline__ void operator()(const f32x4 (&acc)[2][2][4][2], const Unit& u, int wr, int wc, int fr, int fq) const {
        const int row0 = u.pm * BM + wr * 64 + fr; int colt = u.pn * BM; PG8_GAS bf16_t* base = O;
        float sc = 1.f; if (split_cols) { const int t = colt / split_cols; base += (size_t)t * split_stride; colt -= t * split_cols; if (t == 0) sc = scale0; }
        const int col0 = colt + wc * 32 + 8 * fq, bcol0 = u.pn * BM + wc * 32 + 8 * fq;
        f32x4 bv[2][2];
#pragma unroll
        for (int bj = 0; bj < 2; ++bj)
#pragma unroll
            for (int n = 0; n < 2; ++n) bv[bj][n] = bias ? *(const PG8_GAS f32x4*)(bias + bcol0 + bj * HALF + 4 * n) : (f32x4){0.f, 0.f, 0.f, 0.f};
#pragma unroll
        for (int ai = 0; ai < 2; ++ai)
#pragma unroll
            for (int m = 0; m < 4; ++m) { PG8_GAS bf16_t* rowp = base + (size_t)(row0 + ai * HALF + m * 16) * ldc + col0;
#pragma unroll
                for (int bj = 0; bj < 2; ++bj) { f32x4 v0 = acc[ai][bj][m][0] + bv[bj][0], v1 = acc[ai][bj][m][1] + bv[bj][1];
                    if (ACT == 1) { f32x2 a = gelu_pk((f32x2){v0[0], v0[1]}), b = gelu_pk((f32x2){v0[2], v0[3]}), c = gelu_pk((f32x2){v1[0], v1[1]}), d = gelu_pk((f32x2){v1[2], v1[3]});
                        v0 = (f32x4){a.x, a.y, b.x, b.y}; v1 = (f32x4){c.x, c.y, d.x, d.y}; }
                    v0 = v0 * sc; v1 = v1 * sc; u32x4 w; w.x = cvt_pk_bf16(v0[0], v0[1]); w.y = cvt_pk_bf16(v0[2], v0[3]); w.z = cvt_pk_bf16(v1[0], v1[1]); w.w = cvt_pk_bf16(v1[2], v1[3]);
                    *(PG8_GAS u32x4*)(rowp + bj * HALF) = w; } }
    }
};
struct EpiF32 {
    static constexpr bool PERM = true, AFTER_DRAIN = false;
    PG8_GAS float* O; int ldc;
    __device__ __forceinline__ void operator()(const f32x4 (&acc)[2][2][4][2], const Unit& u, int wr, int wc, int fr, int fq) const {
        const int row0 = u.pm * BM + wr * 64 + fr, col0 = u.pn * BM + wc * 32 + 8 * fq;
#pragma unroll
        for (int ai = 0; ai < 2; ++ai)
#pragma unroll
            for (int m = 0; m < 4; ++m) { PG8_GAS float* rowp = O + (size_t)(row0 + ai * HALF + m * 16) * ldc + col0;
#pragma unroll
                for (int bj = 0; bj < 2; ++bj) { *(PG8_GAS f32x4*)(rowp + bj * HALF) = acc[ai][bj][m][0]; *(PG8_GAS f32x4*)(rowp + bj * HALF + 4) = acc[ai][bj][m][1]; } }
    }
};

template <class Epi, class Sched, bool ALIGN_EPI = false, bool SP2 = false>
__device__ __forceinline__ void gemm_phase(PG8_LAS unsigned char* lds, const Gemm g, const Sched& S, const Epi& E, const int tid) {
    const int wid = __builtin_amdgcn_readfirstlane(tid >> 6), lane = tid & 63, wr = wid >> 2, wc = wid & 3, fr = lane & 15, fq = lane >> 4;
    const int K = g.K, nt = K / BK;
    unsigned voffA[2], voffB[2];
#pragma unroll
    for (int i = 0; i < 2; ++i) { int R, C; stage_rc(tid * 16 + i * 8192, R, C); const int Rb = Epi::PERM ? ((R & ~31) + perm32(R & 31)) : R;
        voffA[i] = (unsigned)(R * K + C) * 2u; voffB[i] = (unsigned)(Rb * K + C) * 2u; }
    const size_t kstep = (size_t)(BK * 2);
    const size_t hstep = (size_t)HALF * K * 2;
    const size_t tstep = 2 * hstep;
    const unsigned ldsw = (unsigned)wid * 1024u;
    const int aoff = lds_byte(wr * 64 + fr, fq * 8), boff = lds_byte(wc * 32 + fr, fq * 8);
#define PG8_SA(b, h) (((b) * 2 + (h)) * HTB)
#define PG8_SB(b, h) ((4 + (b) * 2 + (h)) * HTB)
#define PG8_STAGE(bufoff, gbase, voff) do { _Pragma("unroll") for (int _i = 0; _i < 2; ++_i) \
        __builtin_amdgcn_global_load_lds((const PG8_GAS unsigned*)((const PG8_GAS char*)(gbase) + (voff)[_i]), (PG8_LAS unsigned*)(lds + (bufoff) + ldsw + _i * 8192), 16, 0, 0); } while (0)
#define PG8_LDA(dst, b, h) do { _Pragma("unroll") for (int m = 0; m < 4; ++m) _Pragma("unroll") for (int k = 0; k < 2; ++k) dst[m][k] = *(const PG8_LAS bf16x8*)(lds + PG8_SA(b, h) + aoff + m * 2048 + k * 1024); } while (0)
#define PG8_LDB(dst, b, h) do { _Pragma("unroll") for (int n = 0; n < 2; ++n) _Pragma("unroll") for (int k = 0; k < 2; ++k) dst[n][k] = *(const PG8_LAS bf16x8*)(lds + PG8_SB(b, h) + boff + n * 2048 + k * 1024); } while (0)
#define PG8_MMA(ai, bj, At, Bt) do { __builtin_amdgcn_s_setprio(1); _Pragma("unroll") for (int m = 0; m < 4; ++m) _Pragma("unroll") for (int n = 0; n < 2; ++n) _Pragma("unroll") for (int k = 0; k < 2; ++k) \
        acc[ai][bj][m][n] = __builtin_amdgcn_mfma_f32_16x16x32_bf16(Bt[n][k], At[m][k], acc[ai][bj][m][n], 0, 0, 0); __builtin_amdgcn_s_setprio(0); } while (0)
#define PG8_WAIT_V(n) asm volatile("s_waitcnt vmcnt(" #n ")" ::: "memory")
#define PG8_WAIT_L(n) asm volatile("s_waitcnt lgkmcnt(" #n ")" ::: "memory")
#define PG8_BAR __builtin_amdgcn_s_barrier()
#define PG8_SCHED __builtin_amdgcn_sched_barrier(0)
    Unit cur, nxt; int ui = 0;
    if (!S.next(0, cur)) return;
    f32x4 acc[2][2][4][2];
#pragma unroll
    for (int a = 0; a < 2; ++a)
#pragma unroll
        for (int b = 0; b < 2; ++b)
#pragma unroll
            for (int m = 0; m < 4; ++m)
#pragma unroll
                for (int n = 0; n < 2; ++n) acc[a][b][m][n] = (f32x4){0.f, 0.f, 0.f, 0.f};
    bf16x8 At[4][2], B0[2][2], B1[2][2];
    const PG8_GAS char* cA = (const PG8_GAS char*)g.A + (size_t)cur.pm * tstep; const PG8_GAS char* cB = (const PG8_GAS char*)g.Bt + (size_t)cur.pn * tstep;
    S.a_ready(cur);
    if constexpr (SP2) {
        PG8_STAGE(PG8_SB(0, 0), cB, voffB); PG8_STAGE(PG8_SB(0, 1), cB + hstep, voffB); PG8_STAGE(PG8_SA(0, 0), cA, voffA); PG8_STAGE(PG8_SA(0, 1), cA + hstep, voffA);
        if (wr == 1) PG8_BAR;
        PG8_WAIT_V(2); PG8_BAR;
        PG8_STAGE(PG8_SB(1, 0), cB + kstep, voffB); PG8_STAGE(PG8_SA(1, 0), cA + kstep, voffA); PG8_STAGE(PG8_SB(1, 1), cB + hstep + kstep, voffB);
        PG8_WAIT_V(6); PG8_BAR;
    } else {
        PG8_STAGE(PG8_SB(0, 0), cB, voffB); PG8_STAGE(PG8_SA(0, 0), cA, voffA); PG8_STAGE(PG8_SB(0, 1), cB + hstep, voffB); PG8_STAGE(PG8_SA(0, 1), cA + hstep, voffA);
        if (wr == 1) PG8_BAR;
        PG8_WAIT_V(4); PG8_BAR;
        PG8_STAGE(PG8_SB(1, 0), cB + kstep, voffB); PG8_STAGE(PG8_SA(1, 0), cA + kstep, voffA); PG8_STAGE(PG8_SB(1, 1), cB + hstep + kstep, voffB);
        PG8_WAIT_V(6); PG8_BAR;
    }
    for (;;) {
        const bool has_next = S.next(ui + 1, nxt);
        const PG8_GAS char* nA = has_next ? (const PG8_GAS char*)g.A + (size_t)nxt.pm * tstep : cA; const PG8_GAS char* nB = has_next ? (const PG8_GAS char*)g.Bt + (size_t)nxt.pn * tstep : cB;
        for (int t = 0; t < nt; t += 2) {
            const bool last = (t == nt - 2);
            const PG8_GAS char* a1 = cA + (size_t)(t + 1) * kstep;
            const PG8_GAS char* a2 = last ? nA : cA + (size_t)(t + 2) * kstep; const PG8_GAS char* b2 = last ? nB : cB + (size_t)(t + 2) * kstep;
            const PG8_GAS char* a3 = a2 + kstep; const PG8_GAS char* b3 = b2 + kstep;
            if (last && has_next) S.a_ready(nxt);
            if constexpr (SP2) {
            PG8_LDB(B0, 0, 0); PG8_LDB(B1, 0, 1); PG8_SCHED; PG8_LDA(At, 0, 0); PG8_STAGE(PG8_SA(1, 1), a1 + hstep, voffA);
            PG8_WAIT_V(8); PG8_WAIT_L(0); PG8_BAR; PG8_MMA(0, 0, At, B0); PG8_MMA(0, 1, At, B1); PG8_BAR; PG8_SCHED;
            PG8_LDA(At, 0, 1); PG8_STAGE(PG8_SB(0, 0), b2, voffB); PG8_STAGE(PG8_SB(0, 1), b2 + hstep, voffB); PG8_STAGE(PG8_SA(0, 0), a2, voffA);
            PG8_WAIT_V(8); PG8_WAIT_L(0); PG8_BAR; PG8_MMA(1, 0, At, B0); PG8_MMA(1, 1, At, B1); PG8_BAR; PG8_SCHED;
            PG8_LDB(B0, 1, 0); PG8_LDB(B1, 1, 1); PG8_SCHED; PG8_LDA(At, 1, 0); PG8_STAGE(PG8_SA(0, 1), a2 + hstep, voffA);
            PG8_WAIT_V(8); PG8_WAIT_L(0); PG8_BAR; PG8_MMA(0, 0, At, B0); PG8_MMA(0, 1, At, B1); PG8_BAR; PG8_SCHED;
            PG8_LDA(At, 1, 1); PG8_STAGE(PG8_SB(1, 0), b3, voffB); PG8_STAGE(PG8_SB(1, 1), b3 + hstep, voffB); PG8_STAGE(PG8_SA(1, 0), a3, voffA);
            PG8_WAIT_V(8); PG8_WAIT_L(0); PG8_BAR; PG8_MMA(1, 0, At, B0); PG8_MMA(1, 1, At, B1); PG8_BAR; PG8_SCHED;
            } else {
            PG8_LDB(B0, 0, 0); PG8_SCHED; PG8_LDA(At, 0, 0); PG8_STAGE(PG8_SA(1, 1), a1 + hstep, voffA);
            PG8_WAIT_L(8); PG8_BAR; PG8_WAIT_L(0); PG8_MMA(0, 0, At, B0); PG8_BAR; PG8_SCHED;
            PG8_LDB(B1, 0, 1); PG8_STAGE(PG8_SB(0, 0), b2, voffB);
            PG8_BAR; PG8_WAIT_L(0); PG8_MMA(0, 1, At, B1); PG8_BAR;
            PG8_LDA(At, 0, 1); PG8_STAGE(PG8_SA(0, 0), a2, voffA);
            PG8_BAR; PG8_WAIT_L(0); PG8_MMA(1, 0, At, B0); PG8_BAR; PG8_SCHED;
            PG8_STAGE(PG8_SB(0, 1), b2 + hstep, voffB);
            PG8_WAIT_V(6); PG8_BAR; PG8_MMA(1, 1, At, B1); PG8_BAR;
            PG8_LDB(B0, 1, 0); PG8_SCHED; PG8_LDA(At, 1, 0); PG8_STAGE(PG8_SA(0, 1), a2 + hstep, voffA);
            PG8_WAIT_L(8); PG8_BAR; PG8_WAIT_L(0); PG8_MMA(0, 0, At, B0); PG8_BAR; PG8_SCHED;
            PG8_LDB(B1, 1, 1); PG8_STAGE(PG8_SB(1, 0), b3, voffB);
            PG8_BAR; PG8_WAIT_L(0); PG8_MMA(0, 1, At, B1); PG8_BAR;
            PG8_LDA(At, 1, 1); PG8_STAGE(PG8_SA(1, 0), a3, voffA);
            PG8_BAR; PG8_WAIT_L(0); PG8_MMA(1, 0, At, B0); PG8_BAR; PG8_SCHED;
            PG8_STAGE(PG8_SB(1, 1), b3 + hstep, voffB);
            PG8_WAIT_V(6); PG8_BAR; PG8_MMA(1, 1, At, B1); PG8_BAR;
            }
        }
        if constexpr (ALIGN_EPI) { if (wr == 0) PG8_BAR; }
        if constexpr (!Epi::AFTER_DRAIN) { E(acc, cur, wr, wc, fr, fq); S.done(cur); }
        if (!has_next) break;
#pragma unroll
        for (int a = 0; a < 2; ++a)
#pragma unroll
            for (int b = 0; b < 2; ++b)
#pragma unroll
                for (int m = 0; m < 4; ++m)
#pragma unroll
                    for (int n = 0; n < 2; ++n) acc[a][b][m][n] = (f32x4){0.f, 0.f, 0.f, 0.f};
        cur = nxt; cA = nA; cB = nB; ++ui;
        if constexpr (ALIGN_EPI) { if (wr == 1) PG8_BAR; }
    }
    PG8_WAIT_V(0);
    if constexpr (!ALIGN_EPI) { if (wr == 0) PG8_BAR; }
    PG8_BAR;
    if constexpr (Epi::AFTER_DRAIN) { E.fused(acc, cur, wr, wc, fr, fq, lds, wid, lane); S.done(cur); }
#undef PG8_SA
#undef PG8_SB
#undef PG8_STAGE
#undef PG8_LDA
#undef PG8_LDB
#undef PG8_MMA
#undef PG8_WAIT_V
#undef PG8_WAIT_L
#undef PG8_BAR
#undef PG8_SCHED
}
}
#define GAS __attribute__((address_space(1)))
#define LAS __attribute__((address_space(3)))
typedef unsigned short bf16;
typedef unsigned v4u __attribute__((ext_vector_type(4)));
typedef float f32x4 __attribute__((ext_vector_type(4)));
typedef short bf16x8 __attribute__((ext_vector_type(8)));
typedef GAS unsigned gu32;
typedef GAS unsigned long long gu64;
#define RLX_AGENT __ATOMIC_RELAXED, __HIP_MEMORY_SCOPE_AGENT
#define LDS_WAIT() asm volatile("s_waitcnt lgkmcnt(0)" ::: "memory")
#define VM_WAIT() asm volatile("s_waitcnt vmcnt(0)" ::: "memory")
__device__ __forceinline__ unsigned long long rt() { return __builtin_amdgcn_s_memrealtime(); }
__device__ __forceinline__ unsigned f2bf(float f) { unsigned u = __builtin_bit_cast(unsigned, f); return (u + 0x7fffu + ((u >> 16) & 1u)) >> 16; }
__device__ __forceinline__ unsigned pk2(float lo, float hi) { return f2bf(lo) | (f2bf(hi) << 16); }

#define XB_TMO      128
#define XB_XCNT(j)  (256  + 64 * (j))
#define XB_XSUB(j)  (1280 + 64 * (j))
#define XB_XGEN(j)  (2304 + 64 * (j))
#define XB_TOP      3328
#define XB_TOPGEN   3392
#define XCD_BAR_WORDS 3456
#define XB_SPIN_CAP (1u << 18)

__device__ __forceinline__ unsigned xb_ld(unsigned* p)              { return __hip_atomic_load(p, __ATOMIC_RELAXED, __HIP_MEMORY_SCOPE_AGENT); }
__device__ __forceinline__ unsigned xb_add(unsigned* p, unsigned v) { return __hip_atomic_fetch_add(p, v, __ATOMIC_RELAXED, __HIP_MEMORY_SCOPE_AGENT); }
__device__ __forceinline__ unsigned xb_xcc_id() { return (unsigned)__builtin_amdgcn_s_getreg((3 << 11) | 20) & 0xFu; }
#define XB_SPIN(cond, bar) do { unsigned _sp = 0; while (cond) { __builtin_amdgcn_s_sleep(1); \
    if ((++_sp & 255u) == 0u) { if (xb_ld(&(bar)[XB_TMO])) break; if (_sp > XB_SPIN_CAP) { atomicAdd(&(bar)[XB_TMO], 1u); break; } } } } while (0)

struct XcdBarrier {
    unsigned* bar; unsigned x;
    volatile LAS unsigned* st;
};

__device__ __forceinline__ XcdBarrier xcd_barrier_post(unsigned* bar, volatile LAS unsigned* st, const int tid) {
    XcdBarrier b; b.bar = bar; b.x = xb_xcc_id(); b.st = st;
    if (tid == 0) (void)xb_add(&bar[XB_XCNT(b.x)], 1u);
    return b;
}
__device__ __forceinline__ void xcd_barrier_complete(unsigned* bar, unsigned x, unsigned& nloc, unsigned& nx) {
    const unsigned G = gridDim.x * gridDim.y * gridDim.z;
    unsigned sum, cnt, mine, sp = 0u;
    for (;;) {
        sum = 0u; cnt = 0u; mine = 0u;
#pragma unroll
        for (unsigned j = 0; j < 16; ++j) { const unsigned c = xb_ld(&bar[XB_XCNT(j)]); sum += c; cnt += (c > 0u) ? 1u : 0u; mine = (j == x) ? c : mine; }
        if (sum == G) break;
        __builtin_amdgcn_s_sleep(1);
        if ((++sp & 255u) == 0u) { if (xb_ld(&bar[XB_TMO])) break; if (sp > XB_SPIN_CAP) { atomicAdd(&bar[XB_TMO], 1u); break; } }
    }
    nloc = mine > 0u ? mine : 1u; nx = cnt > 0u ? cnt : 1u;
}

__device__ __forceinline__ void xcd_barrier(const XcdBarrier& b, const int tid) {
    asm volatile("s_waitcnt vmcnt(0)" ::: "memory");
    __syncthreads();
    if (tid == 0) {
        unsigned* bar = b.bar;
        __builtin_amdgcn_s_waitcnt(0);
        unsigned nloc = b.st[0], nx = b.st[1];
        if (nloc == 0u) { xcd_barrier_complete(bar, b.x, nloc, nx); b.st[0] = nloc; b.st[1] = nx; }
        const unsigned old = xb_add(&bar[XB_XSUB(b.x)], 1u);
        const unsigned gen = old / nloc;
        if (old + 1u == (gen + 1u) * nloc) {
            __builtin_amdgcn_fence(__ATOMIC_RELEASE, "agent");
            asm volatile("s_waitcnt vmcnt(0)" ::: "memory");
            const unsigned og = xb_add(&bar[XB_TOP], 1u);
            const unsigned tg = og / nx;
            if (og + 1u == (tg + 1u) * nx) xb_add(&bar[XB_TOPGEN], 1u);
            else XB_SPIN(xb_ld(&bar[XB_TOPGEN]) == tg, bar);
            __builtin_amdgcn_fence(__ATOMIC_ACQUIRE, "agent");
            xb_add(&bar[XB_XGEN(b.x)], 1u);
            asm volatile("s_waitcnt vmcnt(0)" ::: "memory");
        } else {
            XB_SPIN(xb_ld(&bar[XB_XGEN(b.x)]) == gen, bar);
            __builtin_amdgcn_fence(__ATOMIC_ACQUIRE, "agent");
            asm volatile("s_waitcnt vmcnt(0)" ::: "memory");
        }
    }
    __syncthreads();
}
constexpr int BATCH = 2, SEQ = 4096, DM = 2048, DEPTH = 4, MTOK = BATCH * SEQ;
constexpr int HD = 64, RH = 12, AH = 12, GGRP = 8, RWID = 768, AWID = 768, GWID = 512;
constexpr int RCOLS = 2560, ACOLS = 2304, GCOLS = 1024, INCOLS = 5888, DFF = 5632, UPN = 2 * DFF;
constexpr int QOFF = RCOLS, KOFF = RCOLS + AWID, VOFF = RCOLS + 2 * AWID, GOFF = RCOLS + ACOLS;
constexpr int TCH = 64, NCH = SEQ / TCH;
constexpr int NTASK_SCAN = BATCH * RH * NCH;
constexpr float NORM_EPS = 1e-6f, GN_EPS = 1e-5f, RWKV_LN_EPS = 64e-5f;
constexpr float DECAY_SCALE = 0.6065306597126334f;
constexpr int NWAVES = 8, NTHR = NWAVES * 64;

constexpr size_t MiB = 1u << 20;
constexpr size_t WS_CTL = 0, CTL_ZERO_BYTES = 1 * MiB;
constexpr size_t WS_WIN = 2 * MiB, WS_WOUT = 94 * MiB, WS_WUP = 126 * MiB, WS_WDN = 302 * MiB;
constexpr size_t WS_HN = 390 * MiB, WS_Y = 422 * MiB, WS_O = 454 * MiB;
constexpr size_t WS_REG = 518 * MiB;
constexpr size_t WS_PROJ = WS_REG;
constexpr size_t WS_RW = WS_REG + 92 * MiB;
constexpr size_t WS_CHK = WS_RW + 216 * MiB;
constexpr size_t WS_QKR = WS_CHK + 72 * MiB;
constexpr size_t WS_AO = WS_QKR + 24 * MiB;
constexpr size_t WS_LSE = WS_AO + 72 * MiB;
constexpr size_t WS_SGU = WS_LSE + 2 * MiB;
constexpr size_t WS_BON = WS_SGU + 32 * MiB;
constexpr size_t WS_LORA = WS_BON + 1 * MiB;
constexpr size_t WS_END_MIX = WS_LORA + 2 * MiB;
constexpr size_t WS_UP = WS_REG;
constexpr size_t WS_H = WS_REG + 176 * MiB;
constexpr size_t WS_END = WS_END_MIX;
static_assert(WS_H + 88 * MiB <= WS_END, "map");
constexpr int LORA_L = RWID * 256;
constexpr int CW_BAR = 4096, CW_ATT = 8192;

constexpr int RING_BYTES = 131072, LDSCTL_OFF = RING_BYTES, MISC_OFF = LDSCTL_OFF + 320, LDS_BYTES = 147456;

struct Params { const float* in[29]; float* out; unsigned char* ws; };

typedef const GAS float* gcf; typedef GAS float* gfp; typedef const GAS bf16* gcb; typedef GAS bf16* gbp; typedef const GAS int* gci;
__device__ __forceinline__ float bf2f(unsigned short u) { return __builtin_bit_cast(float, (unsigned)u << 16); }
__device__ __forceinline__ float bflo(unsigned u) { return __builtin_bit_cast(float, u << 16); }
__device__ __forceinline__ float bfhi(unsigned u) { return __builtin_bit_cast(float, u & 0xffff0000u); }
__device__ __forceinline__ float wave_sum(float v) {
#pragma unroll
    for (int o = 1; o < 64; o <<= 1) v += __shfl_xor(v, o);
    return v;
}
__device__ __forceinline__ float wave_max(float v) {
#pragma unroll
    for (int o = 1; o < 64; o <<= 1) v = fmaxf(v, __shfl_xor(v, o));
    return v;
}
__device__ __forceinline__ float sigmoidf_(float x) { return 1.f / (1.f + __expf(-x)); }
__device__ __forceinline__ float gelu_tanh(float x) { const float u = 0.7978845608028654f * (x + 0.044715f * x * x * x); return 0.5f * x * (1.f + tanhf(u)); }

typedef float f32x16 __attribute__((ext_vector_type(16)));
typedef float f32x2_t __attribute__((ext_vector_type(2))); typedef __bf16 bf16x2_t __attribute__((ext_vector_type(2)));
typedef short s16x4 __attribute__((ext_vector_type(4)));
__device__ __forceinline__ unsigned cvtpk(float lo, float hi) { f32x2_t v = {lo, hi}; bf16x2_t b = __builtin_convertvector(v, bf16x2_t); return __builtin_bit_cast(unsigned, b); }
__device__ __forceinline__ bf16x8 pack8(float a0, float a1, float a2, float a3, float a4, float a5, float a6, float a7) { v4u p; p.x = cvtpk(a0, a1); p.y = cvtpk(a2, a3); p.z = cvtpk(a4, a5); p.w = cvtpk(a6, a7); return __builtin_bit_cast(bf16x8, p); }
#define MFMA16(a, b, c) __builtin_amdgcn_mfma_f32_16x16x32_bf16((a), (b), (c), 0, 0, 0)
#define MFMA32(a, b, c) __builtin_amdgcn_mfma_f32_32x32x16_bf16((a), (b), (c), 0, 0, 0)
__device__ __forceinline__ int crow(int reg, int h) { return (reg & 3) + 8 * (reg >> 2) + 4 * h; }

__device__ __forceinline__ void p0_transpose_item(gcf W, int K, int N, gbp WT, int row_off, LAS float* scr, int item, int lane) {
    const int nblk = N / 32, kb = item / nblk, nb = item % nblk, k0 = 64 * kb, n0 = 32 * nb;
#pragma unroll 8
    for (int i = 0; i < 32; ++i) { const int kk = 2 * i + (lane >> 5); scr[kk * 33 + (lane & 31)] = W[(size_t)(k0 + kk) * N + n0 + (lane & 31)]; }
    LDS_WAIT(); asm volatile("" ::: "memory");
    const int c = lane & 7;
#pragma unroll
    for (int j = 0; j < 4; ++j) { const int n = (lane >> 3) + 8 * j; const LAS float* s = scr + (8 * c) * 33 + n;
        v4u o; o.x = pk2(s[0 * 33], s[1 * 33]); o.y = pk2(s[2 * 33], s[3 * 33]); o.z = pk2(s[4 * 33], s[5 * 33]); o.w = pk2(s[6 * 33], s[7 * 33]);
        *(GAS v4u*)(WT + (size_t)(row_off + n0 + n) * K + k0 + 8 * c) = o; }
    LDS_WAIT(); asm volatile("" ::: "memory");
}

__device__ __forceinline__ void rowpass(gcf xin, gcf delta, gcf gpost, gfp xout, gcf gnext, gbp hn, int gw, int ngw, int lane) {
    for (int m = gw; m < MTOK; m += ngw) {
        const GAS f32x4* xr = (const GAS f32x4*)(xin + (size_t)m * DM) + lane;
        f32x4 xv[8];
#pragma unroll
        for (int j = 0; j < 8; ++j) xv[j] = xr[64 * j];
        if (delta) {
            const GAS f32x4* dr = (const GAS f32x4*)(delta + (size_t)m * DM) + lane;
            f32x4 dv[8]; float ss = 0.f;
#pragma unroll
            for (int j = 0; j < 8; ++j) { dv[j] = dr[64 * j]; ss += dv[j].x * dv[j].x + dv[j].y * dv[j].y + dv[j].z * dv[j].z + dv[j].w * dv[j].w; }
            const float rstd = rsqrtf(wave_sum(ss) * (1.f / DM) + NORM_EPS);
            GAS f32x4* xo = (GAS f32x4*)(xout + (size_t)m * DM) + lane;
#pragma unroll
            for (int j = 0; j < 8; ++j) { const f32x4 g = ((const GAS f32x4*)gpost)[lane + 64 * j]; xv[j] = xv[j] + dv[j] * rstd * g; xo[64 * j] = xv[j]; }
        }
        if (gnext) {
            float ss = 0.f;
#pragma unroll
            for (int j = 0; j < 8; ++j) ss += xv[j].x * xv[j].x + xv[j].y * xv[j].y + xv[j].z * xv[j].z + xv[j].w * xv[j].w;
            const float rstd = rsqrtf(wave_sum(ss) * (1.f / DM) + NORM_EPS);
            GAS unsigned long long* o8 = (GAS unsigned long long*)(hn + (size_t)m * DM) + lane;
#pragma unroll
            for (int j = 0; j < 8; ++j) { const f32x4 g = ((const GAS f32x4*)gnext)[lane + 64 * j]; const f32x4 v = xv[j] * rstd * g;
                o8[64 * j] = (unsigned long long)pk2(v.x, v.y) | ((unsigned long long)pk2(v.z, v.w) << 32); }
        }
    }
}

struct PrepW { gcf sgu_g, sgu_b; gci pos; };
__device__ __forceinline__ void prep_token(int tok, gcb PROJ, const PrepW& w, gbp QKR, gfp SU, gfp SVN, int lane) {
    gcb prow = PROJ + (size_t)tok * INCOLS;
    {
        float cs = 1.f, sn = 0.f;
        if (lane < 16) { const int f = lane & 7; const float inv = exp2f(-(float)f * (18.931568569324174f / 8.f)); const float ang = (float)w.pos[tok] * inv; cs = cosf(ang); sn = sinf(ang); }
#pragma unroll 4
        for (int i = 0; i < 24; ++i) { const int c = lane + 64 * i; float x = bf2f(prow[QOFF + c]);
            if (lane < 16) { const float oth = bf2f(prow[QOFF + c + (lane < 8 ? 8 : -8)]); x = lane < 8 ? x * cs - oth * sn : x * cs + oth * sn; }
            if (i < 12) x *= 0.18033688011112042f;
            QKR[(size_t)tok * 1536 + c] = (bf16)f2bf(x); }
    }
#pragma unroll 4
    for (int i = 0; i < 16; ++i) { const int c = lane + 64 * i; const float z = gelu_tanh(bf2f(prow[GOFF + c]));
        if (i < 8) SU[(size_t)tok * GWID + c] = z;
        else { const int g = i - 8; const float mu = wave_sum(z) * (1.f / 64.f); const float d = z - mu; const float var = wave_sum(d * d) * (1.f / 64.f);
            SVN[(size_t)tok * GWID + g * 64 + lane] = d * rsqrtf(var + GN_EPS) * w.sgu_g[g * 64 + lane] + w.sgu_b[g * 64 + lane]; } }
}

constexpr int LIN_ROW = 264;
struct RPW { gcf mu, w0, a0, kk_, ka_, rk; gcb w2t, a2t, g2t; };
__device__ __forceinline__ f32x4 ld4bf(gcb p) { const unsigned long long u = *(const GAS unsigned long long*)p; const unsigned lo = (unsigned)u, hi = (unsigned)(u >> 32); return (f32x4){bflo(lo), bfhi(lo), bflo(hi), bfhi(hi)}; }
__device__ __forceinline__ void rwkv_prep_unit(int unit, gcb PROJ, const RPW& w, gfp RWb, gfp BON, LAS unsigned char* lds, int tid, int wave, int lane) {
    constexpr size_t AS = (size_t)MTOK * RWID;
    gfp R = RWb; gfp Wd = RWb + AS; gfp K2 = RWb + 2 * AS; gfp V = RWb + 3 * AS; gfp KK = RWb + 4 * AS; gfp KKA = RWb + 5 * AS; gfp Gt = RWb + 6 * AS;
    const int tok0 = unit * 32;
    LAS bf16* lin = (LAS bf16*)lds;
    {
        const int tk = tid >> 4, c0 = (tid & 15) * 16, tokA = tok0 + tk, tA = tokA % SEQ;
        gcb pr = PROJ + (size_t)tokA * INCOLS + 2304 + c0;
        unsigned ob[8];
#pragma unroll
        for (int q4 = 0; q4 < 4; ++q4) { const f32x4 cu = ld4bf(pr + 4 * q4); f32x4 pv = {0.f, 0.f, 0.f, 0.f}; if (tA > 0) pv = ld4bf(pr + 4 * q4 - INCOLS);
            const f32x4 mu = *(const GAS f32x4*)(w.mu + 2304 + c0 + 4 * q4); f32x4 x = cu + (pv - cu) * mu;
#pragma unroll
            for (int e = 0; e < 4; ++e) { const int c = c0 + 4 * q4 + e; x[e] = c < 64 ? tanhf(x[e]) : (c < 128 ? x[e] : sigmoidf_(x[e])); }
            ob[2 * q4] = pk2(x[0], x[1]); ob[2 * q4 + 1] = pk2(x[2], x[3]); }
        LAS v4u* dst = (LAS v4u*)(lin + tk * LIN_ROW + c0);
        dst[0] = (v4u){ob[0], ob[1], ob[2], ob[3]}; dst[1] = (v4u){ob[4], ob[5], ob[6], ob[7]};
    }
    __syncthreads();
    const int tt = wave & 1, hq = wave >> 1, tl = lane & 15, g = lane >> 4;
    const int tok = tok0 + 16 * tt + tl, t = tok % SEQ;
    bf16x8 bfr[8];
#pragma unroll
    for (int ks = 0; ks < 8; ++ks) bfr[ks] = *(const LAS bf16x8*)(lin + (16 * tt + tl) * LIN_ROW + 32 * ks + 8 * g);
    gcb prow = PROJ + (size_t)tok * INCOLS;
    for (int hi = 0; hi < 3; ++hi) { const int h = hq + 4 * hi;
        f32x4 kr[4], aa[4]; float ss = 0.f, bon = 0.f;
#pragma unroll
        for (int nt = 0; nt < 4; ++nt) { const int n0 = h * 64 + 16 * nt;
            f32x4 cw = {0.f, 0.f, 0.f, 0.f}, ca = cw, cg = cw;
#pragma unroll
            for (int ks = 0; ks < 2; ++ks) { cw = MFMA16(*(const GAS bf16x8*)(w.w2t + (n0 + tl) * 64 + 32 * ks + 8 * g), bfr[ks], cw);
                                             ca = MFMA16(*(const GAS bf16x8*)(w.a2t + (n0 + tl) * 64 + 32 * ks + 8 * g), bfr[2 + ks], ca); }
#pragma unroll
            for (int ks = 0; ks < 4; ++ks) cg = MFMA16(*(const GAS bf16x8*)(w.g2t + (n0 + tl) * 128 + 32 * ks + 8 * g), bfr[4 + ks], cg);
            const int c = n0 + 4 * g;
            const f32x4 pr_ = ld4bf(prow + c), pk_ = ld4bf(prow + 768 + c), pv_ = ld4bf(prow + 1536 + c);
            f32x4 qr_ = {0.f, 0.f, 0.f, 0.f}, qk_ = qr_, qv_ = qr_;
            if (t > 0) { qr_ = ld4bf(prow - INCOLS + c); qk_ = ld4bf(prow - INCOLS + 768 + c); qv_ = ld4bf(prow - INCOLS + 1536 + c); }
            const f32x4 r4 = pr_ + (qr_ - pr_) * *(const GAS f32x4*)(w.mu + c), k4 = pk_ + (qk_ - pk_) * *(const GAS f32x4*)(w.mu + 768 + c), v4 = pv_ + (qv_ - pv_) * *(const GAS f32x4*)(w.mu + 1536 + c);
            const f32x4 w04 = *(const GAS f32x4*)(w.w0 + c), a04 = *(const GAS f32x4*)(w.a0 + c), kk4 = *(const GAS f32x4*)(w.kk_ + c), ka4 = *(const GAS f32x4*)(w.ka_ + c), rk4 = *(const GAS f32x4*)(w.rk + c);
            f32x4 dec, a_;
#pragma unroll
            for (int e = 0; e < 4; ++e) { dec[e] = __expf(-DECAY_SCALE * sigmoidf_(w04[e] + cw[e])); a_[e] = sigmoidf_(a04[e] + ca[e]); }
            const f32x4 kkr = k4 * kk4, k2 = k4 * (1.f + (a_ - 1.f) * ka4);
            ss += kkr[0] * kkr[0] + kkr[1] * kkr[1] + kkr[2] * kkr[2] + kkr[3] * kkr[3];
            const f32x4 bb = r4 * k2 * rk4; bon += bb[0] + bb[1] + bb[2] + bb[3];
            { const size_t o = (size_t)tok * RWID + c; *(GAS f32x4*)(R + o) = r4; *(GAS f32x4*)(Wd + o) = dec; *(GAS f32x4*)(K2 + o) = k2; *(GAS f32x4*)(V + o) = v4; *(GAS f32x4*)(Gt + o) = cg; }
            kr[nt] = kkr; aa[nt] = a_; }
        ss += __shfl_xor(ss, 16); ss += __shfl_xor(ss, 32); bon += __shfl_xor(bon, 16); bon += __shfl_xor(bon, 32);
        const float rn = 1.f / fmaxf(sqrtf(ss), 1e-12f);
#pragma unroll
        for (int nt = 0; nt < 4; ++nt) { const size_t o = (size_t)tok * RWID + h * 64 + 16 * nt + 4 * g; const f32x4 kk = kr[nt] * rn;
            *(GAS f32x4*)(KK + o) = kk; *(GAS f32x4*)(KKA + o) = kk * aa[nt]; }
        if (g == 0) BON[tok * 12 + h] = bon; }
    __syncthreads();
}

template <bool IDN>
__device__ __forceinline__ void scan_chunk(int task, gcf RWb, gfp OUTV  , gfp OUTM  , LAS float* ops, int lane) {
    constexpr unsigned AS = (unsigned)MTOK * RWID;
    gcf R = RWb; gcf Wd = RWb + AS; gcf K2 = RWb + 2 * AS; gcf V = RWb + 3 * AS; gcf KK = RWb + 4 * AS; gcf KKA = RWb + 5 * AS;
    const int bh = task / NCH, c = task % NCH, b = bh / RH, h = bh % RH;
    const unsigned base = (unsigned)((b * SEQ + c * TCH) * RWID + h * 64 + lane);
    float st[64];
#pragma unroll
    for (int k = 0; k < 64; ++k) st[k] = (IDN && k == lane) ? 1.f : 0.f;
    float nw = Wd[base], nkk = KK[base], nka = KKA[base], nk = IDN ? 0.f : K2[base], nr = R[base], nv = IDN ? 0.f : V[base];
    for (int i = 0; i < TCH; ++i) {
        LAS float* ob = ops + (i & 1) * 320;
        ob[lane] = nw; ob[64 + lane] = nkk; ob[128 + lane] = nka; if (!IDN) ob[192 + lane] = nk; ob[256 + lane] = nr;
        const float vcur = nv;
        if (i + 1 < TCH) { const unsigned o = base + (unsigned)(i + 1) * RWID; nw = Wd[o]; nkk = KK[o]; nka = KKA[o]; nr = R[o]; if (!IDN) { nk = K2[o]; nv = V[o]; } }
        const LAS f32x4* o4 = (const LAS f32x4*)ob;
        float sk = 0.f;
#pragma unroll
        for (int k4 = 0; k4 < 16; ++k4) { const f32x4 q = o4[16 + k4];
            sk += st[4 * k4] * q.x + st[4 * k4 + 1] * q.y + st[4 * k4 + 2] * q.z + st[4 * k4 + 3] * q.w; }
        float y = 0.f;
#pragma unroll
        for (int k4 = 0; k4 < 16; ++k4) { const f32x4 w4 = o4[k4], a4 = o4[32 + k4], r4 = o4[64 + k4]; f32x4 kv = {0.f, 0.f, 0.f, 0.f}; if (!IDN) kv = o4[48 + k4];
#pragma unroll
            for (int j = 0; j < 4; ++j) { const int k = 4 * k4 + j;
                if (IDN) st[k] = st[k] * w4[j] - sk * a4[j]; else st[k] = st[k] * w4[j] - sk * a4[j] + vcur * kv[j];
                y += st[k] * r4[j]; } }
        OUTV[base + (unsigned)i * RWID] = y;
    }
    if (IDN) { gbp om = (gbp)OUTM + (unsigned)(task * 4096 + lane);
#pragma unroll
        for (int k = 0; k < 64; ++k) om[k * 64] = (bf16)f2bf(st[k]); }
    else { gfp om = OUTM + (unsigned)(task * 4096 + lane);
#pragma unroll
        for (int k = 0; k < 64; ++k) om[k * 64] = st[k]; }
}

__device__ __forceinline__ void scan_carry_mfma(int bh, int vt, gcb PT, gcf SLT, gfp SST, int lane) {
    const int r = lane & 31, h = lane >> 5;
    f32x16 acc[2];
#pragma unroll
    for (int i = 0; i < 16; ++i) { acc[0][i] = 0.f; acc[1][i] = 0.f; }
    s16x4 pa[2][2][2][2]; f32x16 sl[2];
    {   const unsigned tb = (unsigned)(bh * NCH) * 4096u;
#pragma unroll
        for (int mt = 0; mt < 2; ++mt) {
#pragma unroll
            for (int kt = 0; kt < 2; ++kt)
#pragma unroll
                for (int sx = 0; sx < 2; ++sx) { gcb pr = PT + tb + (unsigned)((32 * mt + r) * 64 + 32 * kt + 16 * sx + 4 * h); pa[mt][kt][sx][0] = *(const GAS s16x4*)pr; pa[mt][kt][sx][1] = *(const GAS s16x4*)(pr + 8); }
#pragma unroll
            for (int i = 0; i < 16; ++i) sl[mt][i] = SLT[tb + (unsigned)((32 * mt + crow(i, h)) * 64 + 32 * vt + r)]; } }
    for (int c = 0; c < NCH; ++c) {
        const unsigned tb = (unsigned)(bh * NCH + c) * 4096u;
#pragma unroll
        for (int mt = 0; mt < 2; ++mt)
#pragma unroll
            for (int g = 0; g < 4; ++g) { const f32x4 v = {acc[mt][4 * g], acc[mt][4 * g + 1], acc[mt][4 * g + 2], acc[mt][4 * g + 3]};
                *(GAS f32x4*)(SST + tb + (unsigned)((32 * vt + r) * 64 + 32 * mt + 8 * g + 4 * h)) = v; }
        if (c == NCH - 1) break;
        bf16x8 bfr[2][2], afr[2][2][2];
#pragma unroll
        for (int kt = 0; kt < 2; ++kt)
#pragma unroll
            for (int sx = 0; sx < 2; ++sx) bfr[kt][sx] = pack8(acc[kt][8 * sx], acc[kt][8 * sx + 1], acc[kt][8 * sx + 2], acc[kt][8 * sx + 3], acc[kt][8 * sx + 4], acc[kt][8 * sx + 5], acc[kt][8 * sx + 6], acc[kt][8 * sx + 7]);
#pragma unroll
        for (int mt = 0; mt < 2; ++mt) { acc[mt] = sl[mt];
#pragma unroll
            for (int kt = 0; kt < 2; ++kt)
#pragma unroll
                for (int sx = 0; sx < 2; ++sx) afr[mt][kt][sx] = __builtin_shufflevector(pa[mt][kt][sx][0], pa[mt][kt][sx][1], 0, 1, 2, 3, 4, 5, 6, 7); }
        if (c + 1 < NCH - 1) { const unsigned tn = tb + 4096u;
#pragma unroll
            for (int mt = 0; mt < 2; ++mt) {
#pragma unroll
                for (int kt = 0; kt < 2; ++kt)
#pragma unroll
                    for (int sx = 0; sx < 2; ++sx) { gcb pr = PT + tn + (unsigned)((32 * mt + r) * 64 + 32 * kt + 16 * sx + 4 * h); pa[mt][kt][sx][0] = *(const GAS s16x4*)pr; pa[mt][kt][sx][1] = *(const GAS s16x4*)(pr + 8); }
#pragma unroll
                for (int i = 0; i < 16; ++i) sl[mt][i] = SLT[tn + (unsigned)((32 * mt + crow(i, h)) * 64 + 32 * vt + r)]; } }
#pragma unroll
        for (int mt = 0; mt < 2; ++mt)
#pragma unroll
            for (int kt = 0; kt < 2; ++kt)
#pragma unroll
                for (int sx = 0; sx < 2; ++sx) acc[mt] = MFMA32(afr[mt][kt][sx], bfr[kt][sx], acc[mt]);
    }
}

__device__ __forceinline__ void scan_out(int task, gcf RWb, gcf YL, gcf Z, gcf SST, gcf BON, gcf ln_g, gcf ln_b, gbp Y, LAS float* zb, int lane) {
    constexpr size_t AS = (size_t)MTOK * RWID;
    gcf V = RWb + 3 * AS; gcf Gt = RWb + 6 * AS;
    const int bh = task / NCH, c = task % NCH, b = bh / RH, h = bh % RH;
    const int tok0 = b * SEQ + c * TCH; const int n = h * 64 + lane;
    float S[64];
#pragma unroll
    for (int k4 = 0; k4 < 16; ++k4) { const f32x4 q = *(const GAS f32x4*)(SST + (unsigned)(task * 4096 + lane * 64 + 4 * k4)); S[4 * k4] = q.x; S[4 * k4 + 1] = q.y; S[4 * k4 + 2] = q.z; S[4 * k4 + 3] = q.w; }
    const float lg = ln_g[n], lb = ln_b[n];
    for (int i = 0; i < TCH; ++i) { const int tok = tok0 + i; const size_t o = (size_t)tok * RWID + n;
        zb[(i & 1) * 64 + lane] = Z[o];
        float y = YL[o];
#pragma unroll
        for (int k4 = 0; k4 < 16; ++k4) { const f32x4 q = ((const LAS f32x4*)(zb + (i & 1) * 64))[k4];
            y += S[4 * k4] * q.x + S[4 * k4 + 1] * q.y + S[4 * k4 + 2] * q.z + S[4 * k4 + 3] * q.w; }
        const float mu = wave_sum(y) * (1.f / 64.f); const float d = y - mu; const float var = wave_sum(d * d) * (1.f / 64.f);
        float yn = d * rsqrtf(var + RWKV_LN_EPS) * lg + lb;
        yn += BON[tok * 12 + h] * V[o];
        Y[(size_t)tok * DM + n] = (bf16)f2bf(yn * Gt[o]); }
}

constexpr int ATT_UNITS_PER_BH = 48, ATT_UNITS = BATCH * AH * ATT_UNITS_PER_BH, ATT_KROW = 144, ATT_VROW = 776, ATT_VOFF = 384 * ATT_KROW;
__device__ __forceinline__ void attn_unit(int unit, gcb QKR, gcb PROJ, gfp AOP, gfp LSE, LAS unsigned char* lds, int tid, int wave, int lane) {
    const int bh = unit / ATT_UNITS_PER_BH, uu = unit % ATT_UNITS_PER_BH, b = bh / AH, h = bh % AH;
    int p, d, rho, qb;
    if (uu < 16) { p = 0; d = 1; rho = 0; qb = uu; } else if (uu < 32) { p = 1; d = 4; rho = (uu - 16) >> 2; qb = (uu - 16) & 3; } else { p = 2; d = 16; rho = uu - 32; qb = 0; }
    const int i0 = qb * 256;
    LAS unsigned char* Kl = lds; LAS unsigned char* Vl = lds + ATT_VOFF;
#pragma unroll
    for (int it = 0; it < 6; ++it) { const int idx = tid + 512 * it, key = idx % 384, piece = idx / 384; const int ki = i0 - 128 + key;
        v4u kv = {0u, 0u, 0u, 0u}, vv = {0u, 0u, 0u, 0u};
        if (ki >= 0) { const unsigned tokk = (unsigned)(b * SEQ + rho + d * ki);
            kv = *(const GAS v4u*)(QKR + tokk * 1536u + 768u + (unsigned)(h * 64 + piece * 8));
            vv = *(const GAS v4u*)(PROJ + (size_t)tokk * INCOLS + VOFF + h * 64 + piece * 8); }
        *(LAS v4u*)(Kl + key * ATT_KROW + piece * 16) = kv;
        LAS unsigned short* vd = (LAS unsigned short*)(Vl + (piece * 8) * ATT_VROW + key * 2);
        vd[0 * (ATT_VROW / 2)] = (unsigned short)(vv.x & 0xffffu); vd[1 * (ATT_VROW / 2)] = (unsigned short)(vv.x >> 16);
        vd[2 * (ATT_VROW / 2)] = (unsigned short)(vv.y & 0xffffu); vd[3 * (ATT_VROW / 2)] = (unsigned short)(vv.y >> 16);
        vd[4 * (ATT_VROW / 2)] = (unsigned short)(vv.z & 0xffffu); vd[5 * (ATT_VROW / 2)] = (unsigned short)(vv.z >> 16);
        vd[6 * (ATT_VROW / 2)] = (unsigned short)(vv.w & 0xffffu); vd[7 * (ATT_VROW / 2)] = (unsigned short)(vv.w >> 16); }
    __syncthreads();
    const int r = lane & 31, hh = lane >> 5;
    const int iq0 = i0 + 32 * wave;
    const unsigned tokq = (unsigned)(b * SEQ + rho + d * (iq0 + r));
    bf16x8 qf[4];
#pragma unroll
    for (int sx = 0; sx < 4; ++sx) qf[sx] = *(const GAS bf16x8*)(QKR + tokq * 1536u + (unsigned)(h * 64 + 16 * sx + 8 * hh));
    float m = -1e30f, l = 0.f;
    f32x16 o[2];
#pragma unroll
    for (int i = 0; i < 16; ++i) { o[0][i] = 0.f; o[1][i] = 0.f; }
#pragma unroll
    for (int j = 0; j < 5; ++j) {
        const int kk0 = 32 * wave + 32 * j, kabs0 = iq0 - 128 + 32 * j;
        if (kabs0 + 31 < 0) continue;
        f32x16 st;
#pragma unroll
        for (int i = 0; i < 16; ++i) st[i] = 0.f;
#pragma unroll
        for (int sx = 0; sx < 4; ++sx) { const bf16x8 a = *(const LAS bf16x8*)(Kl + (kk0 + r) * ATT_KROW + (16 * sx + 8 * hh) * 2); st = MFMA32(a, qf[sx], st); }
        bool ok[16]; float tmax = -1e30f;
#pragma unroll
        for (int i = 0; i < 16; ++i) { const int row = crow(i, hh); ok[i] = (kabs0 + row >= 0) && (j != 0 || row >= r) && (j != 4 || row <= r); tmax = fmaxf(tmax, ok[i] ? st[i] : -1e30f); }
        tmax = fmaxf(tmax, __shfl_xor(tmax, 32));
        const float mnew = fmaxf(m, tmax), alpha = exp2f(m - mnew);
        float pr[16], ps = 0.f;
#pragma unroll
        for (int i = 0; i < 16; ++i) { pr[i] = ok[i] ? exp2f(st[i] - mnew) : 0.f; ps += pr[i]; }
        l = l * alpha + ps; m = mnew;
#pragma unroll
        for (int i = 0; i < 16; ++i) { o[0][i] *= alpha; o[1][i] *= alpha; }
#pragma unroll
        for (int s2 = 0; s2 < 2; ++s2) { const bf16x8 bfrag = pack8(pr[8 * s2], pr[8 * s2 + 1], pr[8 * s2 + 2], pr[8 * s2 + 3], pr[8 * s2 + 4], pr[8 * s2 + 5], pr[8 * s2 + 6], pr[8 * s2 + 7]);
#pragma unroll
            for (int mt = 0; mt < 2; ++mt) { const LAS unsigned char* ap = Vl + (32 * mt + r) * ATT_VROW + (kk0 + 16 * s2 + 4 * hh) * 2;
                const s16x4 lo = *(const LAS s16x4*)ap, hi = *(const LAS s16x4*)(ap + 16);
                const bf16x8 a = __builtin_shufflevector(lo, hi, 0, 1, 2, 3, 4, 5, 6, 7);
                o[mt] = MFMA32(a, bfrag, o[mt]); } }
    }
    const float ltot = l + __shfl_xor(l, 32), inv = 1.f / ltot;
    gfp op = AOP + (size_t)p * MTOK * AWID + (size_t)tokq * AWID + h * 64;
#pragma unroll
    for (int mt = 0; mt < 2; ++mt)
#pragma unroll
        for (int g = 0; g < 4; ++g) { const f32x4 v = {o[mt][4 * g] * inv, o[mt][4 * g + 1] * inv, o[mt][4 * g + 2] * inv, o[mt][4 * g + 3] * inv};
            *(GAS f32x4*)(op + 32 * mt + 8 * g + 4 * hh) = v; }
    if (hh == 0) LSE[(size_t)p * MTOK * AH + tokq * AH + h] = (m + log2f(ltot)) * 0.6931471805599453f;
    __syncthreads();
}

__device__ __forceinline__ void attn_norm_token(int tok, gcf AOP, gcf LSE, gcf g, gbp Y, int lane) {
    float v[12], ss = 0.f;
#pragma unroll
    for (int i = 0; i < 12; ++i) { const float l0 = LSE[(size_t)tok * AH + i], l1 = LSE[(size_t)MTOK * AH + (size_t)tok * AH + i], l2 = LSE[2 * (size_t)MTOK * AH + (size_t)tok * AH + i];
        const float mx = fmaxf(fmaxf(l0, l1), l2), w0 = __expf(l0 - mx), w1 = __expf(l1 - mx), w2 = __expf(l2 - mx);
        const size_t o = (size_t)tok * AWID + lane + 64 * i;
        v[i] = (w0 * AOP[o] + w1 * AOP[(size_t)MTOK * AWID + o] + w2 * AOP[2 * (size_t)MTOK * AWID + o]) / (w0 + w1 + w2); ss += v[i] * v[i]; }
    const float rstd = rsqrtf(wave_sum(ss) * (1.f / AWID) + NORM_EPS);
#pragma unroll
    for (int i = 0; i < 12; ++i) Y[(size_t)tok * DM + RWID + lane + 64 * i] = (bf16)f2bf(v[i] * rstd * g[lane + 64 * i]);
}

__device__ __forceinline__ void sgu_token(int tok, gcf SU, gcf SVN, gcf ws  , gcf bs  , gcf ng, gbp Y, int lane) {
    const int i = tok % 128; const int tok0 = tok - i;
    float q[8], ss = 0.f;
#pragma unroll
    for (int g = 0; g < 8; ++g) { float acc = 0.f; gcf wr = ws + ((size_t)g * 128 + i) * 128; gcf vp = SVN + (size_t)tok0 * GWID + g * 64 + lane;
        for (int j = 0; j <= i; ++j) acc += wr[j] * vp[(size_t)j * GWID];
        const float vo = acc + bs[g * 128 + i]; q[g] = SU[(size_t)tok * GWID + g * 64 + lane] * vo; ss += q[g] * q[g]; }
    const float rstd = rsqrtf(wave_sum(ss) * (1.f / GWID) + NORM_EPS);
#pragma unroll
    for (int g = 0; g < 8; ++g) Y[(size_t)tok * DM + RWID + AWID + g * 64 + lane] = (bf16)f2bf(q[g] * rstd * ng[g * 64 + lane]);
}

__device__ __forceinline__ void conv_item(int item, gcb UP, gcf cw, gcf cb, gbp H) {
    const int tok = item / (DFF / 8), j8 = (item % (DFF / 8)) * 8, t = tok % SEQ;
    float gt[8], vl[8];
#pragma unroll
    for (int e = 0; e < 8; ++e) { gt[e] = cb[j8 + e]; vl[e] = cb[DFF + j8 + e]; }
#pragma unroll
    for (int tap = 0; tap < 3; ++tap) { const int dt = 2 - tap;
        if (t - dt >= 0) { gcb ur = UP + (size_t)(tok - dt) * UPN; const v4u ug = *(const GAS v4u*)(ur + j8), uv = *(const GAS v4u*)(ur + DFF + j8);
            gcf wg = cw + (size_t)tap * UPN + j8; gcf wv = wg + DFF;
            const unsigned a[4] = {ug.x, ug.y, ug.z, ug.w}, c[4] = {uv.x, uv.y, uv.z, uv.w};
#pragma unroll
            for (int e = 0; e < 4; ++e) { gt[2 * e] += bflo(a[e]) * wg[2 * e]; gt[2 * e + 1] += bfhi(a[e]) * wg[2 * e + 1]; vl[2 * e] += bflo(c[e]) * wv[2 * e]; vl[2 * e + 1] += bfhi(c[e]) * wv[2 * e + 1]; } } }
    v4u o; o.x = pk2(gelu_tanh(gt[0]) * vl[0], gelu_tanh(gt[1]) * vl[1]); o.y = pk2(gelu_tanh(gt[2]) * vl[2], gelu_tanh(gt[3]) * vl[3]);
    o.z = pk2(gelu_tanh(gt[4]) * vl[4], gelu_tanh(gt[5]) * vl[5]); o.w = pk2(gelu_tanh(gt[6]) * vl[6], gelu_tanh(gt[7]) * vl[7]);
    *(GAS v4u*)(H + (size_t)tok * DFF + j8) = o;
}

typedef const __attribute__((address_space(4))) unsigned long long* kargs_t;
__device__ __forceinline__ kargs_t kargs() { kargs_t ka = (kargs_t)__builtin_amdgcn_kernarg_segment_ptr(); asm volatile("" : "+s"(ka)); return ka; }
#define KIN(i) ((gcf)ka[i])
#define KOUT ((gfp)ka[29])
#define KWS ((GAS unsigned char*)ka[30])
constexpr size_t AS_ = (size_t)MTOK * RWID;
__device__ __forceinline__ int lane_id() { int l; asm volatile("v_mbcnt_lo_u32_b32 %0, -1, 0\n\tv_mbcnt_hi_u32_b32 %0, -1, %0" : "=v"(l)); return l; }
#define PH_IDS const int lane = lane_id(); const int tid = wave * 64 + lane; (void)tid
#define GBAR() do { const int lane_b = lane_id(); kargs_t kb = kargs(); XcdBarrier bb; bb.bar = (unsigned*)((GAS unsigned*)((GAS unsigned char*)kb[30] + WS_CTL) + CW_BAR); bb.x = xb_xcc_id(); \
    bb.st = (volatile LAS unsigned*)(lds + MISC_OFF) + 8; xcd_barrier(bb, wave * 64 + lane_b); } while (0)

__global__ void __launch_bounds__(NTHR, 2) mega_fwd(Params p) {
    extern __shared__ __attribute__((aligned(16))) unsigned char lds_raw[];
    LAS unsigned char* lds = (LAS unsigned char*)lds_raw;
    const int wave = __builtin_amdgcn_readfirstlane((int)threadIdx.x >> 6);
    const int G = gridDim.x, gw = blockIdx.x * NWAVES + wave, ngw = G * NWAVES;
    { PH_IDS; kargs_t ka = kargs();
      for (int u = tid; u < (LDS_BYTES - LDSCTL_OFF) / 4; u += NTHR) ((LAS unsigned*)(lds + LDSCTL_OFF))[u] = 0u;
      __syncthreads();
      (void)xcd_barrier_post((unsigned*)((GAS unsigned*)(KWS + WS_CTL) + CW_BAR), (volatile LAS unsigned*)(lds + MISC_OFF) + 8, tid); }

    {
        PH_IDS; kargs_t ka = kargs(); GAS unsigned char* ws = KWS;
        LAS float* scr = (LAS float* )(lds + wave * 16384);
        for (int l = 0; l < DEPTH; ++l) {
            for (int it = gw; it < (DM / 64) * (INCOLS / 32); it += ngw) p0_transpose_item(KIN(6) + (size_t)l * DM * INCOLS, DM, INCOLS, (gbp)(ws + WS_WIN) + (size_t)l * INCOLS * DM, 0, scr, it, lane);
            for (int it = gw; it < (DM / 64) * (DM / 32); it += ngw) p0_transpose_item(KIN(24) + (size_t)l * DM * DM, DM, DM, (gbp)(ws + WS_WOUT) + (size_t)l * DM * DM, 0, scr, it, lane);
            for (int it = gw; it < (DM / 64) * (UPN / 32); it += ngw) p0_transpose_item(KIN(25) + (size_t)l * DM * UPN, DM, UPN, (gbp)(ws + WS_WUP) + (size_t)l * UPN * DM, 0, scr, it, lane);
            for (int it = gw; it < (DFF / 64) * (DM / 32); it += ngw) p0_transpose_item(KIN(28) + (size_t)l * DFF * DM, DFF, DM, (gbp)(ws + WS_WDN) + (size_t)l * DM * DFF, 0, scr, it, lane);
        }
        {
            gbp LW = (gbp)(ws + WS_LORA);
            for (int i = blockIdx.x * NTHR + tid; i < DEPTH * LORA_L; i += G * NTHR) { const int l = i / LORA_L, rr = i % LORA_L;
                float v; if (rr < RWID * 64) { const int n = rr / 64, k = rr % 64; v = KIN(9)[(size_t)l * 64 * RWID + k * RWID + n]; }
                else if (rr < RWID * 128) { const int q = rr - RWID * 64, n = q / 64, k = q % 64; v = KIN(11)[(size_t)l * 64 * RWID + k * RWID + n]; }
                else { const int q = rr - RWID * 128, n = q / 128, k = q % 128; v = KIN(12)[(size_t)l * 128 * RWID + k * RWID + n]; }
                LW[i] = (bf16)f2bf(v); } }
        rowpass(KIN(0), nullptr, nullptr, nullptr, KIN(2), (gbp)(ws + WS_HN), gw, ngw, lane);
    }
    GBAR();

    for (int l = 0; l < DEPTH; ++l) {
        { PH_IDS; kargs_t ka = kargs(); GAS unsigned char* ws = KWS;
          pg8::Gemm g{(gbp)(ws + WS_HN), (gbp)(ws + WS_WIN) + (size_t)l * INCOLS * DM, MTOK, INCOLS, DM}; pg8::StaticOrder S; S.init(MTOK, INCOLS, G, (int)blockIdx.x);
          pg8::EpiBf16<0> E{(gbp)(ws + WS_PROJ), INCOLS, nullptr, 0, 0, 1.f};
          pg8::gemm_phase<pg8::EpiBf16<0>, pg8::StaticOrder, true, true>(lds, g, S, E, tid); }
        GBAR();
        { PH_IDS; kargs_t ka = kargs(); GAS unsigned char* ws = KWS;
          gcb LW = (gcb)(ws + WS_LORA) + (size_t)l * LORA_L;
          RPW rw{KIN(7) + (size_t)l * RCOLS, KIN(8) + (size_t)l * RWID, KIN(10) + (size_t)l * RWID, KIN(13) + (size_t)l * RWID, KIN(14) + (size_t)l * RWID, KIN(15) + (size_t)l * RWID, LW, LW + RWID * 64, LW + RWID * 128};
          for (int u = blockIdx.x; u < MTOK / 32; u += G) rwkv_prep_unit(u, (gcb)(ws + WS_PROJ), rw, (gfp)(ws + WS_RW), (gfp)(ws + WS_BON), lds, tid, wave, lane);
          PrepW w{KIN(19) + (size_t)l * GWID, KIN(20) + (size_t)l * GWID, (gci)KIN(1)};
          gfp SU = (gfp)(ws + WS_SGU);
          for (int tok = gw; tok < MTOK; tok += ngw) prep_token(tok, (gcb)(ws + WS_PROJ), w, (gbp)(ws + WS_QKR), SU, SU + (size_t)MTOK * GWID, lane); }
        GBAR();
        { PH_IDS; kargs_t ka = kargs(); GAS unsigned char* ws = KWS;
          LAS float* ops = (LAS float*)(lds + wave * 4096);
          gfp RWb = (gfp)(ws + WS_RW); gfp PT = (gfp)(ws + WS_CHK);
          for (int task = gw; task < 2 * NTASK_SCAN; task += ngw) { if (task < NTASK_SCAN) scan_chunk<false>(task, RWb, RWb + 7 * AS_, PT + (size_t)NTASK_SCAN * 4096, ops, lane); else scan_chunk<true>(task - NTASK_SCAN, RWb, RWb + 8 * AS_, PT, ops, lane); } }
        GBAR();
        { PH_IDS; kargs_t ka = kargs(); GAS unsigned char* ws = KWS;
          gfp PT = (gfp)(ws + WS_CHK); gfp SU = (gfp)(ws + WS_SGU);
          if (wave < 2 && blockIdx.x < BATCH * RH) scan_carry_mfma((int)blockIdx.x, wave, (gcb)PT, PT + (size_t)NTASK_SCAN * 4096, PT + 2 * (size_t)NTASK_SCAN * 4096, lane);
          volatile LAS unsigned* MISC = (volatile LAS unsigned*)(lds + MISC_OFF);
          gu32* ctr = (gu32*)(ws + WS_CTL) + CW_ATT + 64 * l;
          for (;;) {
              if (tid == 0) MISC[16] = __hip_atomic_fetch_add(ctr, 1u, __ATOMIC_RELAXED, __HIP_MEMORY_SCOPE_AGENT);
              __syncthreads();
              const int u = (int)MISC[16];
              if (u >= ATT_UNITS) break;
              attn_unit(u, (gcb)(ws + WS_QKR), (gcb)(ws + WS_PROJ), (gfp)(ws + WS_AO), (gfp)(ws + WS_LSE), lds, tid, wave, lane);
          }
          for (int tok = gw; tok < MTOK; tok += ngw) sgu_token(tok, SU, SU + (size_t)MTOK * GWID, KIN(21) + (size_t)l * 8 * 128 * 128, KIN(22) + (size_t)l * 8 * 128, KIN(23) + (size_t)l * GWID, (gbp)(ws + WS_Y), lane); }
        GBAR();
        { PH_IDS; kargs_t ka = kargs(); GAS unsigned char* ws = KWS;
          LAS float* zb = (LAS float*)(lds + wave * 1024);
          gfp RWb = (gfp)(ws + WS_RW); gfp PT = (gfp)(ws + WS_CHK);
          for (int task = gw; task < NTASK_SCAN; task += ngw) scan_out(task, RWb, RWb + 7 * AS_, RWb + 8 * AS_, PT + 2 * (size_t)NTASK_SCAN * 4096, (gfp)(ws + WS_BON), KIN(16) + (size_t)l * RWID, KIN(17) + (size_t)l * RWID, (gbp)(ws + WS_Y), zb, lane);
          for (int tok = gw; tok < MTOK; tok += ngw) attn_norm_token(tok, (gcf)(ws + WS_AO), (gcf)(ws + WS_LSE), KIN(18) + (size_t)l * AWID, (gbp)(ws + WS_Y), lane); }
        GBAR();
        { PH_IDS; kargs_t ka = kargs(); GAS unsigned char* ws = KWS;
          pg8::Gemm g{(gbp)(ws + WS_Y), (gbp)(ws + WS_WOUT) + (size_t)l * DM * DM, MTOK, DM, DM}; pg8::StaticOrder S; S.init(MTOK, DM, G, (int)blockIdx.x);
          pg8::EpiF32 E{(gfp)(ws + WS_O), DM};
          pg8::gemm_phase<pg8::EpiF32, pg8::StaticOrder, true, true>(lds, g, S, E, tid); }
        GBAR();
        { PH_IDS; kargs_t ka = kargs(); GAS unsigned char* ws = KWS;
          rowpass(l == 0 ? KIN(0) : (gcf)KOUT, (gfp)(ws + WS_O), KIN(3) + (size_t)l * DM, KOUT, KIN(4) + (size_t)l * DM, (gbp)(ws + WS_HN), gw, ngw, lane); }
        GBAR();
        { PH_IDS; kargs_t ka = kargs(); GAS unsigned char* ws = KWS;
          pg8::Gemm g{(gbp)(ws + WS_HN), (gbp)(ws + WS_WUP) + (size_t)l * UPN * DM, MTOK, UPN, DM}; pg8::StaticOrder S; S.init(MTOK, UPN, G, (int)blockIdx.x);
          pg8::EpiBf16<0> E{(gbp)(ws + WS_UP), UPN, nullptr, 0, 0, 1.f};
          pg8::gemm_phase<pg8::EpiBf16<0>, pg8::StaticOrder, true, true>(lds, g, S, E, tid); }
        GBAR();
        { PH_IDS; kargs_t ka = kargs(); GAS unsigned char* ws = KWS;
          const int gtid = blockIdx.x * NTHR + tid, ngt = G * NTHR;
          for (int it = gtid; it < MTOK * (DFF / 8); it += ngt) conv_item(it, (gbp)(ws + WS_UP), KIN(26) + (size_t)l * 3 * UPN, KIN(27) + (size_t)l * UPN, (gbp)(ws + WS_H)); }
        GBAR();
        { PH_IDS; kargs_t ka = kargs(); GAS unsigned char* ws = KWS;
          pg8::Gemm g{(gbp)(ws + WS_H), (gbp)(ws + WS_WDN) + (size_t)l * DM * DFF, MTOK, DM, DFF}; pg8::StaticOrder S; S.init(MTOK, DM, G, (int)blockIdx.x);
          pg8::EpiF32 E{(gfp)(ws + WS_O), DM};
          pg8::gemm_phase<pg8::EpiF32, pg8::StaticOrder, true, true>(lds, g, S, E, tid); }
        GBAR();
        { PH_IDS; kargs_t ka = kargs(); GAS unsigned char* ws = KWS;
          rowpass(KOUT, (gfp)(ws + WS_O), KIN(5) + (size_t)l * DM, KOUT, l + 1 < DEPTH ? KIN(2) + (size_t)(l + 1) * DM : nullptr, (gbp)(ws + WS_HN), gw, ngw, lane); }
        if (l + 1 < DEPTH) GBAR();
    }
}

extern "C" void kernel_launch(void* const* d_in, const int* in_sizes, int n_in, void* d_out, int out_size, void* d_ws, size_t ws_size, hipStream_t stream) {
    static int grid = 0;
    if (grid == 0) {
        if (n_in != 29 || out_size != MTOK * DM || ws_size < WS_END) { fprintf(stderr, "kernel_launch: unexpected shapes (n_in %d out %d ws %zu need %zu)\n", n_in, out_size, ws_size, (size_t)WS_END); grid = -1; return; }
        int dev = 0, cus = 0, per_cu = 0;
        if (hipGetDevice(&dev) != hipSuccess || hipDeviceGetAttribute(&cus, hipDeviceAttributeMultiprocessorCount, dev) != hipSuccess) { grid = -1; return; }
        if (hipFuncSetAttribute((const void*)mega_fwd, hipFuncAttributeMaxDynamicSharedMemorySize, LDS_BYTES) != hipSuccess) { fprintf(stderr, "kernel_launch: hipFuncSetAttribute failed\n"); grid = -1; return; }
        if (hipOccupancyMaxActiveBlocksPerMultiprocessor(&per_cu, (const void*)mega_fwd, NTHR, LDS_BYTES) != hipSuccess || per_cu < 1) fprintf(stderr, "kernel_launch: occupancy query says %d\n", per_cu);
        (void)hipGetLastError();
        grid = cus;
    }
    if (grid < 0) return;
    if (hipMemsetAsync((char*)d_ws + WS_CTL, 0, CTL_ZERO_BYTES, stream) != hipSuccess) return;
    Params prm{};
    for (int i = 0; i < 29; ++i) prm.in[i] = (const float*)d_in[i];
    prm.out = (float*)d_out; prm.ws = (unsigned char*)d_ws;
    hipLaunchKernelGGL(mega_fwd, dim3(grid), dim3(NTHR), LDS_BYTES, stream, prm);
}
```

```cpp
#include <hip/hip_runtime.h>
#include <cstdio>
#include <cstdint>
namespace pg8 {
#define PG8_LAS __attribute__((address_space(3)))
#define PG8_GAS __attribute__((address_space(1)))
typedef unsigned short bf16_t;
typedef short bf16x8 __attribute__((ext_vector_type(8)));
typedef float f32x4 __attribute__((ext_vector_type(4)));
typedef unsigned u32x4 __attribute__((ext_vector_type(4)));
constexpr int BM = 256, BK = 64, HALF = 128, HTB = HALF * BK * 2  , STAGE_BYTES = 8 * HTB, NXCD = 8, WGM = 8;

__host__ __device__ __forceinline__ int lds_byte(int r, int c) { const int st = (r >> 4) * 2 + (c >> 5), rr = r & 15, cc = c & 31, ob = rr * 64 + cc * 2; return st * 1024 + (ob ^ (((ob >> 9) & 1) << 5)); }
__host__ __device__ __forceinline__ void stage_rc(int b, int& R, int& C) { const int st = b / 1024, sb = b % 1024, swz = sb ^ (((sb >> 9) & 1) << 5); R = (st >> 1) * 16 + swz / 64; C = (st & 1) * 32 + (swz % 64) / 2; }
__host__ __device__ __forceinline__ int perm32(int rho) { const int n = rho >> 4, i = rho & 15; return 8 * (i >> 2) + 4 * n + (i & 3); }

struct Unit { int pm, pn; };
struct Gemm { const PG8_GAS bf16_t* A; const PG8_GAS bf16_t* Bt; int M, N, K; };

struct StaticOrder {
    int nM, nN, nwg, G, c;
    __host__ __device__ void init(int M, int N, int G_, int c_) { nM = M / BM; nN = N / BM; nwg = nM * nN; G = G_; c = c_; }
    __host__ __device__ bool next(int i, Unit& u) const {
        const long L = (long)i * G + c; if (L >= nwg) return false;
        int wgid = (int)L; { const int q = nwg / NXCD, r = nwg % NXCD, xcd = wgid % NXCD, off = wgid / NXCD; wgid = (xcd < r ? xcd * (q + 1) : r * (q + 1) + (xcd - r) * q) + off; }
        const int nig = WGM * nN, gid = wgid / nig, fm = gid * WGM, gsz = (nM - fm) < WGM ? (nM - fm) : WGM;
        u.pm = fm + ((wgid % nig) % gsz); u.pn = (wgid % nig) / gsz; return true;
    }
    __device__ __forceinline__ void a_ready(const Unit&) const {}
    __device__ __forceinline__ void done(const Unit&) const {}
};

__device__ __forceinline__ unsigned cvt_pk_bf16(float lo, float hi) { unsigned r; asm volatile("v_cvt_pk_bf16_f32 %0, %1, %2" : "=v"(r) : "v"(lo), "v"(hi)); return r; }
typedef float f32x2 __attribute__((ext_vector_type(2)));
__device__ __forceinline__ f32x2 gelu_pk(f32x2 v) {
    const f32x2 av = __builtin_elementwise_abs(v), d = av * 0.2316418882f + 1.0f;
    f32x2 t; t.x = __builtin_amdgcn_rcpf(d.x); t.y = __builtin_amdgcn_rcpf(d.y);
    f32x2 q = t * 0.5307027145f + (-0.7265760135f); q = q * t + 0.7107068705f; q = q * t + (-0.142248368f); q = q * t + 0.127414796f; q = q * t;
    const f32x2 s = (v * v) * (-0.72134752044f);
    f32x2 e; e.x = __builtin_amdgcn_exp2f(s.x); e.y = __builtin_amdgcn_exp2f(s.y);
    const f32x2 m = v * (q * e), r = v - m;
    f32x2 o; o.x = v.x < 0.f ? m.x : r.x; o.y = v.y < 0.f ? m.y : r.y; return o;
}

template <int ACT  > struct EpiBf16 {
    static constexpr bool PERM = true, AFTER_DRAIN = false; static_assert(ACT == 0 || ACT == 1, "EpiBf16: ACT is 0 (none) or 1 (gelu_pk)");
    PG8_GAS bf16_t* O; int ldc; const PG8_GAS float* bias; int split_cols; size_t split_stride; float scale0;
    __device__ __forceinline__ void operator()(const f32x4 (&acc)[2][2][4][2], const Unit& u, int wr, int wc, int fr, int fq) const {
        const int row0 = u.pm * BM + wr * 64 + fr; int colt = u.pn * BM; PG8_GAS bf16_t* base = O;
        float sc = 1.f; if (split_cols) { const int t = colt / split_cols; base += (size_t)t * split_stride; colt -= t * split_cols; if (t == 0) sc = scale0; }
        const int col0 = colt + wc * 32 + 8 * fq, bcol0 = u.pn * BM + wc * 32 + 8 * fq;
        f32x4 bv[2][2];
#pragma unroll
        for (int bj = 0; bj < 2; ++bj)
#pragma unroll
            for (int n = 0; n < 2; ++n) bv[bj][n] = bias ? *(const PG8_GAS f32x4*)(bias + bcol0 + bj * HALF + 4 * n) : (f32x4){0.f, 0.f, 0.f, 0.f};
#pragma unroll
        for (int ai = 0; ai < 2; ++ai)
#pragma unroll
            for (int m = 0; m < 4; ++m) { PG8_GAS bf16_t* rowp = base + (size_t)(row0 + ai * HALF + m * 16) * ldc + col0;
#pragma unroll
                for (int bj = 0; bj < 2; ++bj) { f32x4 v0 = acc[ai][bj][m][0] + bv[bj][0], v1 = acc[ai][bj][m][1] + bv[bj][1];
                    if (ACT == 1) { f32x2 a = gelu_pk((f32x2){v0[0], v0[1]}), b = gelu_pk((f32x2){v0[2], v0[3]}), c = gelu_pk((f32x2){v1[0], v1[1]}), d = gelu_pk((f32x2){v1[2], v1[3]});
                        v0 = (f32x4){a.x, a.y, b.x, b.y}; v1 = (f32x4){c.x, c.y, d.x, d.y}; }
                    v0 = v0 * sc; v1 = v1 * sc; u32x4 w; w.x = cvt_pk_bf16(v0[0], v0[1]); w.y = cvt_pk_bf16(v0[2], v0[3]); w.z = cvt_pk_bf16(v1[0], v1[1]); w.w = cvt_pk_bf16(v1[2], v1[3]);
                    *(PG8_GAS u32x4*)(rowp + bj * HALF) = w; } }
    }
};
struct EpiF32 {
    static constexpr bool PERM = true, AFTER_DRAIN = false;
    PG8_GAS float* O; int ldc;
    __device__ __forceinline__ void operator()(const f32x4 (&acc)[2][2][4][2], const Unit& u, int wr, int wc, int fr, int fq) const {
        const int row0 = u.pm * BM + wr * 64 + fr, col0 = u.pn * BM + wc * 32 + 8 * fq;
#pragma unroll
        for (int ai = 0; ai < 2; ++ai)
#pragma unroll
            for (int m = 0; m < 4; ++m) { PG8_GAS float* rowp = O + (size_t)(row0 + ai * HALF + m * 16) * ldc + col0;
#pragma unroll
                for (int bj = 0; bj < 2; ++bj) { *(PG8_GAS f32x4*)(rowp + bj * HALF) = acc[ai][bj][m][0]; *(PG8_GAS f32x4*)(rowp + bj * HALF + 4) = acc[ai][bj][m][1]; } }
    }
};

template <class Epi, class Sched, bool ALIGN_EPI = false, bool SP2 = false>
__device__ __forceinline__ void gemm_phase(PG8_LAS unsigned char* lds, const Gemm g, const Sched& S, const Epi& E, const int tid) {
    const int wid = __builtin_amdgcn_readfirstlane(tid >> 6), lane = tid & 63, wr = wid >> 2, wc = wid & 3, fr = lane & 15, fq = lane >> 4;
    const int K = g.K, nt = K / BK;
    unsigned voffA[2], voffB[2];
#pragma unroll
    for (int i = 0; i < 2; ++i) { int R, C; stage_rc(tid * 16 + i * 8192, R, C); const int Rb = Epi::PERM ? ((R & ~31) + perm32(R & 31)) : R;
        voffA[i] = (unsigned)(R * K + C) * 2u; voffB[i] = (unsigned)(Rb * K + C) * 2u; }
    const size_t kstep = (size_t)(BK * 2);
    const size_t hstep = (size_t)HALF * K * 2;
    const size_t tstep = 2 * hstep;
    const unsigned ldsw = (unsigned)wid * 1024u;
    const int aoff = lds_byte(wr * 64 + fr, fq * 8), boff = lds_byte(wc * 32 + fr, fq * 8);
#define PG8_SA(b, h) (((b) * 2 + (h)) * HTB)
#define PG8_SB(b, h) ((4 + (b) * 2 + (h)) * HTB)
#define PG8_STAGE(bufoff, gbase, voff) do { _Pragma("unroll") for (int _i = 0; _i < 2; ++_i) \
        __builtin_amdgcn_global_load_lds((const PG8_GAS unsigned*)((const PG8_GAS char*)(gbase) + (voff)[_i]), (PG8_LAS unsigned*)(lds + (bufoff) + ldsw + _i * 8192), 16, 0, 0); } while (0)
#define PG8_LDA(dst, b, h) do { _Pragma("unroll") for (int m = 0; m < 4; ++m) _Pragma("unroll") for (int k = 0; k < 2; ++k) dst[m][k] = *(const PG8_LAS bf16x8*)(lds + PG8_SA(b, h) + aoff + m * 2048 + k * 1024); } while (0)
#define PG8_LDB(dst, b, h) do { _Pragma("unroll") for (int n = 0; n < 2; ++n) _Pragma("unroll") for (int k = 0; k < 2; ++k) dst[n][k] = *(const PG8_LAS bf16x8*)(lds + PG8_SB(b, h) + boff + n * 2048 + k * 1024); } while (0)
#define PG8_MMA(ai, bj, At, Bt) do { __builtin_amdgcn_s_setprio(1); _Pragma("unroll") for (int m = 0; m < 4; ++m) _Pragma("unroll") for (int n = 0; n < 2; ++n) _Pragma("unroll") for (int k = 0; k < 2; ++k) \
        acc[ai][bj][m][n] = __builtin_amdgcn_mfma_f32_16x16x32_bf16(Bt[n][k], At[m][k], acc[ai][bj][m][n], 0, 0, 0); __builtin_amdgcn_s_setprio(0); } while (0)
#define PG8_WAIT_V(n) asm volatile("s_waitcnt vmcnt(" #n ")" ::: "memory")
#define PG8_WAIT_L(n) asm volatile("s_waitcnt lgkmcnt(" #n ")" ::: "memory")
#define PG8_BAR __builtin_amdgcn_s_barrier()
#define PG8_SCHED __builtin_amdgcn_sched_barrier(0)
    Unit cur, nxt; int ui = 0;
    if (!S.next(0, cur)) return;
    f32x4 acc[2][2][4][2];
#pragma unroll
    for (int a = 0; a < 2; ++a)
#pragma unroll
        for (int b = 0; b < 2; ++b)
#pragma unroll
            for (int m = 0; m < 4; ++m)
#pragma unroll
                for (int n = 0; n < 2; ++n) acc[a][b][m][n] = (f32x4){0.f, 0.f, 0.f, 0.f};
    bf16x8 At[4][2], B0[2][2], B1[2][2];
    const PG8_GAS char* cA = (const PG8_GAS char*)g.A + (size_t)cur.pm * tstep; const PG8_GAS char* cB = (const PG8_GAS char*)g.Bt + (size_t)cur.pn * tstep;
    S.a_ready(cur);
    if constexpr (SP2) {
        PG8_STAGE(PG8_SB(0, 0), cB, voffB); PG8_STAGE(PG8_SB(0, 1), cB + hstep, voffB); PG8_STAGE(PG8_SA(0, 0), cA, voffA); PG8_STAGE(PG8_SA(0, 1), cA + hstep, voffA);
        if (wr == 1) PG8_BAR;
        PG8_WAIT_V(2); PG8_BAR;
        PG8_STAGE(PG8_SB(1, 0), cB + kstep, voffB); PG8_STAGE(PG8_SA(1, 0), cA + kstep, voffA); PG8_STAGE(PG8_SB(1, 1), cB + hstep + kstep, voffB);
        PG8_WAIT_V(6); PG8_BAR;
    } else {
        PG8_STAGE(PG8_SB(0, 0), cB, voffB); PG8_STAGE(PG8_SA(0, 0), cA, voffA); PG8_STAGE(PG8_SB(0, 1), cB + hstep, voffB); PG8_STAGE(PG8_SA(0, 1), cA + hstep, voffA);
        if (wr == 1) PG8_BAR;
        PG8_WAIT_V(4); PG8_BAR;
        PG8_STAGE(PG8_SB(1, 0), cB + kstep, voffB); PG8_STAGE(PG8_SA(1, 0), cA + kstep, voffA); PG8_STAGE(PG8_SB(1, 1), cB + hstep + kstep, voffB);
        PG8_WAIT_V(6); PG8_BAR;
    }
    for (;;) {
        const bool has_next = S.next(ui + 1, nxt);
        const PG8_GAS char* nA = has_next ? (const PG8_GAS char*)g.A + (size_t)nxt.pm * tstep : cA; const PG8_GAS char* nB = has_next ? (const PG8_GAS char*)g.Bt + (size_t)nxt.pn * tstep : cB;
        for (int t = 0; t < nt; t += 2) {
            const bool last = (t == nt - 2);
            const PG8_GAS char* a1 = cA + (size_t)(t + 1) * kstep;
            const PG8_GAS char* a2 = last ? nA : cA + (size_t)(t + 2) * kstep; const PG8_GAS char* b2 = last ? nB : cB + (size_t)(t + 2) * kstep;
            const PG8_GAS char* a3 = a2 + kstep; const PG8_GAS char* b3 = b2 + kstep;
            if (last && has_next) S.a_ready(nxt);
            if constexpr (SP2) {
            PG8_LDB(B0, 0, 0); PG8_LDB(B1, 0, 1); PG8_SCHED; PG8_LDA(At, 0, 0); PG8_STAGE(PG8_SA(1, 1), a1 + hstep, voffA);
            PG8_WAIT_V(8); PG8_WAIT_L(0); PG8_BAR; PG8_MMA(0, 0, At, B0); PG8_MMA(0, 1, At, B1); PG8_BAR; PG8_SCHED;
            PG8_LDA(At, 0, 1); PG8_STAGE(PG8_SB(0, 0), b2, voffB); PG8_STAGE(PG8_SB(0, 1), b2 + hstep, voffB); PG8_STAGE(PG8_SA(0, 0), a2, voffA);
            PG8_WAIT_V(8); PG8_WAIT_L(0); PG8_BAR; PG8_MMA(1, 0, At, B0); PG8_MMA(1, 1, At, B1); PG8_BAR; PG8_SCHED;
            PG8_LDB(B0, 1, 0); PG8_LDB(B1, 1, 1); PG8_SCHED; PG8_LDA(At, 1, 0); PG8_STAGE(PG8_SA(0, 1), a2 + hstep, voffA);
            PG8_WAIT_V(8); PG8_WAIT_L(0); PG8_BAR; PG8_MMA(0, 0, At, B0); PG8_MMA(0, 1, At, B1); PG8_BAR; PG8_SCHED;
            PG8_LDA(At, 1, 1); PG8_STAGE(PG8_SB(1, 0), b3, voffB); PG8_STAGE(PG8_SB(1, 1), b3 + hstep, voffB); PG8_STAGE(PG8_SA(1, 0), a3, voffA);
            PG8_WAIT_V(8); PG8_WAIT_L(0); PG8_BAR; PG8_MMA(1, 0, At, B0); PG8_MMA(1, 1, At, B1); PG8_BAR; PG8_SCHED;
            } else {
            PG8_LDB(B0, 0, 0); PG8_SCHED; PG8_LDA(At, 0, 0); PG8_STAGE(PG8_SA(1, 1), a1 + hstep, voffA);
            PG8_WAIT_L(8); PG8_BAR; PG8_WAIT_L(0); PG8_MMA(0, 0, At, B0); PG8_BAR; PG8_SCHED;
            PG8_LDB(B1, 0, 1); PG8_STAGE(PG8_SB(0, 0), b2, voffB);
            PG8_BAR; PG8_WAIT_L(0); PG8_MMA(0, 1, At, B1); PG8_BAR;
            PG8_LDA(At, 0, 1); PG8_STAGE(PG8_SA(0, 0), a2, voffA);
            PG8_BAR; PG8_WAIT_L(0); PG8_MMA(1, 0, At, B0); PG8_BAR; PG8_SCHED;
            PG8_STAGE(PG8_SB(0, 1), b2 + hstep, voffB);
            PG8_WAIT_V(6); PG8_BAR; PG8_MMA(1, 1, At, B1); PG8_BAR;
            PG8_LDB(B0, 1, 0); PG8_SCHED; PG8_LDA(At, 1, 0); PG8_STAGE(PG8_SA(0, 1), a2 + hstep, voffA);
            PG8_WAIT_L(8); PG8_BAR; PG8_WAIT_L(0); PG8_MMA(0, 0, At, B0); PG8_BAR; PG8_SCHED;
            PG8_LDB(B1, 1, 1); PG8_STAGE(PG8_SB(1, 0), b3, voffB);
            PG8_BAR; PG8_WAIT_L(0); PG8_MMA(0, 1, At, B1); PG8_BAR;
            PG8_LDA(At, 1, 1); PG8_STAGE(PG8_SA(1, 0), a3, voffA);
            PG8_BAR; PG8_WAIT_L(0); PG8_MMA(1, 0, At, B0); PG8_BAR; PG8_SCHED;
            PG8_STAGE(PG8_SB(1, 1), b3 + hstep, voffB);
            PG8_WAIT_V(6); PG8_BAR; PG8_MMA(1, 1, At, B1); PG8_BAR;
            }
        }
        if constexpr (ALIGN_EPI) { if (wr == 0) PG8_BAR; }
        if constexpr (!Epi::AFTER_DRAIN) { E(acc, cur, wr, wc, fr, fq); S.done(cur); }
        if (!has_next) break;
#pragma unroll
        for (int a = 0; a < 2; ++a)
#pragma unroll
            for (int b = 0; b < 2; ++b)
#pragma unroll
                for (int m = 0; m < 4; ++m)
#pragma unroll
                    for (int n = 0; n < 2; ++n) acc[a][b][m][n] = (f32x4){0.f, 0.f, 0.f, 0.f};
        cur = nxt; cA = nA; cB = nB; ++ui;
        if constexpr (ALIGN_EPI) { if (wr == 1) PG8_BAR; }
    }
    PG8_WAIT_V(0);
    if constexpr (!ALIGN_EPI) { if (wr == 0) PG8_BAR; }
    PG8_BAR;
    if constexpr (Epi::AFTER_DRAIN) { E.fused(acc, cur, wr, wc, fr, fq, lds, wid, lane); S.done(cur); }
#undef PG8_SA
#undef PG8_SB
#undef PG8_STAGE
#undef PG8_LDA
#undef PG8_LDB
#undef PG8_MMA
#undef PG8_WAIT_V
#undef PG8_WAIT_L
#undef PG8_BAR
#undef PG8_SCHED
}
}
#define GAS __attribute__((address_space(1)))
#define LAS __attribute__((address_space(3)))
typedef unsigned short bf16;
typedef unsigned v4u __attribute__((ext_vector_type(4)));
typedef float f32x4 __attribute__((ext_vector_type(4)));
typedef short bf16x8 __attribute__((ext_vector_type(8)));
typedef GAS unsigned gu32;
typedef GAS unsigned long long gu64;
#define RLX_AGENT __ATOMIC_RELAXED, __HIP_MEMORY_SCOPE_AGENT
#define LDS_WAIT() asm volatile("s_waitcnt lgkmcnt(0)" ::: "memory")
#define VM_WAIT() asm volatile("s_waitcnt vmcnt(0)" ::: "memory")
__device__ __forceinline__ unsigned long long rt() { return __builtin_amdgcn_s_memrealtime(); }
__device__ __forceinline__ unsigned f2bf(float f) { unsigned u = __builtin_bit_cast(unsigned, f); return (u + 0x7fffu + ((u >> 16) & 1u)) >> 16; }
__device__ __forceinline__ unsigned pk2(float lo, float hi) { return f2bf(lo) | (f2bf(hi) << 16); }

#define XB_TMO      128
#define XB_XCNT(j)  (256  + 64 * (j))
#define XB_XSUB(j)  (1280 + 64 * (j))
#define XB_XGEN(j)  (2304 + 64 * (j))
#define XB_TOP      3328
#define XB_TOPGEN   3392
#define XCD_BAR_WORDS 3456
#define XB_SPIN_CAP (1u << 18)

__device__ __forceinline__ unsigned xb_ld(unsigned* p)              { return __hip_atomic_load(p, __ATOMIC_RELAXED, __HIP_MEMORY_SCOPE_AGENT); }
__device__ __forceinline__ unsigned xb_add(unsigned* p, unsigned v) { return __hip_atomic_fetch_add(p, v, __ATOMIC_RELAXED, __HIP_MEMORY_SCOPE_AGENT); }
__device__ __forceinline__ unsigned xb_xcc_id() { return (unsigned)__builtin_amdgcn_s_getreg((3 << 11) | 20) & 0xFu; }
#define XB_SPIN(cond, bar) do { unsigned _sp = 0; while (cond) { __builtin_amdgcn_s_sleep(1); \
    if ((++_sp & 255u) == 0u) { if (xb_ld(&(bar)[XB_TMO])) break; if (_sp > XB_SPIN_CAP) { atomicAdd(&(bar)[XB_TMO], 1u); break; } } } } while (0)

struct XcdBarrier {
    unsigned* bar; unsigned x;
    volatile LAS unsigned* st;
};

__device__ __forceinline__ XcdBarrier xcd_barrier_post(unsigned* bar, volatile LAS unsigned* st, const int tid) {
    XcdBarrier b; b.bar = bar; b.x = xb_xcc_id(); b.st = st;
    if (tid == 0) (void)xb_add(&bar[XB_XCNT(b.x)], 1u);
    return b;
}
__device__ __forceinline__ void xcd_barrier_complete(unsigned* bar, unsigned x, unsigned& nloc, unsigned& nx) {
    const unsigned G = gridDim.x * gridDim.y * gridDim.z;
    unsigned sum, cnt, mine, sp = 0u;
    for (;;) {
        sum = 0u; cnt = 0u; mine = 0u;
#pragma unroll
        for (unsigned j = 0; j < 16; ++j) { const unsigned c = xb_ld(&bar[XB_XCNT(j)]); sum += c; cnt += (c > 0u) ? 1u : 0u; mine = (j == x) ? c : mine; }
        if (sum == G) break;
        __builtin_amdgcn_s_sleep(1);
        if ((++sp & 255u) == 0u) { if (xb_ld(&bar[XB_TMO])) break; if (sp > XB_SPIN_CAP) { atomicAdd(&bar[XB_TMO], 1u); break; } }
    }
    nloc = mine > 0u ? mine : 1u; nx = cnt > 0u ? cnt : 1u;
}

__device__ __forceinline__ void xcd_barrier(const XcdBarrier& b, const int tid) {
    asm volatile("s_waitcnt vmcnt(0)" ::: "memory");
    __syncthreads();
    if (tid == 0) {
        unsigned* bar = b.bar;
        __builtin_amdgcn_s_waitcnt(0);
        unsigned nloc = b.st[0], nx = b.st[1];
        if (nloc == 0u) { xcd_barrier_complete(bar, b.x, nloc, nx); b.st[0] = nloc; b.st[1] = nx; }
        const unsigned old = xb_add(&bar[XB_XSUB(b.x)], 1u);
        const unsigned gen = old / nloc;
        if (old + 1u == (gen + 1u) * nloc) {
            __builtin_amdgcn_fence(__ATOMIC_RELEASE, "agent");
            asm volatile("s_waitcnt vmcnt(0)" ::: "memory");
            const unsigned og = xb_add(&bar[XB_TOP], 1u);
            const unsigned tg = og / nx;
            if (og + 1u == (tg + 1u) * nx) xb_add(&bar[XB_TOPGEN], 1u);
            else XB_SPIN(xb_ld(&bar[XB_TOPGEN]) == tg, bar);
            __builtin_amdgcn_fence(__ATOMIC_ACQUIRE, "agent");
            xb_add(&bar[XB_XGEN(b.x)], 1u);
            asm volatile("s_waitcnt vmcnt(0)" ::: "memory");
        } else {
            XB_SPIN(xb_ld(&bar[XB_XGEN(b.x)]) == gen, bar);
            __builtin_amdgcn_fence(__ATOMIC_ACQUIRE, "agent");
            asm volatile("s_waitcnt vmcnt(0)" ::: "memory");
        }
    }
    __syncthreads();
}
constexpr int BATCH = 2, SEQ = 4096, DM = 2048, DEPTH = 4, MTOK = BATCH * SEQ;
constexpr int HD = 64, RH = 12, AH = 12, GGRP = 8, RWID = 768, AWID = 768, GWID = 512;
constexpr int RCOLS = 2560, ACOLS = 2304, GCOLS = 1024, INCOLS = 5888, DFF = 5632, UPN = 2 * DFF;
constexpr int QOFF = RCOLS, KOFF = RCOLS + AWID, VOFF = RCOLS + 2 * AWID, GOFF = RCOLS + ACOLS;
constexpr int TCH = 64, NCH = SEQ / TCH;
constexpr int NTASK_SCAN = BATCH * RH * NCH;
constexpr float NORM_EPS = 1e-6f, GN_EPS = 1e-5f, RWKV_LN_EPS = 64e-5f;
constexpr float DECAY_SCALE = 0.6065306597126334f;
constexpr int NWAVES = 8, NTHR = NWAVES * 64;

constexpr size_t MiB = 1u << 20;
constexpr size_t WS_CTL = 0, CTL_ZERO_BYTES = 1 * MiB;
constexpr size_t WS_WIN = 2 * MiB, WS_WOUT = 94 * MiB, WS_WUP = 126 * MiB, WS_WDN = 302 * MiB;
constexpr size_t WS_HN = 390 * MiB, WS_Y = 422 * MiB, WS_O = 454 * MiB;
constexpr size_t WS_REG = 518 * MiB;
constexpr size_t WS_PROJ = WS_REG;
constexpr size_t WS_RW = WS_REG + 92 * MiB;
constexpr size_t WS_CHK = WS_RW + 216 * MiB;
constexpr size_t WS_QKR = WS_CHK + 72 * MiB;
constexpr size_t WS_AO = WS_QKR + 24 * MiB;
constexpr size_t WS_LSE = WS_AO + 72 * MiB;
constexpr size_t WS_SGU = WS_LSE + 2 * MiB;
constexpr size_t WS_BON = WS_SGU + 32 * MiB;
constexpr size_t WS_LORA = WS_BON + 1 * MiB;
constexpr size_t WS_SGW = WS_LORA + 2 * MiB;
constexpr size_t WS_END_MIX = WS_SGW + 1 * MiB;
constexpr size_t WS_UP = WS_REG;
constexpr size_t WS_H = WS_REG + 176 * MiB;
constexpr size_t WS_END = WS_END_MIX;
static_assert(WS_H + 88 * MiB <= WS_END, "map");
constexpr int LORA_L = RWID * 256;
constexpr int CW_BAR = 4096, CW_ATT = 8192;

constexpr int RING_BYTES = 131072, LDSCTL_OFF = RING_BYTES, MISC_OFF = LDSCTL_OFF + 320, LDS_BYTES = 147456;

struct Params { const float* in[29]; float* out; unsigned char* ws; };

typedef const GAS float* gcf; typedef GAS float* gfp; typedef const GAS bf16* gcb; typedef GAS bf16* gbp; typedef const GAS int* gci;
__device__ __forceinline__ float bf2f(unsigned short u) { return __builtin_bit_cast(float, (unsigned)u << 16); }
__device__ __forceinline__ float bflo(unsigned u) { return __builtin_bit_cast(float, u << 16); }
__device__ __forceinline__ float bfhi(unsigned u) { return __builtin_bit_cast(float, u & 0xffff0000u); }
__device__ __forceinline__ float wave_sum(float v) {
#pragma unroll
    for (int o = 1; o < 64; o <<= 1) v += __shfl_xor(v, o);
    return v;
}
__device__ __forceinline__ float wave_max(float v) {
#pragma unroll
    for (int o = 1; o < 64; o <<= 1) v = fmaxf(v, __shfl_xor(v, o));
    return v;
}
__device__ __forceinline__ float sigmoidf_(float x) { return 1.f / (1.f + __expf(-x)); }
__device__ __forceinline__ float gelu_tanh(float x) { const float u = 0.7978845608028654f * (x + 0.044715f * x * x * x); return 0.5f * x * (1.f + tanhf(u)); }

typedef float f32x16 __attribute__((ext_vector_type(16)));
typedef float f32x2_t __attribute__((ext_vector_type(2))); typedef __bf16 bf16x2_t __attribute__((ext_vector_type(2)));
typedef short s16x4 __attribute__((ext_vector_type(4)));
__device__ __forceinline__ unsigned cvtpk(float lo, float hi) { f32x2_t v = {lo, hi}; bf16x2_t b = __builtin_convertvector(v, bf16x2_t); return __builtin_bit_cast(unsigned, b); }
__device__ __forceinline__ bf16x8 pack8(float a0, float a1, float a2, float a3, float a4, float a5, float a6, float a7) { v4u p; p.x = cvtpk(a0, a1); p.y = cvtpk(a2, a3); p.z = cvtpk(a4, a5); p.w = cvtpk(a6, a7); return __builtin_bit_cast(bf16x8, p); }
#define MFMA16(a, b, c) __builtin_amdgcn_mfma_f32_16x16x32_bf16((a), (b), (c), 0, 0, 0)
#define MFMA32(a, b, c) __builtin_amdgcn_mfma_f32_32x32x16_bf16((a), (b), (c), 0, 0, 0)
__device__ __forceinline__ int crow(int reg, int h) { return (reg & 3) + 8 * (reg >> 2) + 4 * h; }

__device__ __forceinline__ void p0_transpose_item(gcf W, int K, int N, gbp WT, int row_off, LAS float* scr, int item, int lane) {
    const int nblk = N / 32, kb = item / nblk, nb = item % nblk, k0 = 64 * kb, n0 = 32 * nb;
#pragma unroll 8
    for (int i = 0; i < 32; ++i) { const int kk = 2 * i + (lane >> 5); scr[kk * 33 + (lane & 31)] = W[(size_t)(k0 + kk) * N + n0 + (lane & 31)]; }
    LDS_WAIT(); asm volatile("" ::: "memory");
    const int c = lane & 7;
#pragma unroll
    for (int j = 0; j < 4; ++j) { const int n = (lane >> 3) + 8 * j; const LAS float* s = scr + (8 * c) * 33 + n;
        v4u o; o.x = pk2(s[0 * 33], s[1 * 33]); o.y = pk2(s[2 * 33], s[3 * 33]); o.z = pk2(s[4 * 33], s[5 * 33]); o.w = pk2(s[6 * 33], s[7 * 33]);
        *(GAS v4u*)(WT + (size_t)(row_off + n0 + n) * K + k0 + 8 * c) = o; }
    LDS_WAIT(); asm volatile("" ::: "memory");
}

__device__ __forceinline__ void rowpass(gcf xin, gcf delta, gcf gpost, gfp xout, gcf gnext, gbp hn, int gw, int ngw, int lane) {
    for (int m = gw; m < MTOK; m += ngw) {
        const GAS f32x4* xr = (const GAS f32x4*)(xin + (size_t)m * DM) + lane;
        f32x4 xv[8];
#pragma unroll
        for (int j = 0; j < 8; ++j) xv[j] = xr[64 * j];
        if (delta) {
            const GAS f32x4* dr = (const GAS f32x4*)(delta + (size_t)m * DM) + lane;
            f32x4 dv[8]; float ss = 0.f;
#pragma unroll
            for (int j = 0; j < 8; ++j) { dv[j] = dr[64 * j]; ss += dv[j].x * dv[j].x + dv[j].y * dv[j].y + dv[j].z * dv[j].z + dv[j].w * dv[j].w; }
            const float rstd = rsqrtf(wave_sum(ss) * (1.f / DM) + NORM_EPS);
            GAS f32x4* xo = (GAS f32x4*)(xout + (size_t)m * DM) + lane;
#pragma unroll
            for (int j = 0; j < 8; ++j) { const f32x4 g = ((const GAS f32x4*)gpost)[lane + 64 * j]; xv[j] = xv[j] + dv[j] * rstd * g; xo[64 * j] = xv[j]; }
        }
        if (gnext) {
            float ss = 0.f;
#pragma unroll
            for (int j = 0; j < 8; ++j) ss += xv[j].x * xv[j].x + xv[j].y * xv[j].y + xv[j].z * xv[j].z + xv[j].w * xv[j].w;
            const float rstd = rsqrtf(wave_sum(ss) * (1.f / DM) + NORM_EPS);
            GAS unsigned long long* o8 = (GAS unsigned long long*)(hn + (size_t)m * DM) + lane;
#pragma unroll
            for (int j = 0; j < 8; ++j) { const f32x4 g = ((const GAS f32x4*)gnext)[lane + 64 * j]; const f32x4 v = xv[j] * rstd * g;
                o8[64 * j] = (unsigned long long)pk2(v.x, v.y) | ((unsigned long long)pk2(v.z, v.w) << 32); }
        }
    }
}

struct PrepW { gcf sgu_g, sgu_b; gci pos; };
__device__ __forceinline__ void prep_token(int tok, gcb PROJ, const PrepW& w, gbp QKR, gbp SU, gbp SVN, int lane) {
    gcb prow = PROJ + (size_t)tok * INCOLS;
    {
        float cs = 1.f, sn = 0.f;
        if (lane < 16) { const int f = lane & 7; const float inv = exp2f(-(float)f * (18.931568569324174f / 8.f)); const float ang = (float)w.pos[tok] * inv; cs = cosf(ang); sn = sinf(ang); }
#pragma unroll 4
        for (int i = 0; i < 24; ++i) { const int c = lane + 64 * i; float x = bf2f(prow[QOFF + c]);
            if (lane < 16) { const float oth = bf2f(prow[QOFF + c + (lane < 8 ? 8 : -8)]); x = lane < 8 ? x * cs - oth * sn : x * cs + oth * sn; }
            if (i < 12) x *= 0.18033688011112042f;
            QKR[(size_t)tok * 1536 + c] = (bf16)f2bf(x); }
    }
#pragma unroll 4
    for (int i = 0; i < 16; ++i) { const int c = lane + 64 * i; const float z = gelu_tanh(bf2f(prow[GOFF + c]));
        if (i < 8) SU[(size_t)tok * GWID + c] = (bf16)f2bf(z);
        else { const int g = i - 8; const float mu = wave_sum(z) * (1.f / 64.f); const float d = z - mu; const float var = wave_sum(d * d) * (1.f / 64.f);
            SVN[(size_t)tok * GWID + g * 64 + lane] = (bf16)f2bf(d * rsqrtf(var + GN_EPS) * w.sgu_g[g * 64 + lane] + w.sgu_b[g * 64 + lane]); } }
}

constexpr int LIN_ROW = 264;
struct RPW { gcf mu, w0, a0, kk_, ka_, rk; gcb w2t, a2t, g2t; };
__device__ __forceinline__ f32x4 ld4bf(gcb p) { const unsigned long long u = *(const GAS unsigned long long*)p; const unsigned lo = (unsigned)u, hi = (unsigned)(u >> 32); return (f32x4){bflo(lo), bfhi(lo), bflo(hi), bfhi(hi)}; }
__device__ __forceinline__ void rwkv_prep_unit(int unit, gcb PROJ, const RPW& w, gfp RWb, gfp BON, LAS unsigned char* lds, int tid, int wave, int lane) {
    constexpr size_t AS = (size_t)MTOK * RWID;
    gfp R = RWb; gfp Wd = RWb + AS; gfp K2 = RWb + 2 * AS; gfp V = RWb + 3 * AS; gfp KK = RWb + 4 * AS; gfp KKA = RWb + 5 * AS; gfp Gt = RWb + 6 * AS;
    const int tok0 = unit * 32;
    LAS bf16* lin = (LAS bf16*)lds;
    {
        const int tk = tid >> 4, c0 = (tid & 15) * 16, tokA = tok0 + tk, tA = tokA % SEQ;
        gcb pr = PROJ + (size_t)tokA * INCOLS + 2304 + c0;
        unsigned ob[8];
#pragma unroll
        for (int q4 = 0; q4 < 4; ++q4) { const f32x4 cu = ld4bf(pr + 4 * q4); f32x4 pv = {0.f, 0.f, 0.f, 0.f}; if (tA > 0) pv = ld4bf(pr + 4 * q4 - INCOLS);
            const f32x4 mu = *(const GAS f32x4*)(w.mu + 2304 + c0 + 4 * q4); f32x4 x = cu + (pv - cu) * mu;
#pragma unroll
            for (int e = 0; e < 4; ++e) { const int c = c0 + 4 * q4 + e; x[e] = c < 64 ? tanhf(x[e]) : (c < 128 ? x[e] : sigmoidf_(x[e])); }
            ob[2 * q4] = pk2(x[0], x[1]); ob[2 * q4 + 1] = pk2(x[2], x[3]); }
        LAS v4u* dst = (LAS v4u*)(lin + tk * LIN_ROW + c0);
        dst[0] = (v4u){ob[0], ob[1], ob[2], ob[3]}; dst[1] = (v4u){ob[4], ob[5], ob[6], ob[7]};
    }
    __syncthreads();
    const int tt = wave & 1, hq = wave >> 1, tl = lane & 15, g = lane >> 4;
    const int tok = tok0 + 16 * tt + tl, t = tok % SEQ;
    bf16x8 bfr[8];
#pragma unroll
    for (int ks = 0; ks < 8; ++ks) bfr[ks] = *(const LAS bf16x8*)(lin + (16 * tt + tl) * LIN_ROW + 32 * ks + 8 * g);
    gcb prow = PROJ + (size_t)tok * INCOLS;
    for (int hi = 0; hi < 3; ++hi) { const int h = hq + 4 * hi;
        f32x4 kr[4], aa[4]; float ss = 0.f, bon = 0.f;
#pragma unroll
        for (int nt = 0; nt < 4; ++nt) { const int n0 = h * 64 + 16 * nt;
            f32x4 cw = {0.f, 0.f, 0.f, 0.f}, ca = cw, cg = cw;
#pragma unroll
            for (int ks = 0; ks < 2; ++ks) { cw = MFMA16(*(const GAS bf16x8*)(w.w2t + (n0 + tl) * 64 + 32 * ks + 8 * g), bfr[ks], cw);
                                             ca = MFMA16(*(const GAS bf16x8*)(w.a2t + (n0 + tl) * 64 + 32 * ks + 8 * g), bfr[2 + ks], ca); }
#pragma unroll
            for (int ks = 0; ks < 4; ++ks) cg = MFMA16(*(const GAS bf16x8*)(w.g2t + (n0 + tl) * 128 + 32 * ks + 8 * g), bfr[4 + ks], cg);
            const int c = n0 + 4 * g;
            const f32x4 pr_ = ld4bf(prow + c), pk_ = ld4bf(prow + 768 + c), pv_ = ld4bf(prow + 1536 + c);
            f32x4 qr_ = {0.f, 0.f, 0.f, 0.f}, qk_ = qr_, qv_ = qr_;
            if (t > 0) { qr_ = ld4bf(prow - INCOLS + c); qk_ = ld4bf(prow - INCOLS + 768 + c); qv_ = ld4bf(prow - INCOLS + 1536 + c); }
            const f32x4 r4 = pr_ + (qr_ - pr_) * *(const GAS f32x4*)(w.mu + c), k4 = pk_ + (qk_ - pk_) * *(const GAS f32x4*)(w.mu + 768 + c), v4 = pv_ + (qv_ - pv_) * *(const GAS f32x4*)(w.mu + 1536 + c);
            const f32x4 w04 = *(const GAS f32x4*)(w.w0 + c), a04 = *(const GAS f32x4*)(w.a0 + c), kk4 = *(const GAS f32x4*)(w.kk_ + c), ka4 = *(const GAS f32x4*)(w.ka_ + c), rk4 = *(const GAS f32x4*)(w.rk + c);
            f32x4 dec, a_;
#pragma unroll
            for (int e = 0; e < 4; ++e) { dec[e] = __expf(-DECAY_SCALE * sigmoidf_(w04[e] + cw[e])); a_[e] = sigmoidf_(a04[e] + ca[e]); }
            const f32x4 kkr = k4 * kk4, k2 = k4 * (1.f + (a_ - 1.f) * ka4);
            ss += kkr[0] * kkr[0] + kkr[1] * kkr[1] + kkr[2] * kkr[2] + kkr[3] * kkr[3];
            const f32x4 bb = r4 * k2 * rk4; bon += bb[0] + bb[1] + bb[2] + bb[3];
            { const size_t o = (size_t)tok * RWID + c; *(GAS f32x4*)(R + o) = r4; *(GAS f32x4*)(Wd + o) = dec; *(GAS f32x4*)(K2 + o) = k2; *(GAS f32x4*)(V + o) = v4; *(GAS f32x4*)(Gt + o) = cg; }
            kr[nt] = kkr; aa[nt] = a_; }
        ss += __shfl_xor(ss, 16); ss += __shfl_xor(ss, 32); bon += __shfl_xor(bon, 16); bon += __shfl_xor(bon, 32);
        const float rn = 1.f / fmaxf(sqrtf(ss), 1e-12f);
#pragma unroll
        for (int nt = 0; nt < 4; ++nt) { const size_t o = (size_t)tok * RWID + h * 64 + 16 * nt + 4 * g; const f32x4 kk = kr[nt] * rn;
            *(GAS f32x4*)(KK + o) = kk; *(GAS f32x4*)(KKA + o) = kk * aa[nt]; }
        if (g == 0) BON[tok * 12 + h] = bon; }
    __syncthreads();
}

template <bool IDN>
__device__ __forceinline__ void scan_chunk(int task, gcf RWb, gfp OUTV  , gfp OUTM  , LAS float* ops, int lane) {
    constexpr unsigned AS = (unsigned)MTOK * RWID;
    gcf R = RWb; gcf Wd = RWb + AS; gcf K2 = RWb + 2 * AS; gcf V = RWb + 3 * AS; gcf KK = RWb + 4 * AS; gcf KKA = RWb + 5 * AS;
    const int bh = task / NCH, c = task % NCH, b = bh / RH, h = bh % RH;
    const unsigned base = (unsigned)((b * SEQ + c * TCH) * RWID + h * 64 + lane);
    float st[64];
#pragma unroll
    for (int k = 0; k < 64; ++k) st[k] = (IDN && k == lane) ? 1.f : 0.f;
    float nw = Wd[base], nkk = KK[base], nka = KKA[base], nk = IDN ? 0.f : K2[base], nr = R[base], nv = IDN ? 0.f : V[base];
    for (int i = 0; i < TCH; ++i) {
        LAS float* ob = ops + (i & 1) * 320;
        ob[lane] = nw; ob[64 + lane] = nkk; ob[128 + lane] = nka; if (!IDN) ob[192 + lane] = nk; ob[256 + lane] = nr;
        const float vcur = nv;
        if (i + 1 < TCH) { const unsigned o = base + (unsigned)(i + 1) * RWID; nw = Wd[o]; nkk = KK[o]; nka = KKA[o]; nr = R[o]; if (!IDN) { nk = K2[o]; nv = V[o]; } }
        const LAS f32x4* o4 = (const LAS f32x4*)ob;
        float sk = 0.f;
#pragma unroll
        for (int k4 = 0; k4 < 16; ++k4) { const f32x4 q = o4[16 + k4];
            sk += st[4 * k4] * q.x + st[4 * k4 + 1] * q.y + st[4 * k4 + 2] * q.z + st[4 * k4 + 3] * q.w; }
        float y = 0.f;
#pragma unroll
        for (int k4 = 0; k4 < 16; ++k4) { const f32x4 w4 = o4[k4], a4 = o4[32 + k4], r4 = o4[64 + k4]; f32x4 kv = {0.f, 0.f, 0.f, 0.f}; if (!IDN) kv = o4[48 + k4];
#pragma unroll
            for (int j = 0; j < 4; ++j) { const int k = 4 * k4 + j;
                if (IDN) st[k] = st[k] * w4[j] - sk * a4[j]; else st[k] = st[k] * w4[j] - sk * a4[j] + vcur * kv[j];
                y += st[k] * r4[j]; } }
        OUTV[base + (unsigned)i * RWID] = y;
    }
    if (IDN) { gbp om = (gbp)OUTM + (unsigned)(task * 4096 + lane);
#pragma unroll
        for (int k = 0; k < 64; ++k) om[k * 64] = (bf16)f2bf(st[k]); }
    else { gfp om = OUTM + (unsigned)(task * 4096 + lane);
#pragma unroll
        for (int k = 0; k < 64; ++k) om[k * 64] = st[k]; }
}

__device__ __forceinline__ void scan_carry_mfma(int bh, int vt, gcb PT, gcf SLT, gfp SST, int lane) {
    const int r = lane & 31, h = lane >> 5;
    f32x16 acc[2];
#pragma unroll
    for (int i = 0; i < 16; ++i) { acc[0][i] = 0.f; acc[1][i] = 0.f; }
    s16x4 pa[2][2][2][2]; f32x16 sl[2];
    {   const unsigned tb = (unsigned)(bh * NCH) * 4096u;
#pragma unroll
        for (int mt = 0; mt < 2; ++mt) {
#pragma unroll
            for (int kt = 0; kt < 2; ++kt)
#pragma unroll
                for (int sx = 0; sx < 2; ++sx) { gcb pr = PT + tb + (unsigned)((32 * mt + r) * 64 + 32 * kt + 16 * sx + 4 * h); pa[mt][kt][sx][0] = *(const GAS s16x4*)pr; pa[mt][kt][sx][1] = *(const GAS s16x4*)(pr + 8); }
#pragma unroll
            for (int i = 0; i < 16; ++i) sl[mt][i] = SLT[tb + (unsigned)((32 * mt + crow(i, h)) * 64 + 32 * vt + r)]; } }
    for (int c = 0; c < NCH; ++c) {
        const unsigned tb = (unsigned)(bh * NCH + c) * 4096u;
#pragma unroll
        for (int mt = 0; mt < 2; ++mt)
#pragma unroll
            for (int g = 0; g < 4; ++g) { const f32x4 v = {acc[mt][4 * g], acc[mt][4 * g + 1], acc[mt][4 * g + 2], acc[mt][4 * g + 3]};
                *(GAS f32x4*)(SST + tb + (unsigned)((32 * vt + r) * 64 + 32 * mt + 8 * g + 4 * h)) = v; }
        if (c == NCH - 1) break;
        bf16x8 bfr[2][2], afr[2][2][2];
#pragma unroll
        for (int kt = 0; kt < 2; ++kt)
#pragma unroll
            for (int sx = 0; sx < 2; ++sx) bfr[kt][sx] = pack8(acc[kt][8 * sx], acc[kt][8 * sx + 1], acc[kt][8 * sx + 2], acc[kt][8 * sx + 3], acc[kt][8 * sx + 4], acc[kt][8 * sx + 5], acc[kt][8 * sx + 6], acc[kt][8 * sx + 7]);
#pragma unroll
        for (int mt = 0; mt < 2; ++mt) { acc[mt] = sl[mt];
#pragma unroll
            for (int kt = 0; kt < 2; ++kt)
#pragma unroll
                for (int sx = 0; sx < 2; ++sx) afr[mt][kt][sx] = __builtin_shufflevector(pa[mt][kt][sx][0], pa[mt][kt][sx][1], 0, 1, 2, 3, 4, 5, 6, 7); }
        if (c + 1 < NCH - 1) { const unsigned tn = tb + 4096u;
#pragma unroll
            for (int mt = 0; mt < 2; ++mt) {
#pragma unroll
                for (int kt = 0; kt < 2; ++kt)
#pragma unroll
                    for (int sx = 0; sx < 2; ++sx) { gcb pr = PT + tn + (unsigned)((32 * mt + r) * 64 + 32 * kt + 16 * sx + 4 * h); pa[mt][kt][sx][0] = *(const GAS s16x4*)pr; pa[mt][kt][sx][1] = *(const GAS s16x4*)(pr + 8); }
#pragma unroll
                for (int i = 0; i < 16; ++i) sl[mt][i] = SLT[tn + (unsigned)((32 * mt + crow(i, h)) * 64 + 32 * vt + r)]; } }
#pragma unroll
        for (int mt = 0; mt < 2; ++mt)
#pragma unroll
            for (int kt = 0; kt < 2; ++kt)
#pragma unroll
                for (int sx = 0; sx < 2; ++sx) acc[mt] = MFMA32(afr[mt][kt][sx], bfr[kt][sx], acc[mt]);
    }
}

__device__ __forceinline__ void scan_out(int task, gcf RWb, gcf YL, gcf Z, gcf SST, gcf BON, gcf ln_g, gcf ln_b, gbp Y, LAS float* zb, int lane) {
    constexpr size_t AS = (size_t)MTOK * RWID;
    gcf V = RWb + 3 * AS; gcf Gt = RWb + 6 * AS;
    const int bh = task / NCH, c = task % NCH, b = bh / RH, h = bh % RH;
    const int tok0 = b * SEQ + c * TCH; const int n = h * 64 + lane;
    float S[64];
#pragma unroll
    for (int k4 = 0; k4 < 16; ++k4) { const f32x4 q = *(const GAS f32x4*)(SST + (unsigned)(task * 4096 + lane * 64 + 4 * k4)); S[4 * k4] = q.x; S[4 * k4 + 1] = q.y; S[4 * k4 + 2] = q.z; S[4 * k4 + 3] = q.w; }
    const float lg = ln_g[n], lb = ln_b[n];
    for (int i = 0; i < TCH; ++i) { const int tok = tok0 + i; const size_t o = (size_t)tok * RWID + n;
        zb[(i & 1) * 64 + lane] = Z[o];
        float y = YL[o];
#pragma unroll
        for (int k4 = 0; k4 < 16; ++k4) { const f32x4 q = ((const LAS f32x4*)(zb + (i & 1) * 64))[k4];
            y += S[4 * k4] * q.x + S[4 * k4 + 1] * q.y + S[4 * k4 + 2] * q.z + S[4 * k4 + 3] * q.w; }
        const float mu = wave_sum(y) * (1.f / 64.f); const float d = y - mu; const float var = wave_sum(d * d) * (1.f / 64.f);
        float yn = d * rsqrtf(var + RWKV_LN_EPS) * lg + lb;
        yn += BON[tok * 12 + h] * V[o];
        Y[(size_t)tok * DM + n] = (bf16)f2bf(yn * Gt[o]); }
}

constexpr int ATT_UNITS_PER_BH = 48, ATT_UNITS = BATCH * AH * ATT_UNITS_PER_BH, ATT_KROW = 144, ATT_VROW = 776, ATT_VOFF = 384 * ATT_KROW;
__device__ __forceinline__ void attn_unit(int unit, gcb QKR, gcb PROJ, gfp AOP, gfp LSE, LAS unsigned char* lds, int tid, int wave, int lane) {
    const int bh = unit / ATT_UNITS_PER_BH, uu = unit % ATT_UNITS_PER_BH, b = bh / AH, h = bh % AH;
    int p, d, rho, qb;
    if (uu < 16) { p = 0; d = 1; rho = 0; qb = uu; } else if (uu < 32) { p = 1; d = 4; rho = (uu - 16) >> 2; qb = (uu - 16) & 3; } else { p = 2; d = 16; rho = uu - 32; qb = 0; }
    const int i0 = qb * 256;
    LAS unsigned char* Kl = lds; LAS unsigned char* Vl = lds + ATT_VOFF;
#pragma unroll
    for (int it = 0; it < 6; ++it) { const int idx = tid + 512 * it, key = idx % 384, piece = idx / 384; const int ki = i0 - 128 + key;
        v4u kv = {0u, 0u, 0u, 0u}, vv = {0u, 0u, 0u, 0u};
        if (ki >= 0) { const unsigned tokk = (unsigned)(b * SEQ + rho + d * ki);
            kv = *(const GAS v4u*)(QKR + tokk * 1536u + 768u + (unsigned)(h * 64 + piece * 8));
            vv = *(const GAS v4u*)(PROJ + (size_t)tokk * INCOLS + VOFF + h * 64 + piece * 8); }
        *(LAS v4u*)(Kl + key * ATT_KROW + piece * 16) = kv;
        LAS unsigned short* vd = (LAS unsigned short*)(Vl + (piece * 8) * ATT_VROW + key * 2);
        vd[0 * (ATT_VROW / 2)] = (unsigned short)(vv.x & 0xffffu); vd[1 * (ATT_VROW / 2)] = (unsigned short)(vv.x >> 16);
        vd[2 * (ATT_VROW / 2)] = (unsigned short)(vv.y & 0xffffu); vd[3 * (ATT_VROW / 2)] = (unsigned short)(vv.y >> 16);
        vd[4 * (ATT_VROW / 2)] = (unsigned short)(vv.z & 0xffffu); vd[5 * (ATT_VROW / 2)] = (unsigned short)(vv.z >> 16);
        vd[6 * (ATT_VROW / 2)] = (unsigned short)(vv.w & 0xffffu); vd[7 * (ATT_VROW / 2)] = (unsigned short)(vv.w >> 16); }
    __syncthreads();
    const int r = lane & 31, hh = lane >> 5;
    const int iq0 = i0 + 32 * wave;
    const unsigned tokq = (unsigned)(b * SEQ + rho + d * (iq0 + r));
    bf16x8 qf[4];
#pragma unroll
    for (int sx = 0; sx < 4; ++sx) qf[sx] = *(const GAS bf16x8*)(QKR + tokq * 1536u + (unsigned)(h * 64 + 16 * sx + 8 * hh));
    float m = -1e30f, l = 0.f;
    f32x16 o[2];
#pragma unroll
    for (int i = 0; i < 16; ++i) { o[0][i] = 0.f; o[1][i] = 0.f; }
#pragma unroll
    for (int j = 0; j < 5; ++j) {
        const int kk0 = 32 * wave + 32 * j, kabs0 = iq0 - 128 + 32 * j;
        if (kabs0 + 31 < 0) continue;
        f32x16 st;
#pragma unroll
        for (int i = 0; i < 16; ++i) st[i] = 0.f;
#pragma unroll
        for (int sx = 0; sx < 4; ++sx) { const bf16x8 a = *(const LAS bf16x8*)(Kl + (kk0 + r) * ATT_KROW + (16 * sx + 8 * hh) * 2); st = MFMA32(a, qf[sx], st); }
        bool ok[16]; float tmax = -1e30f;
#pragma unroll
        for (int i = 0; i < 16; ++i) { const int row = crow(i, hh); ok[i] = (kabs0 + row >= 0) && (j != 0 || row >= r) && (j != 4 || row <= r); tmax = fmaxf(tmax, ok[i] ? st[i] : -1e30f); }
        tmax = fmaxf(tmax, __shfl_xor(tmax, 32));
        const float mnew = fmaxf(m, tmax), alpha = exp2f(m - mnew);
        float pr[16], ps = 0.f;
#pragma unroll
        for (int i = 0; i < 16; ++i) { pr[i] = ok[i] ? exp2f(st[i] - mnew) : 0.f; ps += pr[i]; }
        l = l * alpha + ps; m = mnew;
#pragma unroll
        for (int i = 0; i < 16; ++i) { o[0][i] *= alpha; o[1][i] *= alpha; }
#pragma unroll
        for (int s2 = 0; s2 < 2; ++s2) { const bf16x8 bfrag = pack8(pr[8 * s2], pr[8 * s2 + 1], pr[8 * s2 + 2], pr[8 * s2 + 3], pr[8 * s2 + 4], pr[8 * s2 + 5], pr[8 * s2 + 6], pr[8 * s2 + 7]);
#pragma unroll
            for (int mt = 0; mt < 2; ++mt) { const LAS unsigned char* ap = Vl + (32 * mt + r) * ATT_VROW + (kk0 + 16 * s2 + 4 * hh) * 2;
                const s16x4 lo = *(const LAS s16x4*)ap, hi = *(const LAS s16x4*)(ap + 16);
                const bf16x8 a = __builtin_shufflevector(lo, hi, 0, 1, 2, 3, 4, 5, 6, 7);
                o[mt] = MFMA32(a, bfrag, o[mt]); } }
    }
    const float ltot = l + __shfl_xor(l, 32), inv = 1.f / ltot;
    gfp op = AOP + (size_t)p * MTOK * AWID + (size_t)tokq * AWID + h * 64;
#pragma unroll
    for (int mt = 0; mt < 2; ++mt)
#pragma unroll
        for (int g = 0; g < 4; ++g) { const f32x4 v = {o[mt][4 * g] * inv, o[mt][4 * g + 1] * inv, o[mt][4 * g + 2] * inv, o[mt][4 * g + 3] * inv};
            *(GAS f32x4*)(op + 32 * mt + 8 * g + 4 * hh) = v; }
    if (hh == 0) LSE[(size_t)p * MTOK * AH + tokq * AH + h] = (m + log2f(ltot)) * 0.6931471805599453f;
    __syncthreads();
}

__device__ __forceinline__ void attn_norm_token(int tok, gcf AOP, gcf LSE, gcf g, gbp Y, int lane) {
    float v[12], ss = 0.f;
#pragma unroll
    for (int i = 0; i < 12; ++i) { const float l0 = LSE[(size_t)tok * AH + i], l1 = LSE[(size_t)MTOK * AH + (size_t)tok * AH + i], l2 = LSE[2 * (size_t)MTOK * AH + (size_t)tok * AH + i];
        const float mx = fmaxf(fmaxf(l0, l1), l2), w0 = __expf(l0 - mx), w1 = __expf(l1 - mx), w2 = __expf(l2 - mx);
        const size_t o = (size_t)tok * AWID + lane + 64 * i;
        v[i] = (w0 * AOP[o] + w1 * AOP[(size_t)MTOK * AWID + o] + w2 * AOP[2 * (size_t)MTOK * AWID + o]) / (w0 + w1 + w2); ss += v[i] * v[i]; }
    const float rstd = rsqrtf(wave_sum(ss) * (1.f / AWID) + NORM_EPS);
#pragma unroll
    for (int i = 0; i < 12; ++i) Y[(size_t)tok * DM + RWID + lane + 64 * i] = (bf16)f2bf(v[i] * rstd * g[lane + 64 * i]);
}

constexpr int SGU_ROW = 272;
__device__ __forceinline__ void sgu_unit(int unit, gcb SU, gcb SVN, gcb W16  , gcf bs  , gcf ng, gbp Y, LAS unsigned char* lds, int tid, int wave, int lane) {
    const int b = unit / (SEQ / 128), c = unit % (SEQ / 128), tok0 = b * SEQ + c * 128;
    const int tl = lane & 15, g4 = lane >> 4, tok = tok0 + 16 * wave + tl, nks = (wave >> 1) + 1;
    float ss = 0.f, rstd = 0.f;
    for (int pass = 0; pass < 2; ++pass) {
        for (int g = 0; g < 8; ++g) {
            __syncthreads();
#pragma unroll
            for (int it = 0; it < 2; ++it) { const int idx = tid + 512 * it, tj = idx & 127, piece = idx >> 7;
                const v4u vv = *(const GAS v4u*)(SVN + (unsigned)((tok0 + tj) * GWID + g * 64 + piece * 8));
                LAS unsigned short* vd = (LAS unsigned short*)(lds + (piece * 8) * SGU_ROW + tj * 2);
                vd[0 * (SGU_ROW / 2)] = (unsigned short)(vv.x & 0xffffu); vd[1 * (SGU_ROW / 2)] = (unsigned short)(vv.x >> 16);
                vd[2 * (SGU_ROW / 2)] = (unsigned short)(vv.y & 0xffffu); vd[3 * (SGU_ROW / 2)] = (unsigned short)(vv.y >> 16);
                vd[4 * (SGU_ROW / 2)] = (unsigned short)(vv.z & 0xffffu); vd[5 * (SGU_ROW / 2)] = (unsigned short)(vv.z >> 16);
                vd[6 * (SGU_ROW / 2)] = (unsigned short)(vv.w & 0xffffu); vd[7 * (SGU_ROW / 2)] = (unsigned short)(vv.w >> 16); }
            __syncthreads();
            const float bias = bs[g * 128 + 16 * wave + tl];
            f32x4 acc[4];
#pragma unroll
            for (int nt = 0; nt < 4; ++nt) acc[nt] = (f32x4){0.f, 0.f, 0.f, 0.f};
            for (int ks = 0; ks < nks; ++ks) { const bf16x8 bw = *(const GAS bf16x8*)(W16 + (unsigned)((g * 128 + 16 * wave + tl) * 128 + 32 * ks + 8 * g4));
#pragma unroll
                for (int nt = 0; nt < 4; ++nt) acc[nt] = MFMA16(*(const LAS bf16x8*)(lds + (16 * nt + tl) * SGU_ROW + (32 * ks + 8 * g4) * 2), bw, acc[nt]); }
#pragma unroll
            for (int nt = 0; nt < 4; ++nt) { const int cc = g * 64 + 16 * nt + 4 * g4;
                const f32x4 u4 = ld4bf(SU + (unsigned)(tok * GWID + cc));
                const f32x4 qv = u4 * (acc[nt] + bias);
                if (pass == 0) ss += qv[0] * qv[0] + qv[1] * qv[1] + qv[2] * qv[2] + qv[3] * qv[3];
                else { const f32x4 y = qv * rstd * *(const GAS f32x4*)(ng + cc);
                    *(GAS unsigned long long*)(Y + (unsigned)(tok * DM + RWID + AWID + cc)) = (unsigned long long)pk2(y[0], y[1]) | ((unsigned long long)pk2(y[2], y[3]) << 32); } }
        }
        if (pass == 0) { ss += __shfl_xor(ss, 16); ss += __shfl_xor(ss, 32); rstd = rsqrtf(ss * (1.f / GWID) + NORM_EPS); }
    }
    __syncthreads();
}

__device__ __forceinline__ void conv_item(int item, gcb UP, gcf cw, gcf cb, gbp H) {
    const int tok = item / (DFF / 8), j8 = (item % (DFF / 8)) * 8, t = tok % SEQ;
    float gt[8], vl[8];
#pragma unroll
    for (int e = 0; e < 8; ++e) { gt[e] = cb[j8 + e]; vl[e] = cb[DFF + j8 + e]; }
#pragma unroll
    for (int tap = 0; tap < 3; ++tap) { const int dt = 2 - tap;
        if (t - dt >= 0) { gcb ur = UP + (size_t)(tok - dt) * UPN; const v4u ug = *(const GAS v4u*)(ur + j8), uv = *(const GAS v4u*)(ur + DFF + j8);
            gcf wg = cw + (size_t)tap * UPN + j8; gcf wv = wg + DFF;
            const unsigned a[4] = {ug.x, ug.y, ug.z, ug.w}, c[4] = {uv.x, uv.y, uv.z, uv.w};
#pragma unroll
            for (int e = 0; e < 4; ++e) { gt[2 * e] += bflo(a[e]) * wg[2 * e]; gt[2 * e + 1] += bfhi(a[e]) * wg[2 * e + 1]; vl[2 * e] += bflo(c[e]) * wv[2 * e]; vl[2 * e + 1] += bfhi(c[e]) * wv[2 * e + 1]; } } }
    v4u o; o.x = pk2(gelu_tanh(gt[0]) * vl[0], gelu_tanh(gt[1]) * vl[1]); o.y = pk2(gelu_tanh(gt[2]) * vl[2], gelu_tanh(gt[3]) * vl[3]);
    o.z = pk2(gelu_tanh(gt[4]) * vl[4], gelu_tanh(gt[5]) * vl[5]); o.w = pk2(gelu_tanh(gt[6]) * vl[6], gelu_tanh(gt[7]) * vl[7]);
    *(GAS v4u*)(H + (size_t)tok * DFF + j8) = o;
}

typedef const __attribute__((address_space(4))) unsigned long long* kargs_t;
__device__ __forceinline__ kargs_t kargs() { kargs_t ka = (kargs_t)__builtin_amdgcn_kernarg_segment_ptr(); asm volatile("" : "+s"(ka)); return ka; }
#define KIN(i) ((gcf)ka[i])
#define KOUT ((gfp)ka[29])
#define KWS ((GAS unsigned char*)ka[30])
constexpr size_t AS_ = (size_t)MTOK * RWID;
__device__ __forceinline__ int lane_id() { int l; asm volatile("v_mbcnt_lo_u32_b32 %0, -1, 0\n\tv_mbcnt_hi_u32_b32 %0, -1, %0" : "=v"(l)); return l; }
#define PH_IDS const int lane = lane_id(); const int tid = wave * 64 + lane; (void)tid
#define GBAR() do { const int lane_b = lane_id(); kargs_t kb = kargs(); XcdBarrier bb; bb.bar = (unsigned*)((GAS unsigned*)((GAS unsigned char*)kb[30] + WS_CTL) + CW_BAR); bb.x = xb_xcc_id(); \
    bb.st = (volatile LAS unsigned*)(lds + MISC_OFF) + 8; xcd_barrier(bb, wave * 64 + lane_b); } while (0)

__global__ void __launch_bounds__(NTHR, 2) mega_fwd(Params p) {
    extern __shared__ __attribute__((aligned(16))) unsigned char lds_raw[];
    LAS unsigned char* lds = (LAS unsigned char*)lds_raw;
    const int wave = __builtin_amdgcn_readfirstlane((int)threadIdx.x >> 6);
    const int G = gridDim.x, gw = blockIdx.x * NWAVES + wave, ngw = G * NWAVES;
    { PH_IDS; kargs_t ka = kargs();
      for (int u = tid; u < (LDS_BYTES - LDSCTL_OFF) / 4; u += NTHR) ((LAS unsigned*)(lds + LDSCTL_OFF))[u] = 0u;
      __syncthreads();
      (void)xcd_barrier_post((unsigned*)((GAS unsigned*)(KWS + WS_CTL) + CW_BAR), (volatile LAS unsigned*)(lds + MISC_OFF) + 8, tid); }

    {
        PH_IDS; kargs_t ka = kargs(); GAS unsigned char* ws = KWS;
        LAS float* scr = (LAS float* )(lds + wave * 16384);
        for (int l = 0; l < DEPTH; ++l) {
            for (int it = gw; it < (DM / 64) * (INCOLS / 32); it += ngw) p0_transpose_item(KIN(6) + (size_t)l * DM * INCOLS, DM, INCOLS, (gbp)(ws + WS_WIN) + (size_t)l * INCOLS * DM, 0, scr, it, lane);
            for (int it = gw; it < (DM / 64) * (DM / 32); it += ngw) p0_transpose_item(KIN(24) + (size_t)l * DM * DM, DM, DM, (gbp)(ws + WS_WOUT) + (size_t)l * DM * DM, 0, scr, it, lane);
            for (int it = gw; it < (DM / 64) * (UPN / 32); it += ngw) p0_transpose_item(KIN(25) + (size_t)l * DM * UPN, DM, UPN, (gbp)(ws + WS_WUP) + (size_t)l * UPN * DM, 0, scr, it, lane);
            for (int it = gw; it < (DFF / 64) * (DM / 32); it += ngw) p0_transpose_item(KIN(28) + (size_t)l * DFF * DM, DFF, DM, (gbp)(ws + WS_WDN) + (size_t)l * DM * DFF, 0, scr, it, lane);
        }
        {
            gbp SW = (gbp)(ws + WS_SGW);
            for (int i = blockIdx.x * NTHR + tid; i < DEPTH * 8 * 128 * 128; i += G * NTHR) { const int jj = i & 127, ii = (i >> 7) & 127; SW[i] = (bf16)f2bf(jj <= ii ? KIN(21)[i] : 0.f); } }
        {
            gbp LW = (gbp)(ws + WS_LORA);
            for (int i = blockIdx.x * NTHR + tid; i < DEPTH * LORA_L; i += G * NTHR) { const int l = i / LORA_L, rr = i % LORA_L;
                float v; if (rr < RWID * 64) { const int n = rr / 64, k = rr % 64; v = KIN(9)[(size_t)l * 64 * RWID + k * RWID + n]; }
                else if (rr < RWID * 128) { const int q = rr - RWID * 64, n = q / 64, k = q % 64; v = KIN(11)[(size_t)l * 64 * RWID + k * RWID + n]; }
                else { const int q = rr - RWID * 128, n = q / 128, k = q % 128; v = KIN(12)[(size_t)l * 128 * RWID + k * RWID + n]; }
                LW[i] = (bf16)f2bf(v); } }
        rowpass(KIN(0), nullptr, nullptr, nullptr, KIN(2), (gbp)(ws + WS_HN), gw, ngw, lane);
    }
    GBAR();

    for (int l = 0; l < DEPTH; ++l) {
        { PH_IDS; kargs_t ka = kargs(); GAS unsigned char* ws = KWS;
          pg8::Gemm g{(gbp)(ws + WS_HN), (gbp)(ws + WS_WIN) + (size_t)l * INCOLS * DM, MTOK, INCOLS, DM}; pg8::StaticOrder S; S.init(MTOK, INCOLS, G, (int)blockIdx.x);
          pg8::EpiBf16<0> E{(gbp)(ws + WS_PROJ), INCOLS, nullptr, 0, 0, 1.f};
          pg8::gemm_phase<pg8::EpiBf16<0>, pg8::StaticOrder, true, true>(lds, g, S, E, tid); }
        GBAR();
        { PH_IDS; kargs_t ka = kargs(); GAS unsigned char* ws = KWS;
          gcb LW = (gcb)(ws + WS_LORA) + (size_t)l * LORA_L;
          RPW rw{KIN(7) + (size_t)l * RCOLS, KIN(8) + (size_t)l * RWID, KIN(10) + (size_t)l * RWID, KIN(13) + (size_t)l * RWID, KIN(14) + (size_t)l * RWID, KIN(15) + (size_t)l * RWID, LW, LW + RWID * 64, LW + RWID * 128};
          for (int u = blockIdx.x; u < MTOK / 32; u += G) rwkv_prep_unit(u, (gcb)(ws + WS_PROJ), rw, (gfp)(ws + WS_RW), (gfp)(ws + WS_BON), lds, tid, wave, lane);
          PrepW w{KIN(19) + (size_t)l * GWID, KIN(20) + (size_t)l * GWID, (gci)KIN(1)};
          gbp SU = (gbp)(ws + WS_SGU);
          for (int tok = gw; tok < MTOK; tok += ngw) prep_token(tok, (gcb)(ws + WS_PROJ), w, (gbp)(ws + WS_QKR), SU, SU + (size_t)MTOK * GWID, lane); }
        GBAR();
        { PH_IDS; kargs_t ka = kargs(); GAS unsigned char* ws = KWS;
          LAS float* ops = (LAS float*)(lds + wave * 4096);
          gfp RWb = (gfp)(ws + WS_RW); gfp PT = (gfp)(ws + WS_CHK);
          for (int task = gw; task < 2 * NTASK_SCAN; task += ngw) { if (task < NTASK_SCAN) scan_chunk<false>(task, RWb, RWb + 7 * AS_, PT + (size_t)NTASK_SCAN * 4096, ops, lane); else scan_chunk<true>(task - NTASK_SCAN, RWb, RWb + 8 * AS_, PT, ops, lane); } }
        GBAR();
        if (blockIdx.x < BATCH * RH) { if (wave < 2) { PH_IDS; kargs_t ka = kargs(); GAS unsigned char* ws = KWS; gfp PT = (gfp)(ws + WS_CHK);
              scan_carry_mfma((int)blockIdx.x, wave, (gcb)PT, PT + (size_t)NTASK_SCAN * 4096, PT + 2 * (size_t)NTASK_SCAN * 4096, lane); } }
        else if (blockIdx.x < BATCH * RH + MTOK / 128) { PH_IDS; kargs_t ka = kargs(); GAS unsigned char* ws = KWS; gbp SU = (gbp)(ws + WS_SGU);
              sgu_unit((int)blockIdx.x - BATCH * RH, (gcb)SU, (gcb)SU + (size_t)MTOK * GWID, (gcb)(ws + WS_SGW) + (size_t)l * 8 * 128 * 128, KIN(22) + (size_t)l * 8 * 128, KIN(23) + (size_t)l * GWID, (gbp)(ws + WS_Y), lds, tid, wave, lane); }
        { PH_IDS; kargs_t ka = kargs(); GAS unsigned char* ws = KWS;
          volatile LAS unsigned* MISC = (volatile LAS unsigned*)(lds + MISC_OFF);
          gu32* ctr = (gu32*)(ws + WS_CTL) + CW_ATT + 64 * l;
          for (;;) {
              if (tid == 0) MISC[16] = __hip_atomic_fetch_add(ctr, 1u, __ATOMIC_RELAXED, __HIP_MEMORY_SCOPE_AGENT);
              __syncthreads();
              const int u = (int)MISC[16];
              if (u >= ATT_UNITS) break;
              attn_unit(u, (gcb)(ws + WS_QKR), (gcb)(ws + WS_PROJ), (gfp)(ws + WS_AO), (gfp)(ws + WS_LSE), lds, tid, wave, lane);
          }
        }
        GBAR();
        { PH_IDS; kargs_t ka = kargs(); GAS unsigned char* ws = KWS;
          LAS float* zb = (LAS float*)(lds + wave * 1024);
          gfp RWb = (gfp)(ws + WS_RW); gfp PT = (gfp)(ws + WS_CHK);
          for (int task = gw; task < NTASK_SCAN; task += ngw) scan_out(task, RWb, RWb + 7 * AS_, RWb + 8 * AS_, PT + 2 * (size_t)NTASK_SCAN * 4096, (gfp)(ws + WS_BON), KIN(16) + (size_t)l * RWID, KIN(17) + (size_t)l * RWID, (gbp)(ws + WS_Y), zb, lane);
          for (int tok = gw; tok < MTOK; tok += ngw) attn_norm_token(tok, (gcf)(ws + WS_AO), (gcf)(ws + WS_LSE), KIN(18) + (size_t)l * AWID, (gbp)(ws + WS_Y), lane); }
        GBAR();
        { PH_IDS; kargs_t ka = kargs(); GAS unsigned char* ws = KWS;
          pg8::Gemm g{(gbp)(ws + WS_Y), (gbp)(ws + WS_WOUT) + (size_t)l * DM * DM, MTOK, DM, DM}; pg8::StaticOrder S; S.init(MTOK, DM, G, (int)blockIdx.x);
          pg8::EpiF32 E{(gfp)(ws + WS_O), DM};
          pg8::gemm_phase<pg8::EpiF32, pg8::StaticOrder, true, true>(lds, g, S, E, tid); }
        GBAR();
        { PH_IDS; kargs_t ka = kargs(); GAS unsigned char* ws = KWS;
          rowpass(l == 0 ? KIN(0) : (gcf)KOUT, (gfp)(ws + WS_O), KIN(3) + (size_t)l * DM, KOUT, KIN(4) + (size_t)l * DM, (gbp)(ws + WS_HN), gw, ngw, lane); }
        GBAR();
        { PH_IDS; kargs_t ka = kargs(); GAS unsigned char* ws = KWS;
          pg8::Gemm g{(gbp)(ws + WS_HN), (gbp)(ws + WS_WUP) + (size_t)l * UPN * DM, MTOK, UPN, DM}; pg8::StaticOrder S; S.init(MTOK, UPN, G, (int)blockIdx.x);
          pg8::EpiBf16<0> E{(gbp)(ws + WS_UP), UPN, nullptr, 0, 0, 1.f};
          pg8::gemm_phase<pg8::EpiBf16<0>, pg8::StaticOrder, true, true>(lds, g, S, E, tid); }
        GBAR();
        { PH_IDS; kargs_t ka = kargs(); GAS unsigned char* ws = KWS;
          const int gtid = blockIdx.x * NTHR + tid, ngt = G * NTHR;
          for (int it = gtid; it < MTOK * (DFF / 8); it += ngt) conv_item(it, (gbp)(ws + WS_UP), KIN(26) + (size_t)l * 3 * UPN, KIN(27) + (size_t)l * UPN, (gbp)(ws + WS_H)); }
        GBAR();
        { PH_IDS; kargs_t ka = kargs(); GAS unsigned char* ws = KWS;
          pg8::Gemm g{(gbp)(ws + WS_H), (gbp)(ws + WS_WDN) + (size_t)l * DM * DFF, MTOK, DM, DFF}; pg8::StaticOrder S; S.init(MTOK, DM, G, (int)blockIdx.x);
          pg8::EpiF32 E{(gfp)(ws + WS_O), DM};
          pg8::gemm_phase<pg8::EpiF32, pg8::StaticOrder, true, true>(lds, g, S, E, tid); }
        GBAR();
        { PH_IDS; kargs_t ka = kargs(); GAS unsigned char* ws = KWS;
          rowpass(KOUT, (gfp)(ws + WS_O), KIN(5) + (size_t)l * DM, KOUT, l + 1 < DEPTH ? KIN(2) + (size_t)(l + 1) * DM : nullptr, (gbp)(ws + WS_HN), gw, ngw, lane); }
        if (l + 1 < DEPTH) GBAR();
    }
}

extern "C" void kernel_launch(void* const* d_in, const int* in_sizes, int n_in, void* d_out, int out_size, void* d_ws, size_t ws_size, hipStream_t stream) {
    static int grid = 0;
    if (grid == 0) {
        if (n_in != 29 || out_size != MTOK * DM || ws_size < WS_END) { fprintf(stderr, "kernel_launch: unexpected shapes (n_in %d out %d ws %zu need %zu)\n", n_in, out_size, ws_size, (size_t)WS_END); grid = -1; return; }
        int dev = 0, cus = 0, per_cu = 0;
        if (hipGetDevice(&dev) != hipSuccess || hipDeviceGetAttribute(&cus, hipDeviceAttributeMultiprocessorCount, dev) != hipSuccess) { grid = -1; return; }
        if (hipFuncSetAttribute((const void*)mega_fwd, hipFuncAttributeMaxDynamicSharedMemorySize, LDS_BYTES) != hipSuccess) { fprintf(stderr, "kernel_launch: hipFuncSetAttribute failed\n"); grid = -1; return; }
        if (hipOccupancyMaxActiveBlocksPerMultiprocessor(&per_cu, (const void*)mega_fwd, NTHR, LDS_BYTES) != hipSuccess || per_cu < 1) fprintf(stderr, "kernel_launch: occupancy query says %d\n", per_cu);
        (void)hipGetLastError();
        grid = cus;
    }
    if (grid < 0) return;
    if (hipMemsetAsync((char*)d_ws + WS_CTL, 0, CTL_ZERO_BYTES, stream) != hipSuccess) return;
    Params prm{};
    for (int i = 0; i < 29; ++i) prm.in[i] = (const float*)d_in[i];
    prm.out = (float*)d_out; prm.ws = (unsigned char*)d_ws;
    hipLaunchKernelGGL(mega_fwd, dim3(grid), dim3(NTHR), LDS_BYTES, stream, prm);
}
```

```cpp
#include <hip/hip_runtime.h>
#include <cstdio>
#include <cstdint>
namespace pg8 {
#define PG8_LAS __attribute__((address_space(3)))
#define PG8_GAS __attribute__((address_space(1)))
typedef unsigned short bf16_t;
typedef short bf16x8 __attribute__((ext_vector_type(8)));
typedef float f32x4 __attribute__((ext_vector_type(4)));
typedef unsigned u32x4 __attribute__((ext_vector_type(4)));
constexpr int BM = 256, BK = 64, HALF = 128, HTB = HALF * BK * 2  , STAGE_BYTES = 8 * HTB, NXCD = 8, WGM = 8;

__host__ __device__ __forceinline__ int lds_byte(int r, int c) { const int st = (r >> 4) * 2 + (c >> 5), rr = r & 15, cc = c & 31, ob = rr * 64 + cc * 2; return st * 1024 + (ob ^ (((ob >> 9) & 1) << 5)); }
__host__ __device__ __forceinline__ void stage_rc(int b, int& R, int& C) { const int st = b / 1024, sb = b % 1024, swz = sb ^ (((sb >> 9) & 1) << 5); R = (st >> 1) * 16 + swz / 64; C = (st & 1) * 32 + (swz % 64) / 2; }
__host__ __device__ __forceinline__ int perm32(int rho) { const int n = rho >> 4, i = rho & 15; return 8 * (i >> 2) + 4 * n + (i & 3); }

struct Unit { int pm, pn; };
struct Gemm { const PG8_GAS bf16_t* A; const PG8_GAS bf16_t* Bt; int M, N, K; };

struct StaticOrder {
    int nM, nN, nwg, G, c;
    __host__ __device__ void init(int M, int N, int G_, int c_) { nM = M / BM; nN = N / BM; nwg = nM * nN; G = G_; c = c_; }
    __host__ __device__ bool next(int i, Unit& u) const {
        const long L = (long)i * G + c; if (L >= nwg) return false;
        int wgid = (int)L; { const int q = nwg / NXCD, r = nwg % NXCD, xcd = wgid % NXCD, off = wgid / NXCD; wgid = (xcd < r ? xcd * (q + 1) : r * (q + 1) + (xcd - r) * q) + off; }
        const int nig = WGM * nN, gid = wgid / nig, fm = gid * WGM, gsz = (nM - fm) < WGM ? (nM - fm) : WGM;
        u.pm = fm + ((wgid % nig) % gsz); u.pn = (wgid % nig) / gsz; return true;
    }
    __device__ __forceinline__ void a_ready(const Unit&) const {}
    __device__ __forceinline__ void done(const Unit&) const {}
};

__device__ __forceinline__ unsigned cvt_pk_bf16(float lo, float hi) { unsigned r; asm volatile("v_cvt_pk_bf16_f32 %0, %1, %2" : "=v"(r) : "v"(lo), "v"(hi)); return r; }
typedef float f32x2 __attribute__((ext_vector_type(2)));
__device__ __forceinline__ f32x2 gelu_pk(f32x2 v) {
    const f32x2 av = __builtin_elementwise_abs(v), d = av * 0.2316418882f + 1.0f;
    f32x2 t; t.x = __builtin_amdgcn_rcpf(d.x); t.y = __builtin_amdgcn_rcpf(d.y);
    f32x2 q = t * 0.5307027145f + (-0.7265760135f); q = q * t + 0.7107068705f; q = q * t + (-0.142248368f); q = q * t + 0.127414796f; q = q * t;
    const f32x2 s = (v * v) * (-0.72134752044f);
    f32x2 e; e.x = __builtin_amdgcn_exp2f(s.x); e.y = __builtin_amdgcn_exp2f(s.y);
    const f32x2 m = v * (q * e), r = v - m;
    f32x2 o; o.x = v.x < 0.f ? m.x : r.x; o.y = v.y < 0.f ? m.y : r.y; return o;
}

template <int ACT  > struct EpiBf16 {
    static constexpr bool PERM = true, AFTER_DRAIN = false; static_assert(ACT == 0 || ACT == 1, "EpiBf16: ACT is 0 (none) or 1 (gelu_pk)");
    PG8_GAS bf16_t* O; int ldc; const PG8_GAS float* bias; int split_cols; size_t split_stride; float scale0;
    __device__ __forceinline__ void operator()(const f32x4 (&acc)[2][2][4][2], const Unit& u, int wr, int wc, int fr, int fq) const {
        const int row0 = u.pm * BM + wr * 64 + fr; int colt = u.pn * BM; PG8_GAS bf16_t* base = O;
        float sc = 1.f; if (split_cols) { const int t = colt / split_cols; base += (size_t)t * split_stride; colt -= t * split_cols; if (t == 0) sc = scale0; }
        const int col0 = colt + wc * 32 + 8 * fq, bcol0 = u.pn * BM + wc * 32 + 8 * fq;
        f32x4 bv[2][2];
#pragma unroll
        for (int bj = 0; bj < 2; ++bj)
#pragma unroll
            for (int n = 0; n < 2; ++n) bv[bj][n] = bias ? *(const PG8_GAS f32x4*)(bias + bcol0 + bj * HALF + 4 * n) : (f32x4){0.f, 0.f, 0.f, 0.f};
#pragma unroll
        for (int ai = 0; ai < 2; ++ai)
#pragma unroll
            for (int m = 0; m < 4; ++m) { PG8_GAS bf16_t* rowp = base + (size_t)(row0 + ai * HALF + m * 16) * ldc + col0;
#pragma unroll
                for (int bj = 0; bj < 2; ++bj) { f32x4 v0 = acc[ai][bj][m][0] + bv[bj][0], v1 = acc[ai][bj][m][1] + bv[bj][1];
                    if (ACT == 1) { f32x2 a = gelu_pk((f32x2){v0[0], v0[1]}), b = gelu_pk((f32x2){v0[2], v0[3]}), c = gelu_pk((f32x2){v1[0], v1[1]}), d = gelu_pk((f32x2){v1[2], v1[3]});
                        v0 = (f32x4){a.x, a.y, b.x, b.y}; v1 = (f32x4){c.x, c.y, d.x, d.y}; }
                    v0 = v0 * sc; v1 = v1 * sc; u32x4 w; w.x = cvt_pk_bf16(v0[0], v0[1]); w.y = cvt_pk_bf16(v0[2], v0[3]); w.z = cvt_pk_bf16(v1[0], v1[1]); w.w = cvt_pk_bf16(v1[2], v1[3]);
                    *(PG8_GAS u32x4*)(rowp + bj * HALF) = w; } }
    }
};
struct EpiF32 {
    static constexpr bool PERM = true, AFTER_DRAIN = false;
    PG8_GAS float* O; int ldc;
    __device__ __forceinline__ void operator()(const f32x4 (&acc)[2][2][4][2], const Unit& u, int wr, int wc, int fr, int fq) const {
        const int row0 = u.pm * BM + wr * 64 + fr, col0 = u.pn * BM + wc * 32 + 8 * fq;
#pragma unroll
        for (int ai = 0; ai < 2; ++ai)
#pragma unroll
            for (int m = 0; m < 4; ++m) { PG8_GAS float* rowp = O + (size_t)(row0 + ai * HALF + m * 16) * ldc + col0;
#pragma unroll
                for (int bj = 0; bj < 2; ++bj) { *(PG8_GAS f32x4*)(rowp + bj * HALF) = acc[ai][bj][m][0]; *(PG8_GAS f32x4*)(rowp + bj * HALF + 4) = acc[ai][bj][m][1]; } }
    }
};

template <class Epi, class Sched, bool ALIGN_EPI = false, bool SP2 = false>
__device__ __forceinline__ void gemm_phase(PG8_LAS unsigned char* lds, const Gemm g, const Sched& S, const Epi& E, const int tid) {
    const int wid = __builtin_amdgcn_readfirstlane(tid >> 6), lane = tid & 63, wr = wid >> 2, wc = wid & 3, fr = lane & 15, fq = lane >> 4;
    const int K = g.K, nt = K / BK;
    unsigned voffA[2], voffB[2];
#pragma unroll
    for (int i = 0; i < 2; ++i) { int R, C; stage_rc(tid * 16 + i * 8192, R, C); const int Rb = Epi::PERM ? ((R & ~31) + perm32(R & 31)) : R;
        voffA[i] = (unsigned)(R * K + C) * 2u; voffB[i] = (unsigned)(Rb * K + C) * 2u; }
    const size_t kstep = (size_t)(BK * 2);
    const size_t hstep = (size_t)HALF * K * 2;
    const size_t tstep = 2 * hstep;
    const unsigned ldsw = (unsigned)wid * 1024u;
    const int aoff = lds_byte(wr * 64 + fr, fq * 8), boff = lds_byte(wc * 32 + fr, fq * 8);
#define PG8_SA(b, h) (((b) * 2 + (h)) * HTB)
#define PG8_SB(b, h) ((4 + (b) * 2 + (h)) * HTB)
#define PG8_STAGE(bufoff, gbase, voff) do { _Pragma("unroll") for (int _i = 0; _i < 2; ++_i) \
        __builtin_amdgcn_global_load_lds((const PG8_GAS unsigned*)((const PG8_GAS char*)(gbase) + (voff)[_i]), (PG8_LAS unsigned*)(lds + (bufoff) + ldsw + _i * 8192), 16, 0, 0); } while (0)
#define PG8_LDA(dst, b, h) do { _Pragma("unroll") for (int m = 0; m < 4; ++m) _Pragma("unroll") for (int k = 0; k < 2; ++k) dst[m][k] = *(const PG8_LAS bf16x8*)(lds + PG8_SA(b, h) + aoff + m * 2048 + k * 1024); } while (0)
#define PG8_LDB(dst, b, h) do { _Pragma("unroll") for (int n = 0; n < 2; ++n) _Pragma("unroll") for (int k = 0; k < 2; ++k) dst[n][k] = *(const PG8_LAS bf16x8*)(lds + PG8_SB(b, h) + boff + n * 2048 + k * 1024); } while (0)
#define PG8_MMA(ai, bj, At, Bt) do { __builtin_amdgcn_s_setprio(1); _Pragma("unroll") for (int m = 0; m < 4; ++m) _Pragma("unroll") for (int n = 0; n < 2; ++n) _Pragma("unroll") for (int k = 0; k < 2; ++k) \
        acc[ai][bj][m][n] = __builtin_amdgcn_mfma_f32_16x16x32_bf16(Bt[n][k], At[m][k], acc[ai][bj][m][n], 0, 0, 0); __builtin_amdgcn_s_setprio(0); } while (0)
#define PG8_WAIT_V(n) asm volatile("s_waitcnt vmcnt(" #n ")" ::: "memory")
#define PG8_WAIT_L(n) asm volatile("s_waitcnt lgkmcnt(" #n ")" ::: "memory")
#define PG8_BAR __builtin_amdgcn_s_barrier()
#define PG8_SCHED __builtin_amdgcn_sched_barrier(0)
    Unit cur, nxt; int ui = 0;
    if (!S.next(0, cur)) return;
    f32x4 acc[2][2][4][2];
#pragma unroll
    for (int a = 0; a < 2; ++a)
#pragma unroll
        for (int b = 0; b < 2; ++b)
#pragma unroll
            for (int m = 0; m < 4; ++m)
#pragma unroll
                for (int n = 0; n < 2; ++n) acc[a][b][m][n] = (f32x4){0.f, 0.f, 0.f, 0.f};
    bf16x8 At[4][2], B0[2][2], B1[2][2];
    const PG8_GAS char* cA = (const PG8_GAS char*)g.A + (size_t)cur.pm * tstep; const PG8_GAS char* cB = (const PG8_GAS char*)g.Bt + (size_t)cur.pn * tstep;
    S.a_ready(cur);
    if constexpr (SP2) {
        PG8_STAGE(PG8_SB(0, 0), cB, voffB); PG8_STAGE(PG8_SB(0, 1), cB + hstep, voffB); PG8_STAGE(PG8_SA(0, 0), cA, voffA); PG8_STAGE(PG8_SA(0, 1), cA + hstep, voffA);
        if (wr == 1) PG8_BAR;
        PG8_WAIT_V(2); PG8_BAR;
        PG8_STAGE(PG8_SB(1, 0), cB + kstep, voffB); PG8_STAGE(PG8_SA(1, 0), cA + kstep, voffA); PG8_STAGE(PG8_SB(1, 1), cB + hstep + kstep, voffB);
        PG8_WAIT_V(6); PG8_BAR;
    } else {
        PG8_STAGE(PG8_SB(0, 0), cB, voffB); PG8_STAGE(PG8_SA(0, 0), cA, voffA); PG8_STAGE(PG8_SB(0, 1), cB + hstep, voffB); PG8_STAGE(PG8_SA(0, 1), cA + hstep, voffA);
        if (wr == 1) PG8_BAR;
        PG8_WAIT_V(4); PG8_BAR;
        PG8_STAGE(PG8_SB(1, 0), cB + kstep, voffB); PG8_STAGE(PG8_SA(1, 0), cA + kstep, voffA); PG8_STAGE(PG8_SB(1, 1), cB + hstep + kstep, voffB);
        PG8_WAIT_V(6); PG8_BAR;
    }
    for (;;) {
        const bool has_next = S.next(ui + 1, nxt);
        const PG8_GAS char* nA = has_next ? (const PG8_GAS char*)g.A + (size_t)nxt.pm * tstep : cA; const PG8_GAS char* nB = has_next ? (const PG8_GAS char*)g.Bt + (size_t)nxt.pn * tstep : cB;
        for (int t = 0; t < nt; t += 2) {
            const bool last = (t == nt - 2);
            const PG8_GAS char* a1 = cA + (size_t)(t + 1) * kstep;
            const PG8_GAS char* a2 = last ? nA : cA + (size_t)(t + 2) * kstep; const PG8_GAS char* b2 = last ? nB : cB + (size_t)(t + 2) * kstep;
            const PG8_GAS char* a3 = a2 + kstep; const PG8_GAS char* b3 = b2 + kstep;
            if (last && has_next) S.a_ready(nxt);
            if constexpr (SP2) {
            PG8_LDB(B0, 0, 0); PG8_LDB(B1, 0, 1); PG8_SCHED; PG8_LDA(At, 0, 0); PG8_STAGE(PG8_SA(1, 1), a1 + hstep, voffA);
            PG8_WAIT_V(8); PG8_WAIT_L(0); PG8_BAR; PG8_MMA(0, 0, At, B0); PG8_MMA(0, 1, At, B1); PG8_BAR; PG8_SCHED;
            PG8_LDA(At, 0, 1); PG8_STAGE(PG8_SB(0, 0), b2, voffB); PG8_STAGE(PG8_SB(0, 1), b2 + hstep, voffB); PG8_STAGE(PG8_SA(0, 0), a2, voffA);
            PG8_WAIT_V(8); PG8_WAIT_L(0); PG8_BAR; PG8_MMA(1, 0, At, B0); PG8_MMA(1, 1, At, B1); PG8_BAR; PG8_SCHED;
            PG8_LDB(B0, 1, 0); PG8_LDB(B1, 1, 1); PG8_SCHED; PG8_LDA(At, 1, 0); PG8_STAGE(PG8_SA(0, 1), a2 + hstep, voffA);
            PG8_WAIT_V(8); PG8_WAIT_L(0); PG8_BAR; PG8_MMA(0, 0, At, B0); PG8_MMA(0, 1, At, B1); PG8_BAR; PG8_SCHED;
            PG8_LDA(At, 1, 1); PG8_STAGE(PG8_SB(1, 0), b3, voffB); PG8_STAGE(PG8_SB(1, 1), b3 + hstep, voffB); PG8_STAGE(PG8_SA(1, 0), a3, voffA);
            PG8_WAIT_V(8); PG8_WAIT_L(0); PG8_BAR; PG8_MMA(1, 0, At, B0); PG8_MMA(1, 1, At, B1); PG8_BAR; PG8_SCHED;
            } else {
            PG8_LDB(B0, 0, 0); PG8_SCHED; PG8_LDA(At, 0, 0); PG8_STAGE(PG8_SA(1, 1), a1 + hstep, voffA);
            PG8_WAIT_L(8); PG8_BAR; PG8_WAIT_L(0); PG8_MMA(0, 0, At, B0); PG8_BAR; PG8_SCHED;
            PG8_LDB(B1, 0, 1); PG8_STAGE(PG8_SB(0, 0), b2, voffB);
            PG8_BAR; PG8_WAIT_L(0); PG8_MMA(0, 1, At, B1); PG8_BAR;
            PG8_LDA(At, 0, 1); PG8_STAGE(PG8_SA(0, 0), a2, voffA);
            PG8_BAR; PG8_WAIT_L(0); PG8_MMA(1, 0, At, B0); PG8_BAR; PG8_SCHED;
            PG8_STAGE(PG8_SB(0, 1), b2 + hstep, voffB);
            PG8_WAIT_V(6); PG8_BAR; PG8_MMA(1, 1, At, B1); PG8_BAR;
            PG8_LDB(B0, 1, 0); PG8_SCHED; PG8_LDA(At, 1, 0); PG8_STAGE(PG8_SA(0, 1), a2 + hstep, voffA);
            PG8_WAIT_L(8); PG8_BAR; PG8_WAIT_L(0); PG8_MMA(0, 0, At, B0); PG8_BAR; PG8_SCHED;
            PG8_LDB(B1, 1, 1); PG8_STAGE(PG8_SB(1, 0), b3, voffB);
            PG8_BAR; PG8_WAIT_L(0); PG8_MMA(0, 1, At, B1); PG8_BAR;
            PG8_LDA(At, 1, 1); PG8_STAGE(PG8_SA(1, 0), a3, voffA);
            PG8_BAR; PG8_WAIT_L(0); PG8_MMA(1, 0, At, B0); PG8_BAR; PG8_SCHED;
            PG8_STAGE(PG8_SB(1, 1), b3 + hstep, voffB);
            PG8_WAIT_V(6); PG8_BAR; PG8_MMA(1, 1, At, B1); PG8_BAR;
            }
        }
        if constexpr (ALIGN_EPI) { if (wr == 0) PG8_BAR; }
        if constexpr (!Epi::AFTER_DRAIN) { E(acc, cur, wr, wc, fr, fq); S.done(cur); }
        if (!has_next) break;
#pragma unroll
        for (int a = 0; a < 2; ++a)
#pragma unroll
            for (int b = 0; b < 2; ++b)
#pragma unroll
                for (int m = 0; m < 4; ++m)
#pragma unroll
                    for (int n = 0; n < 2; ++n) acc[a][b][m][n] = (f32x4){0.f, 0.f, 0.f, 0.f};
        cur = nxt; cA = nA; cB = nB; ++ui;
        if constexpr (ALIGN_EPI) { if (wr == 1) PG8_BAR; }
    }
    PG8_WAIT_V(0);
    if constexpr (!ALIGN_EPI) { if (wr == 0) PG8_BAR; }
    PG8_BAR;
    if constexpr (Epi::AFTER_DRAIN) { E.fused(acc, cur, wr, wc, fr, fq, lds, wid, lane); S.done(cur); }
#undef PG8_SA
#undef PG8_SB
#undef PG8_STAGE
#undef PG8_LDA
#undef PG8_LDB
#undef PG8_MMA
#undef PG8_WAIT_V
#undef PG8_WAIT_L
#undef PG8_BAR
#undef PG8_SCHED
}
}
#define GAS __attribute__((address_space(1)))
#define LAS __attribute__((address_space(3)))
typedef unsigned short bf16;
typedef unsigned v4u __attribute__((ext_vector_type(4)));
typedef float f32x4 __attribute__((ext_vector_type(4)));
typedef short bf16x8 __attribute__((ext_vector_type(8)));
typedef GAS unsigned gu32;
typedef GAS unsigned long long gu64;
#define RLX_AGENT __ATOMIC_RELAXED, __HIP_MEMORY_SCOPE_AGENT
#define LDS_WAIT() asm volatile("s_waitcnt lgkmcnt(0)" ::: "memory")
#define VM_WAIT() asm volatile("s_waitcnt vmcnt(0)" ::: "memory")
__device__ __forceinline__ unsigned long long rt() { return __builtin_amdgcn_s_memrealtime(); }
__device__ __forceinline__ unsigned f2bf(float f) { unsigned u = __builtin_bit_cast(unsigned, f); return (u + 0x7fffu + ((u >> 16) & 1u)) >> 16; }
__device__ __forceinline__ unsigned pk2(float lo, float hi) { return f2bf(lo) | (f2bf(hi) << 16); }

#define XB_TMO      128
#define XB_XCNT(j)  (256  + 64 * (j))
#define XB_XSUB(j)  (1280 + 64 * (j))
#define XB_XGEN(j)  (2304 + 64 * (j))
#define XB_TOP      3328
#define XB_TOPGEN   3392
#define XCD_BAR_WORDS 3456
#define XB_SPIN_CAP (1u << 18)

__device__ __forceinline__ unsigned xb_ld(unsigned* p)              { return __hip_atomic_load(p, __ATOMIC_RELAXED, __HIP_MEMORY_SCOPE_AGENT); }
__device__ __forceinline__ unsigned xb_add(unsigned* p, unsigned v) { return __hip_atomic_fetch_add(p, v, __ATOMIC_RELAXED, __HIP_MEMORY_SCOPE_AGENT); }
__device__ __forceinline__ unsigned xb_xcc_id() { return (unsigned)__builtin_amdgcn_s_getreg((3 << 11) | 20) & 0xFu; }
#define XB_SPIN(cond, bar) do { unsigned _sp = 0; while (cond) { __builtin_amdgcn_s_sleep(1); \
    if ((++_sp & 255u) == 0u) { if (xb_ld(&(bar)[XB_TMO])) break; if (_sp > XB_SPIN_CAP) { atomicAdd(&(bar)[XB_TMO], 1u); break; } } } } while (0)

struct XcdBarrier {
    unsigned* bar; unsigned x;
    volatile LAS unsigned* st;
};

__device__ __forceinline__ XcdBarrier xcd_barrier_post(unsigned* bar, volatile LAS unsigned* st, const int tid) {
    XcdBarrier b; b.bar = bar; b.x = xb_xcc_id(); b.st = st;
    if (tid == 0) (void)xb_add(&bar[XB_XCNT(b.x)], 1u);
    return b;
}
__device__ __forceinline__ void xcd_barrier_complete(unsigned* bar, unsigned x, unsigned& nloc, unsigned& nx) {
    const unsigned G = gridDim.x * gridDim.y * gridDim.z;
    unsigned sum, cnt, mine, sp = 0u;
    for (;;) {
        sum = 0u; cnt = 0u; mine = 0u;
#pragma unroll
        for (unsigned j = 0; j < 16; ++j) { const unsigned c = xb_ld(&bar[XB_XCNT(j)]); sum += c; cnt += (c > 0u) ? 1u : 0u; mine = (j == x) ? c : mine; }
        if (sum == G) break;
        __builtin_amdgcn_s_sleep(1);
        if ((++sp & 255u) == 0u) { if (xb_ld(&bar[XB_TMO])) break; if (sp > XB_SPIN_CAP) { atomicAdd(&bar[XB_TMO], 1u); break; } }
    }
    nloc = mine > 0u ? mine : 1u; nx = cnt > 0u ? cnt : 1u;
}

__device__ __forceinline__ void xcd_barrier(const XcdBarrier& b, const int tid) {
    asm volatile("s_waitcnt vmcnt(0)" ::: "memory");
    __syncthreads();
    if (tid == 0) {
        unsigned* bar = b.bar;
        __builtin_amdgcn_s_waitcnt(0);
        unsigned nloc = b.st[0], nx = b.st[1];
        if (nloc == 0u) { xcd_barrier_complete(bar, b.x, nloc, nx); b.st[0] = nloc; b.st[1] = nx; }
        const unsigned old = xb_add(&bar[XB_XSUB(b.x)], 1u);
        const unsigned gen = old / nloc;
        if (old + 1u == (gen + 1u) * nloc) {
            __builtin_amdgcn_fence(__ATOMIC_RELEASE, "agent");
            asm volatile("s_waitcnt vmcnt(0)" ::: "memory");
            const unsigned og = xb_add(&bar[XB_TOP], 1u);
            const unsigned tg = og / nx;
            if (og + 1u == (tg + 1u) * nx) xb_add(&bar[XB_TOPGEN], 1u);
            else XB_SPIN(xb_ld(&bar[XB_TOPGEN]) == tg, bar);
            __builtin_amdgcn_fence(__ATOMIC_ACQUIRE, "agent");
            xb_add(&bar[XB_XGEN(b.x)], 1u);
            asm volatile("s_waitcnt vmcnt(0)" ::: "memory");
        } else {
            XB_SPIN(xb_ld(&bar[XB_XGEN(b.x)]) == gen, bar);
            __builtin_amdgcn_fence(__ATOMIC_ACQUIRE, "agent");
            asm volatile("s_waitcnt vmcnt(0)" ::: "memory");
        }
    }
    __syncthreads();
}
constexpr int BATCH = 2, SEQ = 4096, DM = 2048, DEPTH = 4, MTOK = BATCH * SEQ;
constexpr int HD = 64, RH = 12, AH = 12, GGRP = 8, RWID = 768, AWID = 768, GWID = 512;
constexpr int RCOLS = 2560, ACOLS = 2304, GCOLS = 1024, INCOLS = 5888, DFF = 5632, UPN = 2 * DFF;
constexpr int QOFF = RCOLS, KOFF = RCOLS + AWID, VOFF = RCOLS + 2 * AWID, GOFF = RCOLS + ACOLS;
constexpr int TCH = 64, NCH = SEQ / TCH;
constexpr int NTASK_SCAN = BATCH * RH * NCH;
constexpr float NORM_EPS = 1e-6f, GN_EPS = 1e-5f, RWKV_LN_EPS = 64e-5f;
constexpr float DECAY_SCALE = 0.6065306597126334f;
constexpr int NWAVES = 8, NTHR = NWAVES * 64;

constexpr size_t MiB = 1u << 20;
constexpr size_t WS_CTL = 0, CTL_ZERO_BYTES = 1 * MiB;
constexpr size_t WS_WIN = 2 * MiB, WS_WOUT = 94 * MiB, WS_WUP = 126 * MiB, WS_WDN = 302 * MiB;
constexpr size_t WS_HN = 390 * MiB, WS_Y = 422 * MiB, WS_O = 454 * MiB;
constexpr size_t WS_REG = 518 * MiB;
constexpr size_t WS_PROJ = WS_REG;
constexpr size_t WS_RW = WS_REG + 92 * MiB;
constexpr size_t WS_CHK = WS_RW + 216 * MiB;
constexpr size_t WS_QKR = WS_CHK + 72 * MiB;
constexpr size_t WS_AO = WS_QKR + 24 * MiB;
constexpr size_t WS_LSE = WS_AO + 72 * MiB;
constexpr size_t WS_SGU = WS_LSE + 2 * MiB;
constexpr size_t WS_BON = WS_SGU + 32 * MiB;
constexpr size_t WS_LORA = WS_BON + 1 * MiB;
constexpr size_t WS_SGW = WS_LORA + 2 * MiB;
constexpr size_t WS_END_MIX = WS_SGW + 1 * MiB;
constexpr size_t WS_UP = WS_REG;
constexpr size_t WS_H = WS_REG + 176 * MiB;
constexpr size_t WS_END = WS_END_MIX;
static_assert(WS_H + 88 * MiB <= WS_END, "map");
constexpr int LORA_L = RWID * 256;
constexpr int CW_BAR = 4096, CW_ATT = 8192;

constexpr int RING_BYTES = 131072, LDSCTL_OFF = RING_BYTES, MISC_OFF = LDSCTL_OFF + 320, LDS_BYTES = 147456;

struct Params { const float* in[29]; float* out; unsigned char* ws; };

typedef const GAS float* gcf; typedef GAS float* gfp; typedef const GAS bf16* gcb; typedef GAS bf16* gbp; typedef const GAS int* gci;
__device__ __forceinline__ float bf2f(unsigned short u) { return __builtin_bit_cast(float, (unsigned)u << 16); }
__device__ __forceinline__ float bflo(unsigned u) { return __builtin_bit_cast(float, u << 16); }
__device__ __forceinline__ float bfhi(unsigned u) { return __builtin_bit_cast(float, u & 0xffff0000u); }
__device__ __forceinline__ float wave_sum(float v) {
#pragma unroll
    for (int o = 1; o < 64; o <<= 1) v += __shfl_xor(v, o);
    return v;
}
__device__ __forceinline__ float wave_max(float v) {
#pragma unroll
    for (int o = 1; o < 64; o <<= 1) v = fmaxf(v, __shfl_xor(v, o));
    return v;
}
__device__ __forceinline__ float sigmoidf_(float x) { return 1.f / (1.f + __expf(-x)); }
__device__ __forceinline__ float gelu_tanh(float x) { const float u = 0.7978845608028654f * (x + 0.044715f * x * x * x); return 0.5f * x * (1.f + tanhf(u)); }

typedef float f32x16 __attribute__((ext_vector_type(16)));
typedef float f32x2_t __attribute__((ext_vector_type(2))); typedef __bf16 bf16x2_t __attribute__((ext_vector_type(2)));
typedef short s16x4 __attribute__((ext_vector_type(4)));
__device__ __forceinline__ unsigned cvtpk(float lo, float hi) { f32x2_t v = {lo, hi}; bf16x2_t b = __builtin_convertvector(v, bf16x2_t); return __builtin_bit_cast(unsigned, b); }
__device__ __forceinline__ bf16x8 pack8(float a0, float a1, float a2, float a3, float a4, float a5, float a6, float a7) { v4u p; p.x = cvtpk(a0, a1); p.y = cvtpk(a2, a3); p.z = cvtpk(a4, a5); p.w = cvtpk(a6, a7); return __builtin_bit_cast(bf16x8, p); }
#define MFMA16(a, b, c) __builtin_amdgcn_mfma_f32_16x16x32_bf16((a), (b), (c), 0, 0, 0)
#define MFMA32(a, b, c) __builtin_amdgcn_mfma_f32_32x32x16_bf16((a), (b), (c), 0, 0, 0)
__device__ __forceinline__ int crow(int reg, int h) { return (reg & 3) + 8 * (reg >> 2) + 4 * h; }

__device__ __forceinline__ void p0_transpose_item(gcf W, int K, int N, gbp WT, int row_off, LAS float* scr, int item, int lane) {
    const int nblk = N / 32, kb = item / nblk, nb = item % nblk, k0 = 64 * kb, n0 = 32 * nb;
#pragma unroll 8
    for (int i = 0; i < 32; ++i) { const int kk = 2 * i + (lane >> 5); scr[kk * 33 + (lane & 31)] = W[(size_t)(k0 + kk) * N + n0 + (lane & 31)]; }
    LDS_WAIT(); asm volatile("" ::: "memory");
    const int c = lane & 7;
#pragma unroll
    for (int j = 0; j < 4; ++j) { const int n = (lane >> 3) + 8 * j; const LAS float* s = scr + (8 * c) * 33 + n;
        v4u o; o.x = pk2(s[0 * 33], s[1 * 33]); o.y = pk2(s[2 * 33], s[3 * 33]); o.z = pk2(s[4 * 33], s[5 * 33]); o.w = pk2(s[6 * 33], s[7 * 33]);
        *(GAS v4u*)(WT + (size_t)(row_off + n0 + n) * K + k0 + 8 * c) = o; }
    LDS_WAIT(); asm volatile("" ::: "memory");
}

__device__ __forceinline__ void rowpass(gcf xin, gcf delta, gcf gpost, gfp xout, gcf gnext, gbp hn, int gw, int ngw, int lane) {
    for (int m = gw; m < MTOK; m += ngw) {
        const GAS f32x4* xr = (const GAS f32x4*)(xin + (size_t)m * DM) + lane;
        f32x4 xv[8];
#pragma unroll
        for (int j = 0; j < 8; ++j) xv[j] = xr[64 * j];
        if (delta) {
            const GAS f32x4* dr = (const GAS f32x4*)(delta + (size_t)m * DM) + lane;
            f32x4 dv[8]; float ss = 0.f;
#pragma unroll
            for (int j = 0; j < 8; ++j) { dv[j] = dr[64 * j]; ss += dv[j].x * dv[j].x + dv[j].y * dv[j].y + dv[j].z * dv[j].z + dv[j].w * dv[j].w; }
            const float rstd = rsqrtf(wave_sum(ss) * (1.f / DM) + NORM_EPS);
            GAS f32x4* xo = (GAS f32x4*)(xout + (size_t)m * DM) + lane;
#pragma unroll
            for (int j = 0; j < 8; ++j) { const f32x4 g = ((const GAS f32x4*)gpost)[lane + 64 * j]; xv[j] = xv[j] + dv[j] * rstd * g; xo[64 * j] = xv[j]; }
        }
        if (gnext) {
            float ss = 0.f;
#pragma unroll
            for (int j = 0; j < 8; ++j) ss += xv[j].x * xv[j].x + xv[j].y * xv[j].y + xv[j].z * xv[j].z + xv[j].w * xv[j].w;
            const float rstd = rsqrtf(wave_sum(ss) * (1.f / DM) + NORM_EPS);
            GAS unsigned long long* o8 = (GAS unsigned long long*)(hn + (size_t)m * DM) + lane;
#pragma unroll
            for (int j = 0; j < 8; ++j) { const f32x4 g = ((const GAS f32x4*)gnext)[lane + 64 * j]; const f32x4 v = xv[j] * rstd * g;
                o8[64 * j] = (unsigned long long)pk2(v.x, v.y) | ((unsigned long long)pk2(v.z, v.w) << 32); }
        }
    }
}

struct PrepW { gcf sgu_g, sgu_b; gci pos; };
__device__ __forceinline__ void prep_token(int tok, gcb PROJ, const PrepW& w, gbp QKR, gbp SU, gbp SVN, int lane) {
    gcb prow = PROJ + (size_t)tok * INCOLS;
    {
        float cs = 1.f, sn = 0.f;
        if (lane < 16) { const int f = lane & 7; const float inv = exp2f(-(float)f * (18.931568569324174f / 8.f)); const float ang = (float)w.pos[tok] * inv; cs = cosf(ang); sn = sinf(ang); }
#pragma unroll 4
        for (int i = 0; i < 24; ++i) { const int c = lane + 64 * i; float x = bf2f(prow[QOFF + c]);
            if (lane < 16) { const float oth = bf2f(prow[QOFF + c + (lane < 8 ? 8 : -8)]); x = lane < 8 ? x * cs - oth * sn : x * cs + oth * sn; }
            if (i < 12) x *= 0.18033688011112042f;
            QKR[(size_t)tok * 1536 + c] = (bf16)f2bf(x); }
    }
#pragma unroll 4
    for (int i = 0; i < 16; ++i) { const int c = lane + 64 * i; const float z = gelu_tanh(bf2f(prow[GOFF + c]));
        if (i < 8) SU[(size_t)tok * GWID + c] = (bf16)f2bf(z);
        else { const int g = i - 8; const float mu = wave_sum(z) * (1.f / 64.f); const float d = z - mu; const float var = wave_sum(d * d) * (1.f / 64.f);
            SVN[(size_t)tok * GWID + g * 64 + lane] = (bf16)f2bf(d * rsqrtf(var + GN_EPS) * w.sgu_g[g * 64 + lane] + w.sgu_b[g * 64 + lane]); } }
}

constexpr int LIN_ROW = 264;
struct RPW { gcf mu, w0, a0, kk_, ka_, rk; gcb w2t, a2t, g2t; };
__device__ __forceinline__ f32x4 ld4bf(gcb p) { const unsigned long long u = *(const GAS unsigned long long*)p; const unsigned lo = (unsigned)u, hi = (unsigned)(u >> 32); return (f32x4){bflo(lo), bfhi(lo), bflo(hi), bfhi(hi)}; }
__device__ __forceinline__ void rwkv_prep_unit(int unit, gcb PROJ, const RPW& w, gfp RWb, gfp BON, LAS unsigned char* lds, int tid, int wave, int lane) {
    constexpr size_t AS = (size_t)MTOK * RWID;
    gfp R = RWb; gfp Wd = RWb + AS; gfp K2 = RWb + 2 * AS; gfp V = RWb + 3 * AS; gfp KK = RWb + 4 * AS; gfp KKA = RWb + 5 * AS; gfp Gt = RWb + 6 * AS;
    const int tok0 = unit * 32;
    LAS bf16* lin = (LAS bf16*)lds;
    {
        const int tk = tid >> 4, c0 = (tid & 15) * 16, tokA = tok0 + tk, tA = tokA % SEQ;
        gcb pr = PROJ + (size_t)tokA * INCOLS + 2304 + c0;
        unsigned ob[8];
#pragma unroll
        for (int q4 = 0; q4 < 4; ++q4) { const f32x4 cu = ld4bf(pr + 4 * q4); f32x4 pv = {0.f, 0.f, 0.f, 0.f}; if (tA > 0) pv = ld4bf(pr + 4 * q4 - INCOLS);
            const f32x4 mu = *(const GAS f32x4*)(w.mu + 2304 + c0 + 4 * q4); f32x4 x = cu + (pv - cu) * mu;
#pragma unroll
            for (int e = 0; e < 4; ++e) { const int c = c0 + 4 * q4 + e; x[e] = c < 64 ? tanhf(x[e]) : (c < 128 ? x[e] : sigmoidf_(x[e])); }
            ob[2 * q4] = pk2(x[0], x[1]); ob[2 * q4 + 1] = pk2(x[2], x[3]); }
        LAS v4u* dst = (LAS v4u*)(lin + tk * LIN_ROW + c0);
        dst[0] = (v4u){ob[0], ob[1], ob[2], ob[3]}; dst[1] = (v4u){ob[4], ob[5], ob[6], ob[7]};
    }
    __syncthreads();
    const int tt = wave & 1, hq = wave >> 1, tl = lane & 15, g = lane >> 4;
    const int tok = tok0 + 16 * tt + tl, t = tok % SEQ;
    bf16x8 bfr[8];
#pragma unroll
    for (int ks = 0; ks < 8; ++ks) bfr[ks] = *(const LAS bf16x8*)(lin + (16 * tt + tl) * LIN_ROW + 32 * ks + 8 * g);
    gcb prow = PROJ + (size_t)tok * INCOLS;
    for (int hi = 0; hi < 3; ++hi) { const int h = hq + 4 * hi;
        f32x4 kr[4], aa[4]; float ss = 0.f, bon = 0.f;
#pragma unroll
        for (int nt = 0; nt < 4; ++nt) { const int n0 = h * 64 + 16 * nt;
            f32x4 cw = {0.f, 0.f, 0.f, 0.f}, ca = cw, cg = cw;
#pragma unroll
            for (int ks = 0; ks < 2; ++ks) { cw = MFMA16(*(const GAS bf16x8*)(w.w2t + (n0 + tl) * 64 + 32 * ks + 8 * g), bfr[ks], cw);
                                             ca = MFMA16(*(const GAS bf16x8*)(w.a2t + (n0 + tl) * 64 + 32 * ks + 8 * g), bfr[2 + ks], ca); }
#pragma unroll
            for (int ks = 0; ks < 4; ++ks) cg = MFMA16(*(const GAS bf16x8*)(w.g2t + (n0 + tl) * 128 + 32 * ks + 8 * g), bfr[4 + ks], cg);
            const int c = n0 + 4 * g;
            const f32x4 pr_ = ld4bf(prow + c), pk_ = ld4bf(prow + 768 + c), pv_ = ld4bf(prow + 1536 + c);
            f32x4 qr_ = {0.f, 0.f, 0.f, 0.f}, qk_ = qr_, qv_ = qr_;
            if (t > 0) { qr_ = ld4bf(prow - INCOLS + c); qk_ = ld4bf(prow - INCOLS + 768 + c); qv_ = ld4bf(prow - INCOLS + 1536 + c); }
            const f32x4 r4 = pr_ + (qr_ - pr_) * *(const GAS f32x4*)(w.mu + c), k4 = pk_ + (qk_ - pk_) * *(const GAS f32x4*)(w.mu + 768 + c), v4 = pv_ + (qv_ - pv_) * *(const GAS f32x4*)(w.mu + 1536 + c);
            const f32x4 w04 = *(const GAS f32x4*)(w.w0 + c), a04 = *(const GAS f32x4*)(w.a0 + c), kk4 = *(const GAS f32x4*)(w.kk_ + c), ka4 = *(const GAS f32x4*)(w.ka_ + c), rk4 = *(const GAS f32x4*)(w.rk + c);
            f32x4 dec, a_;
#pragma unroll
            for (int e = 0; e < 4; ++e) { dec[e] = __expf(-DECAY_SCALE * sigmoidf_(w04[e] + cw[e])); a_[e] = sigmoidf_(a04[e] + ca[e]); }
            const f32x4 kkr = k4 * kk4, k2 = k4 * (1.f + (a_ - 1.f) * ka4);
            ss += kkr[0] * kkr[0] + kkr[1] * kkr[1] + kkr[2] * kkr[2] + kkr[3] * kkr[3];
            const f32x4 bb = r4 * k2 * rk4; bon += bb[0] + bb[1] + bb[2] + bb[3];
            { const size_t o = (size_t)tok * RWID + c; *(GAS f32x4*)(R + o) = r4; *(GAS f32x4*)(Wd + o) = dec; *(GAS f32x4*)(K2 + o) = k2; *(GAS f32x4*)(V + o) = v4; *(GAS f32x4*)(Gt + o) = cg; }
            kr[nt] = kkr; aa[nt] = a_; }
        ss += __shfl_xor(ss, 16); ss += __shfl_xor(ss, 32); bon += __shfl_xor(bon, 16); bon += __shfl_xor(bon, 32);
        const float rn = 1.f / fmaxf(sqrtf(ss), 1e-12f);
#pragma unroll
        for (int nt = 0; nt < 4; ++nt) { const size_t o = (size_t)tok * RWID + h * 64 + 16 * nt + 4 * g; const f32x4 kk = kr[nt] * rn;
            *(GAS f32x4*)(KK + o) = kk; *(GAS f32x4*)(KKA + o) = kk * aa[nt]; }
        if (g == 0) BON[tok * 12 + h] = bon; }
    __syncthreads();
}

typedef float f32x2 __attribute__((ext_vector_type(2)));
#define SCHED_FENCE() __builtin_amdgcn_sched_barrier(0)
__device__ __forceinline__ void scan_step(f32x2 (&st)[64], const LAS f32x4* o4, float vcur, float& yo, float& zo) {
    f32x2 sk = {0.f, 0.f};
    f32x4 qa[2][2];
    qa[0][0] = o4[16]; qa[0][1] = o4[17];
#pragma unroll
    for (int g = 0; g < 8; ++g) {
        if (g < 7) { qa[(g + 1) & 1][0] = o4[16 + 2 * (g + 1)]; qa[(g + 1) & 1][1] = o4[17 + 2 * (g + 1)]; }
        SCHED_FENCE();
#pragma unroll
        for (int e = 0; e < 2; ++e) { const f32x4 q = qa[g & 1][e]; const int k = 8 * g + 4 * e;
            sk += st[k] * q.x; sk += st[k + 1] * q.y; sk += st[k + 2] * q.z; sk += st[k + 3] * q.w; }
        SCHED_FENCE();
    }
    const f32x2 vk = {vcur, 0.f};
    f32x2 y = {0.f, 0.f};
    f32x4 ob[2][4];
    ob[0][0] = o4[0]; ob[0][1] = o4[32]; ob[0][2] = o4[48]; ob[0][3] = o4[64];
#pragma unroll
    for (int k4 = 0; k4 < 16; ++k4) {
        if (k4 < 15) { ob[(k4 + 1) & 1][0] = o4[k4 + 1]; ob[(k4 + 1) & 1][1] = o4[33 + k4]; ob[(k4 + 1) & 1][2] = o4[49 + k4]; ob[(k4 + 1) & 1][3] = o4[65 + k4]; }
        SCHED_FENCE();
        { const f32x4 w4 = ob[k4 & 1][0], a4 = ob[k4 & 1][1], kv = ob[k4 & 1][2], r4 = ob[k4 & 1][3];
#pragma unroll
          for (int j = 0; j < 4; ++j) { const int k = 4 * k4 + j; st[k] = st[k] * w4[j] - sk * a4[j] + vk * kv[j]; y += st[k] * r4[j]; } }
        SCHED_FENCE();
    }
    yo = y.x; zo = y.y;
}
__device__ __forceinline__ void scan_chunk(int task, gcf RWb, gfp YL, gfp Z, gbp PT, gfp SLT, LAS float* ops, int lane) {
    constexpr unsigned AS = (unsigned)MTOK * RWID;
    gcf R = RWb; gcf Wd = RWb + AS; gcf K2 = RWb + 2 * AS; gcf V = RWb + 3 * AS; gcf KK = RWb + 4 * AS; gcf KKA = RWb + 5 * AS;
    const int bh = task / NCH, c = task % NCH, b = bh / RH, h = bh % RH;
    const unsigned base = (unsigned)((b * SEQ + c * TCH) * RWID + h * 64 + lane);
    f32x2 st[64];
    int lane_o = lane; asm volatile("" : "+v"(lane_o));
#pragma unroll
    for (int k = 0; k < 64; ++k) st[k] = (f32x2){0.f, (k == lane_o) ? 1.f : 0.f};
    LAS float* b0 = ops; LAS float* b1 = ops + 320;
    float ew = Wd[base], ekk = KK[base], eka = KKA[base], ek = K2[base], er = R[base], ev = V[base];
    float ow = Wd[base + RWID], okk = KK[base + RWID], oka = KKA[base + RWID], ok = K2[base + RWID], orr = R[base + RWID], ov = V[base + RWID];
    b0[lane] = ew; b0[64 + lane] = ekk; b0[128 + lane] = eka; b0[192 + lane] = ek; b0[256 + lane] = er;
    for (int i = 0; i < TCH; i += 2) {
        const float v0 = ev; float y, z;
        if (i + 2 < TCH) { const unsigned o = base + (unsigned)(i + 2) * RWID; ew = Wd[o]; ekk = KK[o]; eka = KKA[o]; ek = K2[o]; er = R[o]; ev = V[o]; }
        scan_step(st, (const LAS f32x4*)b0, v0, y, z);
        { const unsigned o = base + (unsigned)i * RWID; YL[o] = y; Z[o] = z; }
        b1[lane] = ow; b1[64 + lane] = okk; b1[128 + lane] = oka; b1[192 + lane] = ok; b1[256 + lane] = orr;
        const float v1 = ov;
        if (i + 3 < TCH) { const unsigned o = base + (unsigned)(i + 3) * RWID; ow = Wd[o]; okk = KK[o]; oka = KKA[o]; ok = K2[o]; orr = R[o]; ov = V[o]; }
        scan_step(st, (const LAS f32x4*)b1, v1, y, z);
        { const unsigned o = base + (unsigned)(i + 1) * RWID; YL[o] = y; Z[o] = z; }
        b0[lane] = ew; b0[64 + lane] = ekk; b0[128 + lane] = eka; b0[192 + lane] = ek; b0[256 + lane] = er;
    }
    gbp pm = PT + (unsigned)(task * 4096 + lane); gfp sl = SLT + (unsigned)(task * 4096 + lane);
#pragma unroll
    for (int k = 0; k < 64; ++k) { pm[k * 64] = (bf16)f2bf(st[k].y); sl[k * 64] = st[k].x; }
}

__device__ __forceinline__ void scan_carry_mfma(int bh, int vt, gcb PT, gcf SLT, gfp SST, int lane) {
    const int r = lane & 31, h = lane >> 5;
    f32x16 acc[2];
#pragma unroll
    for (int i = 0; i < 16; ++i) { acc[0][i] = 0.f; acc[1][i] = 0.f; }
    s16x4 pa[2][2][2][2]; f32x16 sl[2];
    {   const unsigned tb = (unsigned)(bh * NCH) * 4096u;
#pragma unroll
        for (int mt = 0; mt < 2; ++mt) {
#pragma unroll
            for (int kt = 0; kt < 2; ++kt)
#pragma unroll
                for (int sx = 0; sx < 2; ++sx) { gcb pr = PT + tb + (unsigned)((32 * mt + r) * 64 + 32 * kt + 16 * sx + 4 * h); pa[mt][kt][sx][0] = *(const GAS s16x4*)pr; pa[mt][kt][sx][1] = *(const GAS s16x4*)(pr + 8); }
#pragma unroll
            for (int i = 0; i < 16; ++i) sl[mt][i] = SLT[tb + (unsigned)((32 * mt + crow(i, h)) * 64 + 32 * vt + r)]; } }
    for (int c = 0; c < NCH; ++c) {
        const unsigned tb = (unsigned)(bh * NCH + c) * 4096u;
#pragma unroll
        for (int mt = 0; mt < 2; ++mt)
#pragma unroll
            for (int g = 0; g < 4; ++g) { const f32x4 v = {acc[mt][4 * g], acc[mt][4 * g + 1], acc[mt][4 * g + 2], acc[mt][4 * g + 3]};
                *(GAS f32x4*)(SST + tb + (unsigned)((32 * vt + r) * 64 + 32 * mt + 8 * g + 4 * h)) = v; }
        if (c == NCH - 1) break;
        bf16x8 bfr[2][2], afr[2][2][2];
#pragma unroll
        for (int kt = 0; kt < 2; ++kt)
#pragma unroll
            for (int sx = 0; sx < 2; ++sx) bfr[kt][sx] = pack8(acc[kt][8 * sx], acc[kt][8 * sx + 1], acc[kt][8 * sx + 2], acc[kt][8 * sx + 3], acc[kt][8 * sx + 4], acc[kt][8 * sx + 5], acc[kt][8 * sx + 6], acc[kt][8 * sx + 7]);
#pragma unroll
        for (int mt = 0; mt < 2; ++mt) { acc[mt] = sl[mt];
#pragma unroll
            for (int kt = 0; kt < 2; ++kt)
#pragma unroll
                for (int sx = 0; sx < 2; ++sx) afr[mt][kt][sx] = __builtin_shufflevector(pa[mt][kt][sx][0], pa[mt][kt][sx][1], 0, 1, 2, 3, 4, 5, 6, 7); }
        if (c + 1 < NCH - 1) { const unsigned tn = tb + 4096u;
#pragma unroll
            for (int mt = 0; mt < 2; ++mt) {
#pragma unroll
                for (int kt = 0; kt < 2; ++kt)
#pragma unroll
                    for (int sx = 0; sx < 2; ++sx) { gcb pr = PT + tn + (unsigned)((32 * mt + r) * 64 + 32 * kt + 16 * sx + 4 * h); pa[mt][kt][sx][0] = *(const GAS s16x4*)pr; pa[mt][kt][sx][1] = *(const GAS s16x4*)(pr + 8); }
#pragma unroll
                for (int i = 0; i < 16; ++i) sl[mt][i] = SLT[tn + (unsigned)((32 * mt + crow(i, h)) * 64 + 32 * vt + r)]; } }
#pragma unroll
        for (int mt = 0; mt < 2; ++mt)
#pragma unroll
            for (int kt = 0; kt < 2; ++kt)
#pragma unroll
                for (int sx = 0; sx < 2; ++sx) acc[mt] = MFMA32(afr[mt][kt][sx], bfr[kt][sx], acc[mt]);
    }
}

__device__ __forceinline__ void scan_out(int task, gcf RWb, gcf YL, gcf Z, gcf SST, gcf BON, gcf ln_g, gcf ln_b, gbp Y, LAS float* zb, int lane) {
    constexpr size_t AS = (size_t)MTOK * RWID;
    gcf V = RWb + 3 * AS; gcf Gt = RWb + 6 * AS;
    const int bh = task / NCH, c = task % NCH, b = bh / RH, h = bh % RH;
    const int tok0 = b * SEQ + c * TCH; const int n = h * 64 + lane;
    float S[64];
#pragma unroll
    for (int k4 = 0; k4 < 16; ++k4) { const f32x4 q = *(const GAS f32x4*)(SST + (unsigned)(task * 4096 + lane * 64 + 4 * k4)); S[4 * k4] = q.x; S[4 * k4 + 1] = q.y; S[4 * k4 + 2] = q.z; S[4 * k4 + 3] = q.w; }
    const float lg = ln_g[n], lb = ln_b[n];
    for (int i = 0; i < TCH; ++i) { const int tok = tok0 + i; const size_t o = (size_t)tok * RWID + n;
        zb[(i & 1) * 64 + lane] = Z[o];
        float y = YL[o];
#pragma unroll
        for (int k4 = 0; k4 < 16; ++k4) { const f32x4 q = ((const LAS f32x4*)(zb + (i & 1) * 64))[k4];
            y += S[4 * k4] * q.x + S[4 * k4 + 1] * q.y + S[4 * k4 + 2] * q.z + S[4 * k4 + 3] * q.w; }
        const float mu = wave_sum(y) * (1.f / 64.f); const float d = y - mu; const float var = wave_sum(d * d) * (1.f / 64.f);
        float yn = d * rsqrtf(var + RWKV_LN_EPS) * lg + lb;
        yn += BON[tok * 12 + h] * V[o];
        Y[(size_t)tok * DM + n] = (bf16)f2bf(yn * Gt[o]); }
}

constexpr int ATT_UNITS_PER_BH = 48, ATT_UNITS = BATCH * AH * ATT_UNITS_PER_BH, ATT_KROW = 144, ATT_VROW = 776, ATT_VOFF = 384 * ATT_KROW;
__device__ __forceinline__ void attn_unit(int unit, gcb QKR, gcb PROJ, gfp AOP, gfp LSE, LAS unsigned char* lds, int tid, int wave, int lane) {
    const int bh = unit / ATT_UNITS_PER_BH, uu = unit % ATT_UNITS_PER_BH, b = bh / AH, h = bh % AH;
    int p, d, rho, qb;
    if (uu < 16) { p = 0; d = 1; rho = 0; qb = uu; } else if (uu < 32) { p = 1; d = 4; rho = (uu - 16) >> 2; qb = (uu - 16) & 3; } else { p = 2; d = 16; rho = uu - 32; qb = 0; }
    const int i0 = qb * 256;
    LAS unsigned char* Kl = lds; LAS unsigned char* Vl = lds + ATT_VOFF;
#pragma unroll
    for (int it = 0; it < 6; ++it) { const int idx = tid + 512 * it, key = idx % 384, piece = idx / 384; const int ki = i0 - 128 + key;
        v4u kv = {0u, 0u, 0u, 0u}, vv = {0u, 0u, 0u, 0u};
        if (ki >= 0) { const unsigned tokk = (unsigned)(b * SEQ + rho + d * ki);
            kv = *(const GAS v4u*)(QKR + tokk * 1536u + 768u + (unsigned)(h * 64 + piece * 8));
            vv = *(const GAS v4u*)(PROJ + (size_t)tokk * INCOLS + VOFF + h * 64 + piece * 8); }
        *(LAS v4u*)(Kl + key * ATT_KROW + piece * 16) = kv;
        LAS unsigned short* vd = (LAS unsigned short*)(Vl + (piece * 8) * ATT_VROW + key * 2);
        vd[0 * (ATT_VROW / 2)] = (unsigned short)(vv.x & 0xffffu); vd[1 * (ATT_VROW / 2)] = (unsigned short)(vv.x >> 16);
        vd[2 * (ATT_VROW / 2)] = (unsigned short)(vv.y & 0xffffu); vd[3 * (ATT_VROW / 2)] = (unsigned short)(vv.y >> 16);
        vd[4 * (ATT_VROW / 2)] = (unsigned short)(vv.z & 0xffffu); vd[5 * (ATT_VROW / 2)] = (unsigned short)(vv.z >> 16);
        vd[6 * (ATT_VROW / 2)] = (unsigned short)(vv.w & 0xffffu); vd[7 * (ATT_VROW / 2)] = (unsigned short)(vv.w >> 16); }
    __syncthreads();
    const int r = lane & 31, hh = lane >> 5;
    const int iq0 = i0 + 32 * wave;
    const unsigned tokq = (unsigned)(b * SEQ + rho + d * (iq0 + r));
    bf16x8 qf[4];
#pragma unroll
    for (int sx = 0; sx < 4; ++sx) qf[sx] = *(const GAS bf16x8*)(QKR + tokq * 1536u + (unsigned)(h * 64 + 16 * sx + 8 * hh));
    float m = -1e30f, l = 0.f;
    f32x16 o[2];
#pragma unroll
    for (int i = 0; i < 16; ++i) { o[0][i] = 0.f; o[1][i] = 0.f; }
#pragma unroll
    for (int j = 0; j < 5; ++j) {
        const int kk0 = 32 * wave + 32 * j, kabs0 = iq0 - 128 + 32 * j;
        if (kabs0 + 31 < 0) continue;
        f32x16 st;
#pragma unroll
        for (int i = 0; i < 16; ++i) st[i] = 0.f;
#pragma unroll
        for (int sx = 0; sx < 4; ++sx) { const bf16x8 a = *(const LAS bf16x8*)(Kl + (kk0 + r) * ATT_KROW + (16 * sx + 8 * hh) * 2); st = MFMA32(a, qf[sx], st); }
        bool ok[16]; float tmax = -1e30f;
#pragma unroll
        for (int i = 0; i < 16; ++i) { const int row = crow(i, hh); ok[i] = (kabs0 + row >= 0) && (j != 0 || row >= r) && (j != 4 || row <= r); tmax = fmaxf(tmax, ok[i] ? st[i] : -1e30f); }
        tmax = fmaxf(tmax, __shfl_xor(tmax, 32));
        const float mnew = fmaxf(m, tmax), alpha = exp2f(m - mnew);
        float pr[16], ps = 0.f;
#pragma unroll
        for (int i = 0; i < 16; ++i) { pr[i] = ok[i] ? exp2f(st[i] - mnew) : 0.f; ps += pr[i]; }
        l = l * alpha + ps; m = mnew;
#pragma unroll
        for (int i = 0; i < 16; ++i) { o[0][i] *= alpha; o[1][i] *= alpha; }
#pragma unroll
        for (int s2 = 0; s2 < 2; ++s2) { const bf16x8 bfrag = pack8(pr[8 * s2], pr[8 * s2 + 1], pr[8 * s2 + 2], pr[8 * s2 + 3], pr[8 * s2 + 4], pr[8 * s2 + 5], pr[8 * s2 + 6], pr[8 * s2 + 7]);
#pragma unroll
            for (int mt = 0; mt < 2; ++mt) { const LAS unsigned char* ap = Vl + (32 * mt + r) * ATT_VROW + (kk0 + 16 * s2 + 4 * hh) * 2;
                const s16x4 lo = *(const LAS s16x4*)ap, hi = *(const LAS s16x4*)(ap + 16);
                const bf16x8 a = __builtin_shufflevector(lo, hi, 0, 1, 2, 3, 4, 5, 6, 7);
                o[mt] = MFMA32(a, bfrag, o[mt]); } }
    }
    const float ltot = l + __shfl_xor(l, 32), inv = 1.f / ltot;
    gfp op = AOP + (size_t)p * MTOK * AWID + (size_t)tokq * AWID + h * 64;
#pragma unroll
    for (int mt = 0; mt < 2; ++mt)
#pragma unroll
        for (int g = 0; g < 4; ++g) { const f32x4 v = {o[mt][4 * g] * inv, o[mt][4 * g + 1] * inv, o[mt][4 * g + 2] * inv, o[mt][4 * g + 3] * inv};
            *(GAS f32x4*)(op + 32 * mt + 8 * g + 4 * hh) = v; }
    if (hh == 0) LSE[(size_t)p * MTOK * AH + tokq * AH + h] = (m + log2f(ltot)) * 0.6931471805599453f;
    __syncthreads();
}

__device__ __forceinline__ void attn_norm_token(int tok, gcf AOP, gcf LSE, gcf g, gbp Y, int lane) {
    float v[12], ss = 0.f;
#pragma unroll
    for (int i = 0; i < 12; ++i) { const float l0 = LSE[(size_t)tok * AH + i], l1 = LSE[(size_t)MTOK * AH + (size_t)tok * AH + i], l2 = LSE[2 * (size_t)MTOK * AH + (size_t)tok * AH + i];
        const float mx = fmaxf(fmaxf(l0, l1), l2), w0 = __expf(l0 - mx), w1 = __expf(l1 - mx), w2 = __expf(l2 - mx);
        const size_t o = (size_t)tok * AWID + lane + 64 * i;
        v[i] = (w0 * AOP[o] + w1 * AOP[(size_t)MTOK * AWID + o] + w2 * AOP[2 * (size_t)MTOK * AWID + o]) / (w0 + w1 + w2); ss += v[i] * v[i]; }
    const float rstd = rsqrtf(wave_sum(ss) * (1.f / AWID) + NORM_EPS);
#pragma unroll
    for (int i = 0; i < 12; ++i) Y[(size_t)tok * DM + RWID + lane + 64 * i] = (bf16)f2bf(v[i] * rstd * g[lane + 64 * i]);
}

constexpr int SGU_ROW = 272;
__device__ __forceinline__ void sgu_unit(int unit, gcb SU, gcb SVN, gcb W16  , gcf bs  , gcf ng, gbp Y, LAS unsigned char* lds, int tid, int wave, int lane) {
    const int b = unit / (SEQ / 128), c = unit % (SEQ / 128), tok0 = b * SEQ + c * 128;
    const int tl = lane & 15, g4 = lane >> 4, tok = tok0 + 16 * wave + tl, nks = (wave >> 1) + 1;
    float ss = 0.f, rstd = 0.f;
    for (int pass = 0; pass < 2; ++pass) {
        for (int g = 0; g < 8; ++g) {
            __syncthreads();
#pragma unroll
            for (int it = 0; it < 2; ++it) { const int idx = tid + 512 * it, tj = idx & 127, piece = idx >> 7;
                const v4u vv = *(const GAS v4u*)(SVN + (unsigned)((tok0 + tj) * GWID + g * 64 + piece * 8));
                LAS unsigned short* vd = (LAS unsigned short*)(lds + (piece * 8) * SGU_ROW + tj * 2);
                vd[0 * (SGU_ROW / 2)] = (unsigned short)(vv.x & 0xffffu); vd[1 * (SGU_ROW / 2)] = (unsigned short)(vv.x >> 16);
                vd[2 * (SGU_ROW / 2)] = (unsigned short)(vv.y & 0xffffu); vd[3 * (SGU_ROW / 2)] = (unsigned short)(vv.y >> 16);
                vd[4 * (SGU_ROW / 2)] = (unsigned short)(vv.z & 0xffffu); vd[5 * (SGU_ROW / 2)] = (unsigned short)(vv.z >> 16);
                vd[6 * (SGU_ROW / 2)] = (unsigned short)(vv.w & 0xffffu); vd[7 * (SGU_ROW / 2)] = (unsigned short)(vv.w >> 16); }
            __syncthreads();
            const float bias = bs[g * 128 + 16 * wave + tl];
            f32x4 acc[4];
#pragma unroll
            for (int nt = 0; nt < 4; ++nt) acc[nt] = (f32x4){0.f, 0.f, 0.f, 0.f};
            for (int ks = 0; ks < nks; ++ks) { const bf16x8 bw = *(const GAS bf16x8*)(W16 + (unsigned)((g * 128 + 16 * wave + tl) * 128 + 32 * ks + 8 * g4));
#pragma unroll
                for (int nt = 0; nt < 4; ++nt) acc[nt] = MFMA16(*(const LAS bf16x8*)(lds + (16 * nt + tl) * SGU_ROW + (32 * ks + 8 * g4) * 2), bw, acc[nt]); }
#pragma unroll
            for (int nt = 0; nt < 4; ++nt) { const int cc = g * 64 + 16 * nt + 4 * g4;
                const f32x4 u4 = ld4bf(SU + (unsigned)(tok * GWID + cc));
                const f32x4 qv = u4 * (acc[nt] + bias);
                if (pass == 0) ss += qv[0] * qv[0] + qv[1] * qv[1] + qv[2] * qv[2] + qv[3] * qv[3];
                else { const f32x4 y = qv * rstd * *(const GAS f32x4*)(ng + cc);
                    *(GAS unsigned long long*)(Y + (unsigned)(tok * DM + RWID + AWID + cc)) = (unsigned long long)pk2(y[0], y[1]) | ((unsigned long long)pk2(y[2], y[3]) << 32); } }
        }
        if (pass == 0) { ss += __shfl_xor(ss, 16); ss += __shfl_xor(ss, 32); rstd = rsqrtf(ss * (1.f / GWID) + NORM_EPS); }
    }
    __syncthreads();
}

__device__ __forceinline__ void conv_item(int item, gcb UP, gcf cw, gcf cb, gbp H) {
    const int tok = item / (DFF / 8), j8 = (item % (DFF / 8)) * 8, t = tok % SEQ;
    float gt[8], vl[8];
#pragma unroll
    for (int e = 0; e < 8; ++e) { gt[e] = cb[j8 + e]; vl[e] = cb[DFF + j8 + e]; }
#pragma unroll
    for (int tap = 0; tap < 3; ++tap) { const int dt = 2 - tap;
        if (t - dt >= 0) { gcb ur = UP + (size_t)(tok - dt) * UPN; const v4u ug = *(const GAS v4u*)(ur + j8), uv = *(const GAS v4u*)(ur + DFF + j8);
            gcf wg = cw + (size_t)tap * UPN + j8; gcf wv = wg + DFF;
            const unsigned a[4] = {ug.x, ug.y, ug.z, ug.w}, c[4] = {uv.x, uv.y, uv.z, uv.w};
#pragma unroll
            for (int e = 0; e < 4; ++e) { gt[2 * e] += bflo(a[e]) * wg[2 * e]; gt[2 * e + 1] += bfhi(a[e]) * wg[2 * e + 1]; vl[2 * e] += bflo(c[e]) * wv[2 * e]; vl[2 * e + 1] += bfhi(c[e]) * wv[2 * e + 1]; } } }
    v4u o; o.x = pk2(gelu_tanh(gt[0]) * vl[0], gelu_tanh(gt[1]) * vl[1]); o.y = pk2(gelu_tanh(gt[2]) * vl[2], gelu_tanh(gt[3]) * vl[3]);
    o.z = pk2(gelu_tanh(gt[4]) * vl[4], gelu_tanh(gt[5]) * vl[5]); o.w = pk2(gelu_tanh(gt[6]) * vl[6], gelu_tanh(gt[7]) * vl[7]);
    *(GAS v4u*)(H + (size_t)tok * DFF + j8) = o;
}

typedef const __attribute__((address_space(4))) unsigned long long* kargs_t;
__device__ __forceinline__ kargs_t kargs() { kargs_t ka = (kargs_t)__builtin_amdgcn_kernarg_segment_ptr(); asm volatile("" : "+s"(ka)); return ka; }
#define KIN(i) ((gcf)ka[i])
#define KOUT ((gfp)ka[29])
#define KWS ((GAS unsigned char*)ka[30])
constexpr size_t AS_ = (size_t)MTOK * RWID;
__device__ __forceinline__ int lane_id() { int l; asm volatile("v_mbcnt_lo_u32_b32 %0, -1, 0\n\tv_mbcnt_hi_u32_b32 %0, -1, %0" : "=v"(l)); return l; }
#define PH_IDS const int lane = lane_id(); const int tid = wave * 64 + lane; (void)tid
#define GBAR() do { const int lane_b = lane_id(); kargs_t kb = kargs(); XcdBarrier bb; bb.bar = (unsigned*)((GAS unsigned*)((GAS unsigned char*)kb[30] + WS_CTL) + CW_BAR); bb.x = xb_xcc_id(); \
    bb.st = (volatile LAS unsigned*)(lds + MISC_OFF) + 8; xcd_barrier(bb, wave * 64 + lane_b); } while (0)

__global__ void __launch_bounds__(NTHR, 2) mega_fwd(Params p) {
    extern __shared__ __attribute__((aligned(16))) unsigned char lds_raw[];
    LAS unsigned char* lds = (LAS unsigned char*)lds_raw;
    const int wave = __builtin_amdgcn_readfirstlane((int)threadIdx.x >> 6);
    const int G = gridDim.x, gw = blockIdx.x * NWAVES + wave, ngw = G * NWAVES;
    { PH_IDS; kargs_t ka = kargs();
      for (int u = tid; u < (LDS_BYTES - LDSCTL_OFF) / 4; u += NTHR) ((LAS unsigned*)(lds + LDSCTL_OFF))[u] = 0u;
      __syncthreads();
      (void)xcd_barrier_post((unsigned*)((GAS unsigned*)(KWS + WS_CTL) + CW_BAR), (volatile LAS unsigned*)(lds + MISC_OFF) + 8, tid); }

    {
        PH_IDS; kargs_t ka = kargs(); GAS unsigned char* ws = KWS;
        LAS float* scr = (LAS float* )(lds + wave * 16384);
        for (int l = 0; l < DEPTH; ++l) {
            for (int it = gw; it < (DM / 64) * (INCOLS / 32); it += ngw) p0_transpose_item(KIN(6) + (size_t)l * DM * INCOLS, DM, INCOLS, (gbp)(ws + WS_WIN) + (size_t)l * INCOLS * DM, 0, scr, it, lane);
            for (int it = gw; it < (DM / 64) * (DM / 32); it += ngw) p0_transpose_item(KIN(24) + (size_t)l * DM * DM, DM, DM, (gbp)(ws + WS_WOUT) + (size_t)l * DM * DM, 0, scr, it, lane);
            for (int it = gw; it < (DM / 64) * (UPN / 32); it += ngw) p0_transpose_item(KIN(25) + (size_t)l * DM * UPN, DM, UPN, (gbp)(ws + WS_WUP) + (size_t)l * UPN * DM, 0, scr, it, lane);
            for (int it = gw; it < (DFF / 64) * (DM / 32); it += ngw) p0_transpose_item(KIN(28) + (size_t)l * DFF * DM, DFF, DM, (gbp)(ws + WS_WDN) + (size_t)l * DM * DFF, 0, scr, it, lane);
        }
        {
            gbp SW = (gbp)(ws + WS_SGW);
            for (int i = blockIdx.x * NTHR + tid; i < DEPTH * 8 * 128 * 128; i += G * NTHR) { const int jj = i & 127, ii = (i >> 7) & 127; SW[i] = (bf16)f2bf(jj <= ii ? KIN(21)[i] : 0.f); } }
        {
            gbp LW = (gbp)(ws + WS_LORA);
            for (int i = blockIdx.x * NTHR + tid; i < DEPTH * LORA_L; i += G * NTHR) { const int l = i / LORA_L, rr = i % LORA_L;
                float v; if (rr < RWID * 64) { const int n = rr / 64, k = rr % 64; v = KIN(9)[(size_t)l * 64 * RWID + k * RWID + n]; }
                else if (rr < RWID * 128) { const int q = rr - RWID * 64, n = q / 64, k = q % 64; v = KIN(11)[(size_t)l * 64 * RWID + k * RWID + n]; }
                else { const int q = rr - RWID * 128, n = q / 128, k = q % 128; v = KIN(12)[(size_t)l * 128 * RWID + k * RWID + n]; }
                LW[i] = (bf16)f2bf(v); } }
        rowpass(KIN(0), nullptr, nullptr, nullptr, KIN(2), (gbp)(ws + WS_HN), gw, ngw, lane);
    }
    GBAR();

    for (int l = 0; l < DEPTH; ++l) {
        { PH_IDS; kargs_t ka = kargs(); GAS unsigned char* ws = KWS;
          pg8::Gemm g{(gbp)(ws + WS_HN), (gbp)(ws + WS_WIN) + (size_t)l * INCOLS * DM, MTOK, INCOLS, DM}; pg8::StaticOrder S; S.init(MTOK, INCOLS, G, (int)blockIdx.x);
          pg8::EpiBf16<0> E{(gbp)(ws + WS_PROJ), INCOLS, nullptr, 0, 0, 1.f};
          pg8::gemm_phase<pg8::EpiBf16<0>, pg8::StaticOrder, true, true>(lds, g, S, E, tid); }
        GBAR();
        { PH_IDS; kargs_t ka = kargs(); GAS unsigned char* ws = KWS;
          gcb LW = (gcb)(ws + WS_LORA) + (size_t)l * LORA_L;
          RPW rw{KIN(7) + (size_t)l * RCOLS, KIN(8) + (size_t)l * RWID, KIN(10) + (size_t)l * RWID, KIN(13) + (size_t)l * RWID, KIN(14) + (size_t)l * RWID, KIN(15) + (size_t)l * RWID, LW, LW + RWID * 64, LW + RWID * 128};
          for (int u = blockIdx.x; u < MTOK / 32; u += G) rwkv_prep_unit(u, (gcb)(ws + WS_PROJ), rw, (gfp)(ws + WS_RW), (gfp)(ws + WS_BON), lds, tid, wave, lane);
          PrepW w{KIN(19) + (size_t)l * GWID, KIN(20) + (size_t)l * GWID, (gci)KIN(1)};
          gbp SU = (gbp)(ws + WS_SGU);
          for (int tok = gw; tok < MTOK; tok += ngw) prep_token(tok, (gcb)(ws + WS_PROJ), w, (gbp)(ws + WS_QKR), SU, SU + (size_t)MTOK * GWID, lane); }
        GBAR();
        { PH_IDS; kargs_t ka = kargs(); GAS unsigned char* ws = KWS;
          LAS float* ops = (LAS float*)(lds + wave * 4096);
          gfp RWb = (gfp)(ws + WS_RW); gfp PT = (gfp)(ws + WS_CHK);
          for (int task = blockIdx.x + G * wave; task < NTASK_SCAN; task += G * NWAVES) scan_chunk(task, RWb, RWb + 7 * AS_, RWb + 8 * AS_, (gbp)PT, PT + (size_t)NTASK_SCAN * 4096, ops, lane); }
        GBAR();
        if (blockIdx.x < BATCH * RH) { if (wave < 2) { PH_IDS; kargs_t ka = kargs(); GAS unsigned char* ws = KWS; gfp PT = (gfp)(ws + WS_CHK);
              scan_carry_mfma((int)blockIdx.x, wave, (gcb)PT, PT + (size_t)NTASK_SCAN * 4096, PT + 2 * (size_t)NTASK_SCAN * 4096, lane); } }
        else if (blockIdx.x < BATCH * RH + MTOK / 128) { PH_IDS; kargs_t ka = kargs(); GAS unsigned char* ws = KWS; gbp SU = (gbp)(ws + WS_SGU);
              sgu_unit((int)blockIdx.x - BATCH * RH, (gcb)SU, (gcb)SU + (size_t)MTOK * GWID, (gcb)(ws + WS_SGW) + (size_t)l * 8 * 128 * 128, KIN(22) + (size_t)l * 8 * 128, KIN(23) + (size_t)l * GWID, (gbp)(ws + WS_Y), lds, tid, wave, lane); }
        { PH_IDS; kargs_t ka = kargs(); GAS unsigned char* ws = KWS;
          volatile LAS unsigned* MISC = (volatile LAS unsigned*)(lds + MISC_OFF);
          gu32* ctr = (gu32*)(ws + WS_CTL) + CW_ATT + 64 * l;
          for (;;) {
              if (tid == 0) MISC[16] = __hip_atomic_fetch_add(ctr, 1u, __ATOMIC_RELAXED, __HIP_MEMORY_SCOPE_AGENT);
              __syncthreads();
              const int u = (int)MISC[16];
              if (u >= ATT_UNITS) break;
              attn_unit(u, (gcb)(ws + WS_QKR), (gcb)(ws + WS_PROJ), (gfp)(ws + WS_AO), (gfp)(ws + WS_LSE), lds, tid, wave, lane);
          }
        }
        GBAR();
        { PH_IDS; kargs_t ka = kargs(); GAS unsigned char* ws = KWS;
          LAS float* zb = (LAS float*)(lds + wave * 1024);
          gfp RWb = (gfp)(ws + WS_RW); gfp PT = (gfp)(ws + WS_CHK);
          for (int task = gw; task < NTASK_SCAN; task += ngw) scan_out(task, RWb, RWb + 7 * AS_, RWb + 8 * AS_, PT + 2 * (size_t)NTASK_SCAN * 4096, (gfp)(ws + WS_BON), KIN(16) + (size_t)l * RWID, KIN(17) + (size_t)l * RWID, (gbp)(ws + WS_Y), zb, lane);
          for (int tok = gw; tok < MTOK; tok += ngw) attn_norm_token(tok, (gcf)(ws + WS_AO), (gcf)(ws + WS_LSE), KIN(18) + (size_t)l * AWID, (gbp)(ws + WS_Y), lane); }
        GBAR();
        { PH_IDS; kargs_t ka = kargs(); GAS unsigned char* ws = KWS;
          pg8::Gemm g{(gbp)(ws + WS_Y), (gbp)(ws + WS_WOUT) + (size_t)l * DM * DM, MTOK, DM, DM}; pg8::StaticOrder S; S.init(MTOK, DM, G, (int)blockIdx.x);
          pg8::EpiF32 E{(gfp)(ws + WS_O), DM};
          pg8::gemm_phase<pg8::EpiF32, pg8::StaticOrder, true, true>(lds, g, S, E, tid); }
        GBAR();
        { PH_IDS; kargs_t ka = kargs(); GAS unsigned char* ws = KWS;
          rowpass(l == 0 ? KIN(0) : (gcf)KOUT, (gfp)(ws + WS_O), KIN(3) + (size_t)l * DM, KOUT, KIN(4) + (size_t)l * DM, (gbp)(ws + WS_HN), gw, ngw, lane); }
        GBAR();
        { PH_IDS; kargs_t ka = kargs(); GAS unsigned char* ws = KWS;
          pg8::Gemm g{(gbp)(ws + WS_HN), (gbp)(ws + WS_WUP) + (size_t)l * UPN * DM, MTOK, UPN, DM}; pg8::StaticOrder S; S.init(MTOK, UPN, G, (int)blockIdx.x);
          pg8::EpiBf16<0> E{(gbp)(ws + WS_UP), UPN, nullptr, 0, 0, 1.f};
          pg8::gemm_phase<pg8::EpiBf16<0>, pg8::StaticOrder, true, true>(lds, g, S, E, tid); }
        GBAR();
        { PH_IDS; kargs_t ka = kargs(); GAS unsigned char* ws = KWS;
          const int gtid = blockIdx.x * NTHR + tid, ngt = G * NTHR;
          for (int it = gtid; it < MTOK * (DFF / 8); it += ngt) conv_item(it, (gbp)(ws + WS_UP), KIN(26) + (size_t)l * 3 * UPN, KIN(27) + (size_t)l * UPN, (gbp)(ws + WS_H)); }
        GBAR();
        { PH_IDS; kargs_t ka = kargs(); GAS unsigned char* ws = KWS;
          pg8::Gemm g{(gbp)(ws + WS_H), (gbp)(ws + WS_WDN) + (size_t)l * DM * DFF, MTOK, DM, DFF}; pg8::StaticOrder S; S.init(MTOK, DM, G, (int)blockIdx.x);
          pg8::EpiF32 E{(gfp)(ws + WS_O), DM};
          pg8::gemm_phase<pg8::EpiF32, pg8::StaticOrder, true, true>(lds, g, S, E, tid); }
        GBAR();
        { PH_IDS; kargs_t ka = kargs(); GAS unsigned char* ws = KWS;
          rowpass(KOUT, (gfp)(ws + WS_O), KIN(5) + (size_t)l * DM, KOUT, l + 1 < DEPTH ? KIN(2) + (size_t)(l + 1) * DM : nullptr, (gbp)(ws + WS_HN), gw, ngw, lane); }
        if (l + 1 < DEPTH) GBAR();
    }
}

extern "C" void kernel_launch(void* const* d_in, const int* in_sizes, int n_in, void* d_out, int out_size, void* d_ws, size_t ws_size, hipStream_t stream) {
    static int grid = 0;
    if (grid == 0) {
        if (n_in != 29 || out_size != MTOK * DM || ws_size < WS_END) { fprintf(stderr, "kernel_launch: unexpected shapes (n_in %d out %d ws %zu need %zu)\n", n_in, out_size, ws_size, (size_t)WS_END); grid = -1; return; }
        int dev = 0, cus = 0, per_cu = 0;
        if (hipGetDevice(&dev) != hipSuccess || hipDeviceGetAttribute(&cus, hipDeviceAttributeMultiprocessorCount, dev) != hipSuccess) { grid = -1; return; }
        if (hipFuncSetAttribute((const void*)mega_fwd, hipFuncAttributeMaxDynamicSharedMemorySize, LDS_BYTES) != hipSuccess) { fprintf(stderr, "kernel_launch: hipFuncSetAttribute failed\n"); grid = -1; return; }
        if (hipOccupancyMaxActiveBlocksPerMultiprocessor(&per_cu, (const void*)mega_fwd, NTHR, LDS_BYTES) != hipSuccess || per_cu < 1) fprintf(stderr, "kernel_launch: occupancy query says %d\n", per_cu);
        (void)hipGetLastError();
        grid = cus;
    }
    if (grid < 0) return;
    if (hipMemsetAsync((char*)d_ws + WS_CTL, 0, CTL_ZERO_BYTES, stream) != hipSuccess) return;
    Params prm{};
    for (int i = 0; i < 29; ++i) prm.in[i] = (const float*)d_in[i];
    prm.out = (float*)d_out; prm.ws = (unsigned char*)d_ws;
    hipLaunchKernelGGL(mega_fwd, dim3(grid), dim3(NTHR), LDS_BYTES, stream, prm);
}
```

```cpp
#include <hip/hip_runtime.h>
#include <cstdio>
#include <cstdint>
namespace pg8 {
#define PG8_LAS __attribute__((address_space(3)))
#define PG8_GAS __attribute__((address_space(1)))
typedef unsigned short bf16_t;
typedef short bf16x8 __attribute__((ext_vector_type(8)));
typedef float f32x4 __attribute__((ext_vector_type(4)));
typedef unsigned u32x4 __attribute__((ext_vector_type(4)));
constexpr int BM = 256, BK = 64, HALF = 128, HTB = HALF * BK * 2  , STAGE_BYTES = 8 * HTB, NXCD = 8, WGM = 8;

__host__ __device__ __forceinline__ int lds_byte(int r, int c) { const int st = (r >> 4) * 2 + (c >> 5), rr = r & 15, cc = c & 31, ob = rr * 64 + cc * 2; return st * 1024 + (ob ^ (((ob >> 9) & 1) << 5)); }
__host__ __device__ __forceinline__ void stage_rc(int b, int& R, int& C) { const int st = b / 1024, sb = b % 1024, swz = sb ^ (((sb >> 9) & 1) << 5); R = (st >> 1) * 16 + swz / 64; C = (st & 1) * 32 + (swz % 64) / 2; }
__host__ __device__ __forceinline__ int perm32(int rho) { const int n = rho >> 4, i = rho & 15; return 8 * (i >> 2) + 4 * n + (i & 3); }

struct Unit { int pm, pn; };
struct Gemm { const PG8_GAS bf16_t* A; const PG8_GAS bf16_t* Bt; int M, N, K; };

struct StaticOrder {
    int nM, nN, nwg, G, c;
    __host__ __device__ void init(int M, int N, int G_, int c_) { nM = M / BM; nN = N / BM; nwg = nM * nN; G = G_; c = c_; }
    __host__ __device__ bool next(int i, Unit& u) const {
        const long L = (long)i * G + c; if (L >= nwg) return false;
        int wgid = (int)L; { const int q = nwg / NXCD, r = nwg % NXCD, xcd = wgid % NXCD, off = wgid / NXCD; wgid = (xcd < r ? xcd * (q + 1) : r * (q + 1) + (xcd - r) * q) + off; }
        const int nig = WGM * nN, gid = wgid / nig, fm = gid * WGM, gsz = (nM - fm) < WGM ? (nM - fm) : WGM;
        u.pm = fm + ((wgid % nig) % gsz); u.pn = (wgid % nig) / gsz; return true;
    }
    __device__ __forceinline__ void a_ready(const Unit&) const {}
    __device__ __forceinline__ void done(const Unit&) const {}
};

__device__ __forceinline__ unsigned cvt_pk_bf16(float lo, float hi) { unsigned r; asm volatile("v_cvt_pk_bf16_f32 %0, %1, %2" : "=v"(r) : "v"(lo), "v"(hi)); return r; }
typedef float f32x2 __attribute__((ext_vector_type(2)));
__device__ __forceinline__ f32x2 gelu_pk(f32x2 v) {
    const f32x2 av = __builtin_elementwise_abs(v), d = av * 0.2316418882f + 1.0f;
    f32x2 t; t.x = __builtin_amdgcn_rcpf(d.x); t.y = __builtin_amdgcn_rcpf(d.y);
    f32x2 q = t * 0.5307027145f + (-0.7265760135f); q = q * t + 0.7107068705f; q = q * t + (-0.142248368f); q = q * t + 0.127414796f; q = q * t;
    const f32x2 s = (v * v) * (-0.72134752044f);
    f32x2 e; e.x = __builtin_amdgcn_exp2f(s.x); e.y = __builtin_amdgcn_exp2f(s.y);
    const f32x2 m = v * (q * e), r = v - m;
    f32x2 o; o.x = v.x < 0.f ? m.x : r.x; o.y = v.y < 0.f ? m.y : r.y; return o;
}

template <int ACT  > struct EpiBf16 {
    static constexpr bool PERM = true, AFTER_DRAIN = false; static_assert(ACT == 0 || ACT == 1, "EpiBf16: ACT is 0 (none) or 1 (gelu_pk)");
    PG8_GAS bf16_t* O; int ldc; const PG8_GAS float* bias; int split_cols; size_t split_stride; float scale0;
    __device__ __forceinline__ void operator()(const f32x4 (&acc)[2][2][4][2], const Unit& u, int wr, int wc, int fr, int fq) const {
        const int row0 = u.pm * BM + wr * 64 + fr; int colt = u.pn * BM; PG8_GAS bf16_t* base = O;
        float sc = 1.f; if (split_cols) { const int t = colt / split_cols; base += (size_t)t * split_stride; colt -= t * split_cols; if (t == 0) sc = scale0; }
        const int col0 = colt + wc * 32 + 8 * fq, bcol0 = u.pn * BM + wc * 32 + 8 * fq;
        f32x4 bv[2][2];
#pragma unroll
        for (int bj = 0; bj < 2; ++bj)
#pragma unroll
            for (int n = 0; n < 2; ++n) bv[bj][n] = bias ? *(const PG8_GAS f32x4*)(bias + bcol0 + bj * HALF + 4 * n) : (f32x4){0.f, 0.f, 0.f, 0.f};
#pragma unroll
        for (int ai = 0; ai < 2; ++ai)
#pragma unroll
            for (int m = 0; m < 4; ++m) { PG8_GAS bf16_t* rowp = base + (size_t)(row0 + ai * HALF + m * 16) * ldc + col0;
#pragma unroll
                for (int bj = 0; bj < 2; ++bj) { f32x4 v0 = acc[ai][bj][m][0] + bv[bj][0], v1 = acc[ai][bj][m][1] + bv[bj][1];
                    if (ACT == 1) { f32x2 a = gelu_pk((f32x2){v0[0], v0[1]}), b = gelu_pk((f32x2){v0[2], v0[3]}), c = gelu_pk((f32x2){v1[0], v1[1]}), d = gelu_pk((f32x2){v1[2], v1[3]});
                        v0 = (f32x4){a.x, a.y, b.x, b.y}; v1 = (f32x4){c.x, c.y, d.x, d.y}; }
                    v0 = v0 * sc; v1 = v1 * sc; u32x4 w; w.x = cvt_pk_bf16(v0[0], v0[1]); w.y = cvt_pk_bf16(v0[2], v0[3]); w.z = cvt_pk_bf16(v1[0], v1[1]); w.w = cvt_pk_bf16(v1[2], v1[3]);
                    *(PG8_GAS u32x4*)(rowp + bj * HALF) = w; } }
    }
};
struct EpiF32 {
    static constexpr bool PERM = true, AFTER_DRAIN = false;
    PG8_GAS float* O; int ldc;
    __device__ __forceinline__ void operator()(const f32x4 (&acc)[2][2][4][2], const Unit& u, int wr, int wc, int fr, int fq) const {
        const int row0 = u.pm * BM + wr * 64 + fr, col0 = u.pn * BM + wc * 32 + 8 * fq;
#pragma unroll
        for (int ai = 0; ai < 2; ++ai)
#pragma unroll
            for (int m = 0; m < 4; ++m) { PG8_GAS float* rowp = O + (size_t)(row0 + ai * HALF + m * 16) * ldc + col0;
#pragma unroll
                for (int bj = 0; bj < 2; ++bj) { *(PG8_GAS f32x4*)(rowp + bj * HALF) = acc[ai][bj][m][0]; *(PG8_GAS f32x4*)(rowp + bj * HALF + 4) = acc[ai][bj][m][1]; } }
    }
};

__device__ __forceinline__ float dpp_ror1(float x) { return __builtin_bit_cast(float, __builtin_amdgcn_update_dpp(0, __builtin_bit_cast(int, x), 0x121, 0xF, 0xF, false)); }
__device__ __forceinline__ float dpp_ror2(float x) { return __builtin_bit_cast(float, __builtin_amdgcn_update_dpp(0, __builtin_bit_cast(int, x), 0x122, 0xF, 0xF, false)); }
__device__ __forceinline__ float gelu_tanh_fast(float x) { const float u2 = x * (1.5957691216f + 0.0713548162f * x * x); return x * __builtin_amdgcn_rcpf(1.f + __expf(-u2)); }
struct EpiConvGlu {
    static constexpr bool PERM = true, AFTER_DRAIN = false;
    PG8_GAS bf16_t* H; int ldh; const PG8_GAS float* cw; const PG8_GAS float* cb; int upn, dff;
    PG8_GAS float* halo; PG8_GAS float* raw01; PG8_LAS float* xch; int tiles_per_seq;
    __device__ __forceinline__ void operator()(const f32x4 (&acc)[2][2][4][2], const Unit& u, int wr, int wc, int fr, int fq) const {
        const int colt = 32 * wc + 8 * fq;
        const bool first_seq = (u.pm % tiles_per_seq) == 0;
        if (fr >= 14) {
#pragma unroll
            for (int ai = 0; ai < 2; ++ai)
#pragma unroll
                for (int bj = 0; bj < 2; ++bj)
#pragma unroll
                    for (int n = 0; n < 2; ++n) *(PG8_LAS f32x4*)(xch + ((2 * ai + wr) * 2 + (fr - 14)) * 256 + 128 * bj + colt + 4 * n) = acc[ai][bj][3][n];
            if (wr == 1) {
#pragma unroll
                for (int bj = 0; bj < 2; ++bj)
#pragma unroll
                    for (int n = 0; n < 2; ++n) *(PG8_GAS f32x4*)(halo + ((size_t)u.pm * 2 + (fr - 14)) * upn + 256 * u.pn + 128 * bj + colt + 4 * n) = acc[1][bj][3][n]; }
        }
        if (fr < 2 && wr == 0 && !first_seq) {
#pragma unroll
            for (int bj = 0; bj < 2; ++bj)
#pragma unroll
                for (int n = 0; n < 2; ++n) *(PG8_GAS f32x4*)(raw01 + ((size_t)u.pm * 2 + fr) * upn + 256 * u.pn + 128 * bj + colt + 4 * n) = acc[0][bj][0][n]; }
        asm volatile("s_waitcnt lgkmcnt(0)" ::: "memory");
        __builtin_amdgcn_s_barrier();
        const int jcol = 128 * u.pn + colt;
#pragma unroll
        for (int ai = 0; ai < 2; ++ai) { const int seg = 2 * ai + wr;
            unsigned hp[4][2][2];
#pragma unroll
            for (int n = 0; n < 2; ++n) {
                f32x4 vg = {0.f, 0.f, 0.f, 0.f}, vv = vg;
                if (seg > 0 && fr >= 14) { vg = *(const PG8_LAS f32x4*)(xch + ((seg - 1) * 2 + (fr - 14)) * 256 + colt + 4 * n); vv = *(const PG8_LAS f32x4*)(xch + ((seg - 1) * 2 + (fr - 14)) * 256 + 128 + colt + 4 * n); }
                const int j = jcol + 4 * n;
                const f32x4 w0g = *(const PG8_GAS f32x4*)(cw + j), w1g = *(const PG8_GAS f32x4*)(cw + upn + j), w2g = *(const PG8_GAS f32x4*)(cw + 2 * upn + j), bg = *(const PG8_GAS f32x4*)(cb + j);
                const f32x4 w0v = *(const PG8_GAS f32x4*)(cw + dff + j), w1v = *(const PG8_GAS f32x4*)(cw + upn + dff + j), w2v = *(const PG8_GAS f32x4*)(cw + 2 * upn + dff + j), bv = *(const PG8_GAS f32x4*)(cb + dff + j);
                f32x4 pg1, pg2, pv1, pv2;
#pragma unroll
                for (int e = 0; e < 4; ++e) { pg1[e] = dpp_ror1(vg[e]); pg2[e] = dpp_ror2(vg[e]); pv1[e] = dpp_ror1(vv[e]); pv2[e] = dpp_ror2(vv[e]); }
#pragma unroll
                for (int m = 0; m < 4; ++m) { const f32x4 xg = acc[ai][0][m][n], xv = acc[ai][1][m][n]; f32x4 ag1, ag2, av1, av2, hv;
#pragma unroll
                    for (int e = 0; e < 4; ++e) { ag1[e] = dpp_ror1(xg[e]); ag2[e] = dpp_ror2(xg[e]); av1[e] = dpp_ror1(xv[e]); av2[e] = dpp_ror2(xv[e]);
                        const float g1 = fr >= 1 ? ag1[e] : pg1[e], g2 = fr >= 2 ? ag2[e] : pg2[e], v1 = fr >= 1 ? av1[e] : pv1[e], v2 = fr >= 2 ? av2[e] : pv2[e];
                        const float cg = bg[e] + w0g[e] * g2 + w1g[e] * g1 + w2g[e] * xg[e], cv = bv[e] + w0v[e] * v2 + w1v[e] * v1 + w2v[e] * xv[e];
                        hv[e] = gelu_tanh_fast(cg) * cv; }
                    hp[m][n][0] = cvt_pk_bf16(hv[0], hv[1]); hp[m][n][1] = cvt_pk_bf16(hv[2], hv[3]);
                    pg1 = ag1; pg2 = ag2; pv1 = av1; pv2 = av2; }
            }
#pragma unroll
            for (int m = 0; m < 4; ++m) { const int row = u.pm * BM + ai * HALF + wr * 64 + m * 16 + fr;
                const bool skip = !first_seq && ai == 0 && wr == 0 && m == 0 && fr < 2;
                if (!skip) { u32x4 w; w.x = hp[m][0][0]; w.y = hp[m][0][1]; w.z = hp[m][1][0]; w.w = hp[m][1][1]; *(PG8_GAS u32x4*)(H + (size_t)row * ldh + jcol) = w; } }
        }
    }
};

template <class Epi, class Sched, bool ALIGN_EPI = false, bool SP2 = false>
__device__ __forceinline__ void gemm_phase(PG8_LAS unsigned char* lds, const Gemm g, const Sched& S, const Epi& E, const int tid) {
    const int wid = __builtin_amdgcn_readfirstlane(tid >> 6), lane = tid & 63, wr = wid >> 2, wc = wid & 3, fr = lane & 15, fq = lane >> 4;
    const int K = g.K, nt = K / BK;
    unsigned voffA[2], voffB[2];
#pragma unroll
    for (int i = 0; i < 2; ++i) { int R, C; stage_rc(tid * 16 + i * 8192, R, C); const int Rb = Epi::PERM ? ((R & ~31) + perm32(R & 31)) : R;
        voffA[i] = (unsigned)(R * K + C) * 2u; voffB[i] = (unsigned)(Rb * K + C) * 2u; }
    const size_t kstep = (size_t)(BK * 2);
    const size_t hstep = (size_t)HALF * K * 2;
    const size_t tstep = 2 * hstep;
    const unsigned ldsw = (unsigned)wid * 1024u;
    const int aoff = lds_byte(wr * 64 + fr, fq * 8), boff = lds_byte(wc * 32 + fr, fq * 8);
#define PG8_SA(b, h) (((b) * 2 + (h)) * HTB)
#define PG8_SB(b, h) ((4 + (b) * 2 + (h)) * HTB)
#define PG8_STAGE(bufoff, gbase, voff) do { _Pragma("unroll") for (int _i = 0; _i < 2; ++_i) \
        __builtin_amdgcn_global_load_lds((const PG8_GAS unsigned*)((const PG8_GAS char*)(gbase) + (voff)[_i]), (PG8_LAS unsigned*)(lds + (bufoff) + ldsw + _i * 8192), 16, 0, 0); } while (0)
#define PG8_LDA(dst, b, h) do { _Pragma("unroll") for (int m = 0; m < 4; ++m) _Pragma("unroll") for (int k = 0; k < 2; ++k) dst[m][k] = *(const PG8_LAS bf16x8*)(lds + PG8_SA(b, h) + aoff + m * 2048 + k * 1024); } while (0)
#define PG8_LDB(dst, b, h) do { _Pragma("unroll") for (int n = 0; n < 2; ++n) _Pragma("unroll") for (int k = 0; k < 2; ++k) dst[n][k] = *(const PG8_LAS bf16x8*)(lds + PG8_SB(b, h) + boff + n * 2048 + k * 1024); } while (0)
#define PG8_MMA(ai, bj, At, Bt) do { __builtin_amdgcn_s_setprio(1); _Pragma("unroll") for (int m = 0; m < 4; ++m) _Pragma("unroll") for (int n = 0; n < 2; ++n) _Pragma("unroll") for (int k = 0; k < 2; ++k) \
        acc[ai][bj][m][n] = __builtin_amdgcn_mfma_f32_16x16x32_bf16(Bt[n][k], At[m][k], acc[ai][bj][m][n], 0, 0, 0); __builtin_amdgcn_s_setprio(0); } while (0)
#define PG8_WAIT_V(n) asm volatile("s_waitcnt vmcnt(" #n ")" ::: "memory")
#define PG8_WAIT_L(n) asm volatile("s_waitcnt lgkmcnt(" #n ")" ::: "memory")
#define PG8_BAR __builtin_amdgcn_s_barrier()
#define PG8_SCHED __builtin_amdgcn_sched_barrier(0)
    Unit cur, nxt; int ui = 0;
    if (!S.next(0, cur)) return;
    f32x4 acc[2][2][4][2];
#pragma unroll
    for (int a = 0; a < 2; ++a)
#pragma unroll
        for (int b = 0; b < 2; ++b)
#pragma unroll
            for (int m = 0; m < 4; ++m)
#pragma unroll
                for (int n = 0; n < 2; ++n) acc[a][b][m][n] = (f32x4){0.f, 0.f, 0.f, 0.f};
    bf16x8 At[4][2], B0[2][2], B1[2][2];
    const PG8_GAS char* cA = (const PG8_GAS char*)g.A + (size_t)cur.pm * tstep; const PG8_GAS char* cB = (const PG8_GAS char*)g.Bt + (size_t)cur.pn * tstep;
    S.a_ready(cur);
    if constexpr (SP2) {
        PG8_STAGE(PG8_SB(0, 0), cB, voffB); PG8_STAGE(PG8_SB(0, 1), cB + hstep, voffB); PG8_STAGE(PG8_SA(0, 0), cA, voffA); PG8_STAGE(PG8_SA(0, 1), cA + hstep, voffA);
        if (wr == 1) PG8_BAR;
        PG8_WAIT_V(2); PG8_BAR;
        PG8_STAGE(PG8_SB(1, 0), cB + kstep, voffB); PG8_STAGE(PG8_SA(1, 0), cA + kstep, voffA); PG8_STAGE(PG8_SB(1, 1), cB + hstep + kstep, voffB);
        PG8_WAIT_V(6); PG8_BAR;
    } else {
        PG8_STAGE(PG8_SB(0, 0), cB, voffB); PG8_STAGE(PG8_SA(0, 0), cA, voffA); PG8_STAGE(PG8_SB(0, 1), cB + hstep, voffB); PG8_STAGE(PG8_SA(0, 1), cA + hstep, voffA);
        if (wr == 1) PG8_BAR;
        PG8_WAIT_V(4); PG8_BAR;
        PG8_STAGE(PG8_SB(1, 0), cB + kstep, voffB); PG8_STAGE(PG8_SA(1, 0), cA + kstep, voffA); PG8_STAGE(PG8_SB(1, 1), cB + hstep + kstep, voffB);
        PG8_WAIT_V(6); PG8_BAR;
    }
    for (;;) {
        const bool has_next = S.next(ui + 1, nxt);
        const PG8_GAS char* nA = has_next ? (const PG8_GAS char*)g.A + (size_t)nxt.pm * tstep : cA; const PG8_GAS char* nB = has_next ? (const PG8_GAS char*)g.Bt + (size_t)nxt.pn * tstep : cB;
        for (int t = 0; t < nt; t += 2) {
            const bool last = (t == nt - 2);
            const PG8_GAS char* a1 = cA + (size_t)(t + 1) * kstep;
            const PG8_GAS char* a2 = last ? nA : cA + (size_t)(t + 2) * kstep; const PG8_GAS char* b2 = last ? nB : cB + (size_t)(t + 2) * kstep;
            const PG8_GAS char* a3 = a2 + kstep; const PG8_GAS char* b3 = b2 + kstep;
            if (last && has_next) S.a_ready(nxt);
            if constexpr (SP2) {
            PG8_LDB(B0, 0, 0); PG8_LDB(B1, 0, 1); PG8_SCHED; PG8_LDA(At, 0, 0); PG8_STAGE(PG8_SA(1, 1), a1 + hstep, voffA);
            PG8_WAIT_V(8); PG8_WAIT_L(0); PG8_BAR; PG8_MMA(0, 0, At, B0); PG8_MMA(0, 1, At, B1); PG8_BAR; PG8_SCHED;
            PG8_LDA(At, 0, 1); PG8_STAGE(PG8_SB(0, 0), b2, voffB); PG8_STAGE(PG8_SB(0, 1), b2 + hstep, voffB); PG8_STAGE(PG8_SA(0, 0), a2, voffA);
            PG8_WAIT_V(8); PG8_WAIT_L(0); PG8_BAR; PG8_MMA(1, 0, At, B0); PG8_MMA(1, 1, At, B1); PG8_BAR; PG8_SCHED;
            PG8_LDB(B0, 1, 0); PG8_LDB(B1, 1, 1); PG8_SCHED; PG8_LDA(At, 1, 0); PG8_STAGE(PG8_SA(0, 1), a2 + hstep, voffA);
            PG8_WAIT_V(8); PG8_WAIT_L(0); PG8_BAR; PG8_MMA(0, 0, At, B0); PG8_MMA(0, 1, At, B1); PG8_BAR; PG8_SCHED;
            PG8_LDA(At, 1, 1); PG8_STAGE(PG8_SB(1, 0), b3, voffB); PG8_STAGE(PG8_SB(1, 1), b3 + hstep, voffB); PG8_STAGE(PG8_SA(1, 0), a3, voffA);
            PG8_WAIT_V(8); PG8_WAIT_L(0); PG8_BAR; PG8_MMA(1, 0, At, B0); PG8_MMA(1, 1, At, B1); PG8_BAR; PG8_SCHED;
            } else {
            PG8_LDB(B0, 0, 0); PG8_SCHED; PG8_LDA(At, 0, 0); PG8_STAGE(PG8_SA(1, 1), a1 + hstep, voffA);
            PG8_WAIT_L(8); PG8_BAR; PG8_WAIT_L(0); PG8_MMA(0, 0, At, B0); PG8_BAR; PG8_SCHED;
            PG8_LDB(B1, 0, 1); PG8_STAGE(PG8_SB(0, 0), b2, voffB);
            PG8_BAR; PG8_WAIT_L(0); PG8_MMA(0, 1, At, B1); PG8_BAR;
            PG8_LDA(At, 0, 1); PG8_STAGE(PG8_SA(0, 0), a2, voffA);
            PG8_BAR; PG8_WAIT_L(0); PG8_MMA(1, 0, At, B0); PG8_BAR; PG8_SCHED;
            PG8_STAGE(PG8_SB(0, 1), b2 + hstep, voffB);
            PG8_WAIT_V(6); PG8_BAR; PG8_MMA(1, 1, At, B1); PG8_BAR;
            PG8_LDB(B0, 1, 0); PG8_SCHED; PG8_LDA(At, 1, 0); PG8_STAGE(PG8_SA(0, 1), a2 + hstep, voffA);
            PG8_WAIT_L(8); PG8_BAR; PG8_WAIT_L(0); PG8_MMA(0, 0, At, B0); PG8_BAR; PG8_SCHED;
            PG8_LDB(B1, 1, 1); PG8_STAGE(PG8_SB(1, 0), b3, voffB);
            PG8_BAR; PG8_WAIT_L(0); PG8_MMA(0, 1, At, B1); PG8_BAR;
            PG8_LDA(At, 1, 1); PG8_STAGE(PG8_SA(1, 0), a3, voffA);
            PG8_BAR; PG8_WAIT_L(0); PG8_MMA(1, 0, At, B0); PG8_BAR; PG8_SCHED;
            PG8_STAGE(PG8_SB(1, 1), b3 + hstep, voffB);
            PG8_WAIT_V(6); PG8_BAR; PG8_MMA(1, 1, At, B1); PG8_BAR;
            }
        }
        if constexpr (ALIGN_EPI) { if (wr == 0) PG8_BAR; }
        if constexpr (!Epi::AFTER_DRAIN) { E(acc, cur, wr, wc, fr, fq); S.done(cur); }
        if (!has_next) break;
#pragma unroll
        for (int a = 0; a < 2; ++a)
#pragma unroll
            for (int b = 0; b < 2; ++b)
#pragma unroll
                for (int m = 0; m < 4; ++m)
#pragma unroll
                    for (int n = 0; n < 2; ++n) acc[a][b][m][n] = (f32x4){0.f, 0.f, 0.f, 0.f};
        cur = nxt; cA = nA; cB = nB; ++ui;
        if constexpr (ALIGN_EPI) { if (wr == 1) PG8_BAR; }
    }
    PG8_WAIT_V(0);
    if constexpr (!ALIGN_EPI) { if (wr == 0) PG8_BAR; }
    PG8_BAR;
    if constexpr (Epi::AFTER_DRAIN) { E.fused(acc, cur, wr, wc, fr, fq, lds, wid, lane); S.done(cur); }
#undef PG8_SA
#undef PG8_SB
#undef PG8_STAGE
#undef PG8_LDA
#undef PG8_LDB
#undef PG8_MMA
#undef PG8_WAIT_V
#undef PG8_WAIT_L
#undef PG8_BAR
#undef PG8_SCHED
}
}
#define GAS __attribute__((address_space(1)))
#define LAS __attribute__((address_space(3)))
typedef unsigned short bf16;
typedef unsigned v4u __attribute__((ext_vector_type(4)));
typedef float f32x4 __attribute__((ext_vector_type(4)));
typedef short bf16x8 __attribute__((ext_vector_type(8)));
typedef GAS unsigned gu32;
typedef GAS unsigned long long gu64;
#define RLX_AGENT __ATOMIC_RELAXED, __HIP_MEMORY_SCOPE_AGENT
#define LDS_WAIT() asm volatile("s_waitcnt lgkmcnt(0)" ::: "memory")
#define VM_WAIT() asm volatile("s_waitcnt vmcnt(0)" ::: "memory")
__device__ __forceinline__ unsigned long long rt() { return __builtin_amdgcn_s_memrealtime(); }
__device__ __forceinline__ unsigned f2bf(float f) { unsigned u = __builtin_bit_cast(unsigned, f); return (u + 0x7fffu + ((u >> 16) & 1u)) >> 16; }
__device__ __forceinline__ unsigned pk2(float lo, float hi) { return f2bf(lo) | (f2bf(hi) << 16); }

#define XB_TMO      128
#define XB_XCNT(j)  (256  + 64 * (j))
#define XB_XSUB(j)  (1280 + 64 * (j))
#define XB_XGEN(j)  (2304 + 64 * (j))
#define XB_TOP      3328
#define XB_TOPGEN   3392
#define XCD_BAR_WORDS 3456
#define XB_SPIN_CAP (1u << 18)

__device__ __forceinline__ unsigned xb_ld(unsigned* p)              { return __hip_atomic_load(p, __ATOMIC_RELAXED, __HIP_MEMORY_SCOPE_AGENT); }
__device__ __forceinline__ unsigned xb_add(unsigned* p, unsigned v) { return __hip_atomic_fetch_add(p, v, __ATOMIC_RELAXED, __HIP_MEMORY_SCOPE_AGENT); }
__device__ __forceinline__ unsigned xb_xcc_id() { return (unsigned)__builtin_amdgcn_s_getreg((3 << 11) | 20) & 0xFu; }
#define XB_SPIN(cond, bar) do { unsigned _sp = 0; while (cond) { __builtin_amdgcn_s_sleep(1); \
    if ((++_sp & 255u) == 0u) { if (xb_ld(&(bar)[XB_TMO])) break; if (_sp > XB_SPIN_CAP) { atomicAdd(&(bar)[XB_TMO], 1u); break; } } } } while (0)

struct XcdBarrier {
    unsigned* bar; unsigned x;
    volatile LAS unsigned* st;
};

__device__ __forceinline__ XcdBarrier xcd_barrier_post(unsigned* bar, volatile LAS unsigned* st, const int tid) {
    XcdBarrier b; b.bar = bar; b.x = xb_xcc_id(); b.st = st;
    if (tid == 0) (void)xb_add(&bar[XB_XCNT(b.x)], 1u);
    return b;
}
__device__ __forceinline__ void xcd_barrier_complete(unsigned* bar, unsigned x, unsigned& nloc, unsigned& nx) {
    const unsigned G = gridDim.x * gridDim.y * gridDim.z;
    unsigned sum, cnt, mine, sp = 0u;
    for (;;) {
        sum = 0u; cnt = 0u; mine = 0u;
#pragma unroll
        for (unsigned j = 0; j < 16; ++j) { const unsigned c = xb_ld(&bar[XB_XCNT(j)]); sum += c; cnt += (c > 0u) ? 1u : 0u; mine = (j == x) ? c : mine; }
        if (sum == G) break;
        __builtin_amdgcn_s_sleep(1);
        if ((++sp & 255u) == 0u) { if (xb_ld(&bar[XB_TMO])) break; if (sp > XB_SPIN_CAP) { atomicAdd(&bar[XB_TMO], 1u); break; } }
    }
    nloc = mine > 0u ? mine : 1u; nx = cnt > 0u ? cnt : 1u;
}

__device__ __forceinline__ void xcd_barrier(const XcdBarrier& b, const int tid) {
    asm volatile("s_waitcnt vmcnt(0)" ::: "memory");
    __syncthreads();
    if (tid == 0) {
        unsigned* bar = b.bar;
        __builtin_amdgcn_s_waitcnt(0);
        unsigned nloc = b.st[0], nx = b.st[1];
        if (nloc == 0u) { xcd_barrier_complete(bar, b.x, nloc, nx); b.st[0] = nloc; b.st[1] = nx; }
        const unsigned old = xb_add(&bar[XB_XSUB(b.x)], 1u);
        const unsigned gen = old / nloc;
        if (old + 1u == (gen + 1u) * nloc) {
            __builtin_amdgcn_fence(__ATOMIC_RELEASE, "agent");
            asm volatile("s_waitcnt vmcnt(0)" ::: "memory");
            const unsigned og = xb_add(&bar[XB_TOP], 1u);
            const unsigned tg = og / nx;
            if (og + 1u == (tg + 1u) * nx) xb_add(&bar[XB_TOPGEN], 1u);
            else XB_SPIN(xb_ld(&bar[XB_TOPGEN]) == tg, bar);
            __builtin_amdgcn_fence(__ATOMIC_ACQUIRE, "agent");
            xb_add(&bar[XB_XGEN(b.x)], 1u);
            asm volatile("s_waitcnt vmcnt(0)" ::: "memory");
        } else {
            XB_SPIN(xb_ld(&bar[XB_XGEN(b.x)]) == gen, bar);
            __builtin_amdgcn_fence(__ATOMIC_ACQUIRE, "agent");
            asm volatile("s_waitcnt vmcnt(0)" ::: "memory");
        }
    }
    __syncthreads();
}
constexpr int BATCH = 2, SEQ = 4096, DM = 2048, DEPTH = 4, MTOK = BATCH * SEQ;
constexpr int HD = 64, RH = 12, AH = 12, GGRP = 8, RWID = 768, AWID = 768, GWID = 512;
constexpr int RCOLS = 2560, ACOLS = 2304, GCOLS = 1024, INCOLS = 5888, DFF = 5632, UPN = 2 * DFF;
constexpr int QOFF = RCOLS, KOFF = RCOLS + AWID, VOFF = RCOLS + 2 * AWID, GOFF = RCOLS + ACOLS;
constexpr int TCH = 64, NCH = SEQ / TCH;
constexpr int NTASK_SCAN = BATCH * RH * NCH;
constexpr float NORM_EPS = 1e-6f, GN_EPS = 1e-5f, RWKV_LN_EPS = 64e-5f;
constexpr float DECAY_SCALE = 0.6065306597126334f;
constexpr int NWAVES = 8, NTHR = NWAVES * 64;

constexpr size_t MiB = 1u << 20;
constexpr size_t WS_CTL = 0, CTL_ZERO_BYTES = 1 * MiB;
constexpr size_t WS_WIN = 2 * MiB, WS_WOUT = 94 * MiB, WS_WUP = 126 * MiB, WS_WDN = 302 * MiB;
constexpr size_t WS_HN = 390 * MiB, WS_Y = 422 * MiB, WS_O = 454 * MiB;
constexpr size_t WS_REG = 518 * MiB;
constexpr size_t WS_PROJ = WS_REG;
constexpr size_t WS_RW = WS_REG + 92 * MiB;
constexpr size_t WS_CHK = WS_RW + 216 * MiB;
constexpr size_t WS_QKR = WS_CHK + 72 * MiB;
constexpr size_t WS_AO = WS_QKR + 24 * MiB;
constexpr size_t WS_LSE = WS_AO + 72 * MiB;
constexpr size_t WS_SGU = WS_LSE + 2 * MiB;
constexpr size_t WS_BON = WS_SGU + 32 * MiB;
constexpr size_t WS_LORA = WS_BON + 1 * MiB;
constexpr size_t WS_SGW = WS_LORA + 2 * MiB;
constexpr size_t WS_SSQ = WS_SGW + 1 * MiB;
constexpr size_t WS_HALO = WS_SSQ + 1 * MiB;
constexpr size_t WS_RAW01 = WS_HALO + 3 * MiB;
constexpr size_t WS_END_MIX = WS_RAW01 + 3 * MiB;
constexpr size_t WS_UP = WS_REG;
constexpr size_t WS_H = WS_REG + 176 * MiB;
constexpr size_t WS_END = WS_END_MIX;
static_assert(WS_H + 88 * MiB <= WS_END, "map");
constexpr int LORA_L = RWID * 256;
constexpr int CW_BAR = 4096, CW_ATT = 8192;

constexpr int RING_BYTES = 131072, LDSCTL_OFF = RING_BYTES, MISC_OFF = LDSCTL_OFF + 320, LDS_BYTES = 147456;

struct Params { const float* in[29]; float* out; unsigned char* ws; };

typedef const GAS float* gcf; typedef GAS float* gfp; typedef const GAS bf16* gcb; typedef GAS bf16* gbp; typedef const GAS int* gci;
__device__ __forceinline__ float bf2f(unsigned short u) { return __builtin_bit_cast(float, (unsigned)u << 16); }
__device__ __forceinline__ float bflo(unsigned u) { return __builtin_bit_cast(float, u << 16); }
__device__ __forceinline__ float bfhi(unsigned u) { return __builtin_bit_cast(float, u & 0xffff0000u); }
__device__ __forceinline__ float wave_sum(float v) {
#pragma unroll
    for (int o = 1; o < 64; o <<= 1) v += __shfl_xor(v, o);
    return v;
}
__device__ __forceinline__ float wave_max(float v) {
#pragma unroll
    for (int o = 1; o < 64; o <<= 1) v = fmaxf(v, __shfl_xor(v, o));
    return v;
}
__device__ __forceinline__ float sigmoidf_(float x) { return 1.f / (1.f + __expf(-x)); }
__device__ __forceinline__ float gelu_tanh(float x) { const float u = 0.7978845608028654f * (x + 0.044715f * x * x * x); return 0.5f * x * (1.f + tanhf(u)); }

typedef float f32x16 __attribute__((ext_vector_type(16)));
typedef float f32x2_t __attribute__((ext_vector_type(2))); typedef __bf16 bf16x2_t __attribute__((ext_vector_type(2)));
typedef short s16x4 __attribute__((ext_vector_type(4)));
__device__ __forceinline__ unsigned cvtpk(float lo, float hi) { f32x2_t v = {lo, hi}; bf16x2_t b = __builtin_convertvector(v, bf16x2_t); return __builtin_bit_cast(unsigned, b); }
__device__ __forceinline__ bf16x8 pack8(float a0, float a1, float a2, float a3, float a4, float a5, float a6, float a7) { v4u p; p.x = cvtpk(a0, a1); p.y = cvtpk(a2, a3); p.z = cvtpk(a4, a5); p.w = cvtpk(a6, a7); return __builtin_bit_cast(bf16x8, p); }
#define MFMA16(a, b, c) __builtin_amdgcn_mfma_f32_16x16x32_bf16((a), (b), (c), 0, 0, 0)
#define MFMA32(a, b, c) __builtin_amdgcn_mfma_f32_32x32x16_bf16((a), (b), (c), 0, 0, 0)
__device__ __forceinline__ int crow(int reg, int h) { return (reg & 3) + 8 * (reg >> 2) + 4 * h; }

__device__ __forceinline__ void p0_transpose_item(gcf W, int K, int N, gbp WT, int row_off, LAS float* scr, int item, int lane) {
    const int nblk = N / 32, kb = item / nblk, nb = item % nblk, k0 = 64 * kb, n0 = 32 * nb;
    const int rb = row_off >= 0 ? row_off + n0 : (n0 < DFF ? (n0 / 128) * 256 + (n0 % 128) : ((n0 - DFF) / 128) * 256 + 128 + ((n0 - DFF) % 128));
#pragma unroll 8
    for (int i = 0; i < 32; ++i) { const int kk = 2 * i + (lane >> 5); scr[kk * 33 + (lane & 31)] = W[(size_t)(k0 + kk) * N + n0 + (lane & 31)]; }
    LDS_WAIT(); asm volatile("" ::: "memory");
    const int c = lane & 7;
#pragma unroll
    for (int j = 0; j < 4; ++j) { const int n = (lane >> 3) + 8 * j; const LAS float* s = scr + (8 * c) * 33 + n;
        v4u o; o.x = pk2(s[0 * 33], s[1 * 33]); o.y = pk2(s[2 * 33], s[3 * 33]); o.z = pk2(s[4 * 33], s[5 * 33]); o.w = pk2(s[6 * 33], s[7 * 33]);
        *(GAS v4u*)(WT + (size_t)(rb + n) * K + k0 + 8 * c) = o; }
    LDS_WAIT(); asm volatile("" ::: "memory");
}

__device__ __forceinline__ void rowpass(gcf xin, gcf delta, gcf gpost, gfp xout, gcf gnext, gbp hn, int gw, int ngw, int lane) {
    for (int m = gw; m < MTOK; m += ngw) {
        const GAS f32x4* xr = (const GAS f32x4*)(xin + (size_t)m * DM) + lane;
        f32x4 xv[8];
#pragma unroll
        for (int j = 0; j < 8; ++j) xv[j] = xr[64 * j];
        if (delta) {
            const GAS f32x4* dr = (const GAS f32x4*)(delta + (size_t)m * DM) + lane;
            f32x4 dv[8]; float ss = 0.f;
#pragma unroll
            for (int j = 0; j < 8; ++j) { dv[j] = dr[64 * j]; ss += dv[j].x * dv[j].x + dv[j].y * dv[j].y + dv[j].z * dv[j].z + dv[j].w * dv[j].w; }
            const float rstd = rsqrtf(wave_sum(ss) * (1.f / DM) + NORM_EPS);
            GAS f32x4* xo = (GAS f32x4*)(xout + (size_t)m * DM) + lane;
#pragma unroll
            for (int j = 0; j < 8; ++j) { const f32x4 g = ((const GAS f32x4*)gpost)[lane + 64 * j]; xv[j] = xv[j] + dv[j] * rstd * g; xo[64 * j] = xv[j]; }
        }
        if (gnext) {
            float ss = 0.f;
#pragma unroll
            for (int j = 0; j < 8; ++j) ss += xv[j].x * xv[j].x + xv[j].y * xv[j].y + xv[j].z * xv[j].z + xv[j].w * xv[j].w;
            const float rstd = rsqrtf(wave_sum(ss) * (1.f / DM) + NORM_EPS);
            GAS unsigned long long* o8 = (GAS unsigned long long*)(hn + (size_t)m * DM) + lane;
#pragma unroll
            for (int j = 0; j < 8; ++j) { const f32x4 g = ((const GAS f32x4*)gnext)[lane + 64 * j]; const f32x4 v = xv[j] * rstd * g;
                o8[64 * j] = (unsigned long long)pk2(v.x, v.y) | ((unsigned long long)pk2(v.z, v.w) << 32); }
        }
    }
}

struct PrepW { gcf sgu_g, sgu_b; gci pos; };
__device__ __forceinline__ void prep_token(int tok, gcb PROJ, const PrepW& w, gbp QKR, gbp SU, gbp SVN, int lane) {
    gcb prow = PROJ + (size_t)tok * INCOLS;
    {
        float cs = 1.f, sn = 0.f;
        if (lane < 16) { const int f = lane & 7; const float inv = exp2f(-(float)f * (18.931568569324174f / 8.f)); const float ang = (float)w.pos[tok] * inv; cs = cosf(ang); sn = sinf(ang); }
#pragma unroll 4
        for (int i = 0; i < 24; ++i) { const int c = lane + 64 * i; float x = bf2f(prow[QOFF + c]);
            if (lane < 16) { const float oth = bf2f(prow[QOFF + c + (lane < 8 ? 8 : -8)]); x = lane < 8 ? x * cs - oth * sn : x * cs + oth * sn; }
            if (i < 12) x *= 0.18033688011112042f;
            QKR[(size_t)tok * 1536 + c] = (bf16)f2bf(x); }
    }
#pragma unroll 4
    for (int i = 0; i < 16; ++i) { const int c = lane + 64 * i; const float z = gelu_tanh(bf2f(prow[GOFF + c]));
        if (i < 8) SU[(size_t)tok * GWID + c] = (bf16)f2bf(z);
        else { const int g = i - 8; const float mu = wave_sum(z) * (1.f / 64.f); const float d = z - mu; const float var = wave_sum(d * d) * (1.f / 64.f);
            SVN[(size_t)tok * GWID + g * 64 + lane] = (bf16)f2bf(d * rsqrtf(var + GN_EPS) * w.sgu_g[g * 64 + lane] + w.sgu_b[g * 64 + lane]); } }
}

constexpr int LIN_ROW = 264;
struct RPW { gcf mu, w0, a0, kk_, ka_, rk; gcb w2t, a2t, g2t; };
__device__ __forceinline__ f32x4 ld4bf(gcb p) { const unsigned long long u = *(const GAS unsigned long long*)p; const unsigned lo = (unsigned)u, hi = (unsigned)(u >> 32); return (f32x4){bflo(lo), bfhi(lo), bflo(hi), bfhi(hi)}; }
__device__ __forceinline__ void rwkv_prep_unit(int unit, gcb PROJ, const RPW& w, gfp RWb, gfp BON, LAS unsigned char* lds, int tid, int wave, int lane) {
    constexpr size_t AS = (size_t)MTOK * RWID;
    gfp R = RWb; gfp Wd = RWb + AS; gfp K2 = RWb + 2 * AS; gfp V = RWb + 3 * AS; gfp KK = RWb + 4 * AS; gfp KKA = RWb + 5 * AS; gfp Gt = RWb + 6 * AS;
    const int tok0 = unit * 32;
    LAS bf16* lin = (LAS bf16*)lds;
    {
        const int tk = tid >> 4, c0 = (tid & 15) * 16, tokA = tok0 + tk, tA = tokA % SEQ;
        gcb pr = PROJ + (size_t)tokA * INCOLS + 2304 + c0;
        unsigned ob[8];
#pragma unroll
        for (int q4 = 0; q4 < 4; ++q4) { const f32x4 cu = ld4bf(pr + 4 * q4); f32x4 pv = {0.f, 0.f, 0.f, 0.f}; if (tA > 0) pv = ld4bf(pr + 4 * q4 - INCOLS);
            const f32x4 mu = *(const GAS f32x4*)(w.mu + 2304 + c0 + 4 * q4); f32x4 x = cu + (pv - cu) * mu;
#pragma unroll
            for (int e = 0; e < 4; ++e) { const int c = c0 + 4 * q4 + e; x[e] = c < 64 ? tanhf(x[e]) : (c < 128 ? x[e] : sigmoidf_(x[e])); }
            ob[2 * q4] = pk2(x[0], x[1]); ob[2 * q4 + 1] = pk2(x[2], x[3]); }
        LAS v4u* dst = (LAS v4u*)(lin + tk * LIN_ROW + c0);
        dst[0] = (v4u){ob[0], ob[1], ob[2], ob[3]}; dst[1] = (v4u){ob[4], ob[5], ob[6], ob[7]};
    }
    __syncthreads();
    const int tt = wave & 1, hq = wave >> 1, tl = lane & 15, g = lane >> 4;
    const int tok = tok0 + 16 * tt + tl, t = tok % SEQ;
    bf16x8 bfr[8];
#pragma unroll
    for (int ks = 0; ks < 8; ++ks) bfr[ks] = *(const LAS bf16x8*)(lin + (16 * tt + tl) * LIN_ROW + 32 * ks + 8 * g);
    gcb prow = PROJ + (size_t)tok * INCOLS;
    for (int hi = 0; hi < 3; ++hi) { const int h = hq + 4 * hi;
        f32x4 kr[4], aa[4]; float ss = 0.f, bon = 0.f;
#pragma unroll
        for (int nt = 0; nt < 4; ++nt) { const int n0 = h * 64 + 16 * nt;
            f32x4 cw = {0.f, 0.f, 0.f, 0.f}, ca = cw, cg = cw;
#pragma unroll
            for (int ks = 0; ks < 2; ++ks) { cw = MFMA16(*(const GAS bf16x8*)(w.w2t + (n0 + tl) * 64 + 32 * ks + 8 * g), bfr[ks], cw);
                                             ca = MFMA16(*(const GAS bf16x8*)(w.a2t + (n0 + tl) * 64 + 32 * ks + 8 * g), bfr[2 + ks], ca); }
#pragma unroll
            for (int ks = 0; ks < 4; ++ks) cg = MFMA16(*(const GAS bf16x8*)(w.g2t + (n0 + tl) * 128 + 32 * ks + 8 * g), bfr[4 + ks], cg);
            const int c = n0 + 4 * g;
            const f32x4 pr_ = ld4bf(prow + c), pk_ = ld4bf(prow + 768 + c), pv_ = ld4bf(prow + 1536 + c);
            f32x4 qr_ = {0.f, 0.f, 0.f, 0.f}, qk_ = qr_, qv_ = qr_;
            if (t > 0) { qr_ = ld4bf(prow - INCOLS + c); qk_ = ld4bf(prow - INCOLS + 768 + c); qv_ = ld4bf(prow - INCOLS + 1536 + c); }
            const f32x4 r4 = pr_ + (qr_ - pr_) * *(const GAS f32x4*)(w.mu + c), k4 = pk_ + (qk_ - pk_) * *(const GAS f32x4*)(w.mu + 768 + c), v4 = pv_ + (qv_ - pv_) * *(const GAS f32x4*)(w.mu + 1536 + c);
            const f32x4 w04 = *(const GAS f32x4*)(w.w0 + c), a04 = *(const GAS f32x4*)(w.a0 + c), kk4 = *(const GAS f32x4*)(w.kk_ + c), ka4 = *(const GAS f32x4*)(w.ka_ + c), rk4 = *(const GAS f32x4*)(w.rk + c);
            f32x4 dec, a_;
#pragma unroll
            for (int e = 0; e < 4; ++e) { dec[e] = __expf(-DECAY_SCALE * sigmoidf_(w04[e] + cw[e])); a_[e] = sigmoidf_(a04[e] + ca[e]); }
            const f32x4 kkr = k4 * kk4, k2 = k4 * (1.f + (a_ - 1.f) * ka4);
            ss += kkr[0] * kkr[0] + kkr[1] * kkr[1] + kkr[2] * kkr[2] + kkr[3] * kkr[3];
            const f32x4 bb = r4 * k2 * rk4; bon += bb[0] + bb[1] + bb[2] + bb[3];
            { const size_t o = (size_t)tok * RWID + c; *(GAS f32x4*)(R + o) = r4; *(GAS f32x4*)(Wd + o) = dec; *(GAS f32x4*)(K2 + o) = k2; *(GAS f32x4*)(V + o) = v4; *(GAS f32x4*)(Gt + o) = cg; }
            kr[nt] = kkr; aa[nt] = a_; }
        ss += __shfl_xor(ss, 16); ss += __shfl_xor(ss, 32); bon += __shfl_xor(bon, 16); bon += __shfl_xor(bon, 32);
        const float rn = 1.f / fmaxf(sqrtf(ss), 1e-12f);
#pragma unroll
        for (int nt = 0; nt < 4; ++nt) { const size_t o = (size_t)tok * RWID + h * 64 + 16 * nt + 4 * g; const f32x4 kk = kr[nt] * rn;
            *(GAS f32x4*)(KK + o) = kk; *(GAS f32x4*)(KKA + o) = kk * aa[nt]; }
        if (g == 0) BON[tok * 12 + h] = bon; }
    __syncthreads();
}

typedef float f32x2 __attribute__((ext_vector_type(2)));
#define SCHED_FENCE() __builtin_amdgcn_sched_barrier(0)
__device__ __forceinline__ void scan_step(f32x2 (&st)[64], const LAS f32x4* o4, float vcur, float& yo, float& zo) {
    f32x2 sk = {0.f, 0.f};
    f32x4 qa[2][2];
    qa[0][0] = o4[16]; qa[0][1] = o4[17];
#pragma unroll
    for (int g = 0; g < 8; ++g) {
        if (g < 7) { qa[(g + 1) & 1][0] = o4[16 + 2 * (g + 1)]; qa[(g + 1) & 1][1] = o4[17 + 2 * (g + 1)]; }
        SCHED_FENCE();
#pragma unroll
        for (int e = 0; e < 2; ++e) { const f32x4 q = qa[g & 1][e]; const int k = 8 * g + 4 * e;
            sk += st[k] * q.x; sk += st[k + 1] * q.y; sk += st[k + 2] * q.z; sk += st[k + 3] * q.w; }
        SCHED_FENCE();
    }
    const f32x2 vk = {vcur, 0.f};
    f32x2 y = {0.f, 0.f};
    f32x4 ob[2][4];
    ob[0][0] = o4[0]; ob[0][1] = o4[32]; ob[0][2] = o4[48]; ob[0][3] = o4[64];
#pragma unroll
    for (int k4 = 0; k4 < 16; ++k4) {
        if (k4 < 15) { ob[(k4 + 1) & 1][0] = o4[k4 + 1]; ob[(k4 + 1) & 1][1] = o4[33 + k4]; ob[(k4 + 1) & 1][2] = o4[49 + k4]; ob[(k4 + 1) & 1][3] = o4[65 + k4]; }
        SCHED_FENCE();
        { const f32x4 w4 = ob[k4 & 1][0], a4 = ob[k4 & 1][1], kv = ob[k4 & 1][2], r4 = ob[k4 & 1][3];
#pragma unroll
          for (int j = 0; j < 4; ++j) { const int k = 4 * k4 + j; st[k] = st[k] * w4[j] - sk * a4[j] + vk * kv[j]; y += st[k] * r4[j]; } }
        SCHED_FENCE();
    }
    yo = y.x; zo = y.y;
}
__device__ __forceinline__ void scan_chunk(int task, gcf RWb, gfp YL, gfp Z, gbp PT, gbp SLT, LAS float* ops, int lane) {
    constexpr unsigned AS = (unsigned)MTOK * RWID;
    gcf R = RWb; gcf Wd = RWb + AS; gcf K2 = RWb + 2 * AS; gcf V = RWb + 3 * AS; gcf KK = RWb + 4 * AS; gcf KKA = RWb + 5 * AS;
    const int bh = task / NCH, c = task % NCH, b = bh / RH, h = bh % RH;
    const unsigned base = (unsigned)((b * SEQ + c * TCH) * RWID + h * 64 + lane);
    f32x2 st[64];
    int lane_o = lane; asm volatile("" : "+v"(lane_o));
#pragma unroll
    for (int k = 0; k < 64; ++k) st[k] = (f32x2){0.f, (k == lane_o) ? 1.f : 0.f};
    LAS float* b0 = ops; LAS float* b1 = ops + 320;
    float ew = Wd[base], ekk = KK[base], eka = KKA[base], ek = K2[base], er = R[base], ev = V[base];
    float ow = Wd[base + RWID], okk = KK[base + RWID], oka = KKA[base + RWID], ok = K2[base + RWID], orr = R[base + RWID], ov = V[base + RWID];
    b0[lane] = ew; b0[64 + lane] = ekk; b0[128 + lane] = eka; b0[192 + lane] = ek; b0[256 + lane] = er;
    for (int i = 0; i < TCH; i += 2) {
        const float v0 = ev; float y, z;
        if (i + 2 < TCH) { const unsigned o = base + (unsigned)(i + 2) * RWID; ew = Wd[o]; ekk = KK[o]; eka = KKA[o]; ek = K2[o]; er = R[o]; ev = V[o]; }
        scan_step(st, (const LAS f32x4*)b0, v0, y, z);
        { const unsigned o = base + (unsigned)i * RWID; YL[o] = y; Z[o] = z; }
        b1[lane] = ow; b1[64 + lane] = okk; b1[128 + lane] = oka; b1[192 + lane] = ok; b1[256 + lane] = orr;
        const float v1 = ov;
        if (i + 3 < TCH) { const unsigned o = base + (unsigned)(i + 3) * RWID; ow = Wd[o]; okk = KK[o]; oka = KKA[o]; ok = K2[o]; orr = R[o]; ov = V[o]; }
        scan_step(st, (const LAS f32x4*)b1, v1, y, z);
        { const unsigned o = base + (unsigned)(i + 1) * RWID; YL[o] = y; Z[o] = z; }
        b0[lane] = ew; b0[64 + lane] = ekk; b0[128 + lane] = eka; b0[192 + lane] = ek; b0[256 + lane] = er;
    }
    gbp pm = PT + (unsigned)(task * 4096 + lane); gbp sl = SLT + (unsigned)(task * 4096 + lane);
#pragma unroll
    for (int k = 0; k < 64; ++k) { pm[k * 64] = (bf16)f2bf(st[k].y); sl[k * 64] = (bf16)f2bf(st[k].x); }
}

constexpr int S2_SLOT = 16384, S2_NSLOT = 7, S2_DEPTH = S2_NSLOT - 1, S2_NL = NCH - 1;
__device__ __forceinline__ void s2_issue(int task, gcb PT, gcb SL16, LAS unsigned char* slot, int lw, int lane) {
#pragma unroll
    for (int jj = 0; jj < 4; ++jj) { const int j = 4 * lw + jj;
        gcb src = (lw < 2) ? PT + (unsigned)(task * 4096 + (8 * j + (lane >> 3)) * 64 + (((lane & 7) ^ ((lane >> 3) & 7)) << 3))
                           : SL16 + (unsigned)(task * 4096 + (j - 8) * 512 + lane * 8);
        __builtin_amdgcn_global_load_lds((const GAS unsigned*)src, (LAS unsigned*)(slot + j * 1024), 16, 0, 0); }
}
__device__ __forceinline__ void scan_carry_ring(int bh, gcb PT, gcb SL16, gfp SST, LAS unsigned char* lds, int wave, int lane) {
    if (wave >= 4) {
        const int lw = wave - 4;
        for (int cc = 0; cc < S2_DEPTH; ++cc) s2_issue(bh * NCH + cc, PT, SL16, lds + (cc % S2_NSLOT) * S2_SLOT, lw, lane);
        for (int c = 0; c < S2_NL; ++c) {
            if (c + S2_DEPTH <= S2_NL) asm volatile("s_waitcnt vmcnt(20)" ::: "memory"); else asm volatile("s_waitcnt vmcnt(0)" ::: "memory");
            __builtin_amdgcn_s_barrier();
            if (c + S2_DEPTH < S2_NL) s2_issue(bh * NCH + c + S2_DEPTH, PT, SL16, lds + ((c + S2_DEPTH) % S2_NSLOT) * S2_SLOT, lw, lane);
        }
    } else if (wave < 2) {
        const int r = lane & 31, h = lane >> 5, vt = wave;
        f32x16 acc[2];
#pragma unroll
        for (int i = 0; i < 16; ++i) { acc[0][i] = 0.f; acc[1][i] = 0.f; }
        for (int c = 0; c < NCH; ++c) {
            const unsigned tb = (unsigned)(bh * NCH + c) * 4096u;
#pragma unroll
            for (int mt = 0; mt < 2; ++mt)
#pragma unroll
                for (int g = 0; g < 4; ++g) { const f32x4 v = {acc[mt][4 * g], acc[mt][4 * g + 1], acc[mt][4 * g + 2], acc[mt][4 * g + 3]};
                    *(GAS f32x4*)(SST + tb + (unsigned)((32 * vt + r) * 64 + 32 * mt + 8 * g + 4 * h)) = v; }
            if (c == NCH - 1) break;
            __builtin_amdgcn_s_barrier();
            const LAS unsigned char* sb = lds + (c % S2_NSLOT) * S2_SLOT;
            bf16x8 bfr[2][2];
#pragma unroll
            for (int kt = 0; kt < 2; ++kt)
#pragma unroll
                for (int sx = 0; sx < 2; ++sx) bfr[kt][sx] = pack8(acc[kt][8 * sx], acc[kt][8 * sx + 1], acc[kt][8 * sx + 2], acc[kt][8 * sx + 3], acc[kt][8 * sx + 4], acc[kt][8 * sx + 5], acc[kt][8 * sx + 6], acc[kt][8 * sx + 7]);
#pragma unroll
            for (int mt = 0; mt < 2; ++mt) {
#pragma unroll
                for (int i = 0; i < 16; ++i) acc[mt][i] = bf2f(*(const LAS unsigned short*)(sb + 8192 + (32 * mt + crow(i, h)) * 128 + (32 * vt + r) * 2));
                const int row = 32 * mt + r; const LAS unsigned char* rp = sb + row * 128 + 8 * h;
#pragma unroll
                for (int kt = 0; kt < 2; ++kt)
#pragma unroll
                    for (int sx = 0; sx < 2; ++sx) { const int q = 4 * kt + 2 * sx;
                        const s16x4 lo = *(const LAS s16x4*)(rp + ((q ^ (row & 7)) << 4)), hi = *(const LAS s16x4*)(rp + (((q + 1) ^ (row & 7)) << 4));
                        acc[mt] = MFMA32(__builtin_shufflevector(lo, hi, 0, 1, 2, 3, 4, 5, 6, 7), bfr[kt][sx], acc[mt]); } }
            asm volatile("s_waitcnt lgkmcnt(0)" ::: "memory");
        }
    } else { for (int c = 0; c < S2_NL; ++c) __builtin_amdgcn_s_barrier(); }
}

__device__ __forceinline__ void scan_out(int task, gcf RWb, gcf YL, gcf Z, gcf SST, gcf BON, gcf ln_g, gcf ln_b, gbp Y, LAS float* zb, int lane) {
    constexpr size_t AS = (size_t)MTOK * RWID;
    gcf V = RWb + 3 * AS; gcf Gt = RWb + 6 * AS;
    const int bh = task / NCH, c = task % NCH, b = bh / RH, h = bh % RH;
    const int tok0 = b * SEQ + c * TCH; const int n = h * 64 + lane;
    float S[64];
#pragma unroll
    for (int k4 = 0; k4 < 16; ++k4) { const f32x4 q = *(const GAS f32x4*)(SST + (unsigned)(task * 4096 + lane * 64 + 4 * k4)); S[4 * k4] = q.x; S[4 * k4 + 1] = q.y; S[4 * k4 + 2] = q.z; S[4 * k4 + 3] = q.w; }
    const float lg = ln_g[n], lb = ln_b[n];
    for (int i = 0; i < TCH; ++i) { const int tok = tok0 + i; const size_t o = (size_t)tok * RWID + n;
        zb[(i & 1) * 64 + lane] = Z[o];
        float y = YL[o];
#pragma unroll
        for (int k4 = 0; k4 < 16; ++k4) { const f32x4 q = ((const LAS f32x4*)(zb + (i & 1) * 64))[k4];
            y += S[4 * k4] * q.x + S[4 * k4 + 1] * q.y + S[4 * k4 + 2] * q.z + S[4 * k4 + 3] * q.w; }
        const float mu = wave_sum(y) * (1.f / 64.f); const float d = y - mu; const float var = wave_sum(d * d) * (1.f / 64.f);
        float yn = d * rsqrtf(var + RWKV_LN_EPS) * lg + lb;
        yn += BON[tok * 12 + h] * V[o];
        Y[(size_t)tok * DM + n] = (bf16)f2bf(yn * Gt[o]); }
}

constexpr int ATT_UNITS_PER_BH = 48, ATT_UNITS = BATCH * AH * ATT_UNITS_PER_BH, ATT_KROW = 144, ATT_VROW = 776, ATT_VOFF = 384 * ATT_KROW;
__device__ __forceinline__ void attn_unit(int unit, gcb QKR, gcb PROJ, gfp AOP, gfp LSE, LAS unsigned char* lds, int tid, int wave, int lane) {
    const int bh = unit / ATT_UNITS_PER_BH, uu = unit % ATT_UNITS_PER_BH, b = bh / AH, h = bh % AH;
    int p, d, rho, qb;
    if (uu < 16) { p = 0; d = 1; rho = 0; qb = uu; } else if (uu < 32) { p = 1; d = 4; rho = (uu - 16) >> 2; qb = (uu - 16) & 3; } else { p = 2; d = 16; rho = uu - 32; qb = 0; }
    const int i0 = qb * 256;
    LAS unsigned char* Kl = lds; LAS unsigned char* Vl = lds + ATT_VOFF;
#pragma unroll
    for (int it = 0; it < 6; ++it) { const int idx = tid + 512 * it, key = idx % 384, piece = idx / 384; const int ki = i0 - 128 + key;
        v4u kv = {0u, 0u, 0u, 0u}, vv = {0u, 0u, 0u, 0u};
        if (ki >= 0) { const unsigned tokk = (unsigned)(b * SEQ + rho + d * ki);
            kv = *(const GAS v4u*)(QKR + tokk * 1536u + 768u + (unsigned)(h * 64 + piece * 8));
            vv = *(const GAS v4u*)(PROJ + (size_t)tokk * INCOLS + VOFF + h * 64 + piece * 8); }
        *(LAS v4u*)(Kl + key * ATT_KROW + piece * 16) = kv;
        LAS unsigned short* vd = (LAS unsigned short*)(Vl + (piece * 8) * ATT_VROW + key * 2);
        vd[0 * (ATT_VROW / 2)] = (unsigned short)(vv.x & 0xffffu); vd[1 * (ATT_VROW / 2)] = (unsigned short)(vv.x >> 16);
        vd[2 * (ATT_VROW / 2)] = (unsigned short)(vv.y & 0xffffu); vd[3 * (ATT_VROW / 2)] = (unsigned short)(vv.y >> 16);
        vd[4 * (ATT_VROW / 2)] = (unsigned short)(vv.z & 0xffffu); vd[5 * (ATT_VROW / 2)] = (unsigned short)(vv.z >> 16);
        vd[6 * (ATT_VROW / 2)] = (unsigned short)(vv.w & 0xffffu); vd[7 * (ATT_VROW / 2)] = (unsigned short)(vv.w >> 16); }
    __syncthreads();
    const int r = lane & 31, hh = lane >> 5;
    const int iq0 = i0 + 32 * wave;
    const unsigned tokq = (unsigned)(b * SEQ + rho + d * (iq0 + r));
    bf16x8 qf[4];
#pragma unroll
    for (int sx = 0; sx < 4; ++sx) qf[sx] = *(const GAS bf16x8*)(QKR + tokq * 1536u + (unsigned)(h * 64 + 16 * sx + 8 * hh));
    float m = -1e30f, l = 0.f;
    f32x16 o[2];
#pragma unroll
    for (int i = 0; i < 16; ++i) { o[0][i] = 0.f; o[1][i] = 0.f; }
#pragma unroll
    for (int j = 0; j < 5; ++j) {
        const int kk0 = 32 * wave + 32 * j, kabs0 = iq0 - 128 + 32 * j;
        if (kabs0 + 31 < 0) continue;
        f32x16 st;
#pragma unroll
        for (int i = 0; i < 16; ++i) st[i] = 0.f;
#pragma unroll
        for (int sx = 0; sx < 4; ++sx) { const bf16x8 a = *(const LAS bf16x8*)(Kl + (kk0 + r) * ATT_KROW + (16 * sx + 8 * hh) * 2); st = MFMA32(a, qf[sx], st); }
        bool ok[16]; float tmax = -1e30f;
#pragma unroll
        for (int i = 0; i < 16; ++i) { const int row = crow(i, hh); ok[i] = (kabs0 + row >= 0) && (j != 0 || row >= r) && (j != 4 || row <= r); tmax = fmaxf(tmax, ok[i] ? st[i] : -1e30f); }
        tmax = fmaxf(tmax, __shfl_xor(tmax, 32));
        const float mnew = fmaxf(m, tmax), alpha = exp2f(m - mnew);
        float pr[16], ps = 0.f;
#pragma unroll
        for (int i = 0; i < 16; ++i) { pr[i] = ok[i] ? exp2f(st[i] - mnew) : 0.f; ps += pr[i]; }
        l = l * alpha + ps; m = mnew;
#pragma unroll
        for (int i = 0; i < 16; ++i) { o[0][i] *= alpha; o[1][i] *= alpha; }
#pragma unroll
        for (int s2 = 0; s2 < 2; ++s2) { const bf16x8 bfrag = pack8(pr[8 * s2], pr[8 * s2 + 1], pr[8 * s2 + 2], pr[8 * s2 + 3], pr[8 * s2 + 4], pr[8 * s2 + 5], pr[8 * s2 + 6], pr[8 * s2 + 7]);
#pragma unroll
            for (int mt = 0; mt < 2; ++mt) { const LAS unsigned char* ap = Vl + (32 * mt + r) * ATT_VROW + (kk0 + 16 * s2 + 4 * hh) * 2;
                const s16x4 lo = *(const LAS s16x4*)ap, hi = *(const LAS s16x4*)(ap + 16);
                const bf16x8 a = __builtin_shufflevector(lo, hi, 0, 1, 2, 3, 4, 5, 6, 7);
                o[mt] = MFMA32(a, bfrag, o[mt]); } }
    }
    const float ltot = l + __shfl_xor(l, 32), inv = 1.f / ltot;
    gfp op = AOP + (size_t)p * MTOK * AWID + (size_t)tokq * AWID + h * 64;
#pragma unroll
    for (int mt = 0; mt < 2; ++mt)
#pragma unroll
        for (int g = 0; g < 4; ++g) { const f32x4 v = {o[mt][4 * g] * inv, o[mt][4 * g + 1] * inv, o[mt][4 * g + 2] * inv, o[mt][4 * g + 3] * inv};
            *(GAS f32x4*)(op + 32 * mt + 8 * g + 4 * hh) = v; }
    if (hh == 0) LSE[(size_t)p * MTOK * AH + tokq * AH + h] = (m + log2f(ltot)) * 0.6931471805599453f;
    __syncthreads();
}

__device__ __forceinline__ void attn_norm_token(int tok, gcf AOP, gcf LSE, gcf g, gbp Y, int lane) {
    float v[12], ss = 0.f;
#pragma unroll
    for (int i = 0; i < 12; ++i) { const float l0 = LSE[(size_t)tok * AH + i], l1 = LSE[(size_t)MTOK * AH + (size_t)tok * AH + i], l2 = LSE[2 * (size_t)MTOK * AH + (size_t)tok * AH + i];
        const float mx = fmaxf(fmaxf(l0, l1), l2), w0 = __expf(l0 - mx), w1 = __expf(l1 - mx), w2 = __expf(l2 - mx);
        const size_t o = (size_t)tok * AWID + lane + 64 * i;
        v[i] = (w0 * AOP[o] + w1 * AOP[(size_t)MTOK * AWID + o] + w2 * AOP[2 * (size_t)MTOK * AWID + o]) / (w0 + w1 + w2); ss += v[i] * v[i]; }
    const float rstd = rsqrtf(wave_sum(ss) * (1.f / AWID) + NORM_EPS);
#pragma unroll
    for (int i = 0; i < 12; ++i) Y[(size_t)tok * DM + RWID + lane + 64 * i] = (bf16)f2bf(v[i] * rstd * g[lane + 64 * i]);
}

constexpr int SGU_ROW = 272, SGU_UNITS = (MTOK / 128) * GGRP;
__device__ __forceinline__ void sgu_unit(int unit, gcb SU, gcb SVN, gcb W16  , gcf bs  , gbp Y, gfp SSQ, LAS unsigned char* lds, int tid, int wave, int lane) {
    const int g = unit & 7, bc = unit >> 3, b = bc / (SEQ / 128), c = bc % (SEQ / 128), tok0 = b * SEQ + c * 128;
    const int tl = lane & 15, g4 = lane >> 4, tok = tok0 + 16 * wave + tl, nks = (wave >> 1) + 1;
    bf16x8 bw[4];
#pragma unroll
    for (int ks = 0; ks < 4; ++ks) bw[ks] = *(const GAS bf16x8*)(W16 + (unsigned)((g * 128 + 16 * wave + tl) * 128 + 32 * (ks < nks ? ks : 0) + 8 * g4));
    const float bias = bs[g * 128 + 16 * wave + tl];
    f32x4 u4[4];
#pragma unroll
    for (int nt = 0; nt < 4; ++nt) u4[nt] = ld4bf(SU + (unsigned)(tok * GWID + g * 64 + 16 * nt + 4 * g4));
#pragma unroll
    for (int it = 0; it < 2; ++it) { const int idx = tid + 512 * it, tj = idx & 127, piece = idx >> 7;
        const v4u vv = *(const GAS v4u*)(SVN + (unsigned)((tok0 + tj) * GWID + g * 64 + piece * 8));
        LAS unsigned short* vd = (LAS unsigned short*)(lds + (piece * 8) * SGU_ROW + tj * 2);
        vd[0 * (SGU_ROW / 2)] = (unsigned short)(vv.x & 0xffffu); vd[1 * (SGU_ROW / 2)] = (unsigned short)(vv.x >> 16);
        vd[2 * (SGU_ROW / 2)] = (unsigned short)(vv.y & 0xffffu); vd[3 * (SGU_ROW / 2)] = (unsigned short)(vv.y >> 16);
        vd[4 * (SGU_ROW / 2)] = (unsigned short)(vv.z & 0xffffu); vd[5 * (SGU_ROW / 2)] = (unsigned short)(vv.z >> 16);
        vd[6 * (SGU_ROW / 2)] = (unsigned short)(vv.w & 0xffffu); vd[7 * (SGU_ROW / 2)] = (unsigned short)(vv.w >> 16); }
    __syncthreads();
    f32x4 acc[4];
#pragma unroll
    for (int nt = 0; nt < 4; ++nt) acc[nt] = (f32x4){0.f, 0.f, 0.f, 0.f};
#pragma unroll
    for (int ks = 0; ks < 4; ++ks) if (ks < nks) {
#pragma unroll
        for (int nt = 0; nt < 4; ++nt) acc[nt] = MFMA16(*(const LAS bf16x8*)(lds + (16 * nt + tl) * SGU_ROW + (32 * ks + 8 * g4) * 2), bw[ks], acc[nt]); }
    float ss = 0.f;
#pragma unroll
    for (int nt = 0; nt < 4; ++nt) { const f32x4 qv = u4[nt] * (acc[nt] + bias);
        ss += qv[0] * qv[0] + qv[1] * qv[1] + qv[2] * qv[2] + qv[3] * qv[3];
        *(GAS unsigned long long*)(Y + (unsigned)(tok * DM + RWID + AWID + g * 64 + 16 * nt + 4 * g4)) = (unsigned long long)pk2(qv[0], qv[1]) | ((unsigned long long)pk2(qv[2], qv[3]) << 32); }
    ss += __shfl_xor(ss, 16); ss += __shfl_xor(ss, 32);
    if (g4 == 0) SSQ[tok * 8 + g] = ss;
    __syncthreads();
}
__device__ __forceinline__ void sgu_norm_token(int tok, gcf SSQ, gcf ng, gbp Y, int lane) {
    const f32x4 s0 = *(const GAS f32x4*)(SSQ + tok * 8), s1 = *(const GAS f32x4*)(SSQ + tok * 8 + 4);
    const float rstd = rsqrtf((s0[0] + s0[1] + s0[2] + s0[3] + s1[0] + s1[1] + s1[2] + s1[3]) * (1.f / GWID) + NORM_EPS);
    GAS v4u* yp = (GAS v4u*)(Y + (size_t)tok * DM + RWID + AWID + 8 * lane);
    const v4u y = *yp; const f32x4 g0 = *(const GAS f32x4*)(ng + 8 * lane), g1 = *(const GAS f32x4*)(ng + 8 * lane + 4);
    v4u o; o.x = pk2(bflo(y.x) * rstd * g0[0], bfhi(y.x) * rstd * g0[1]); o.y = pk2(bflo(y.y) * rstd * g0[2], bfhi(y.y) * rstd * g0[3]);
    o.z = pk2(bflo(y.z) * rstd * g1[0], bfhi(y.z) * rstd * g1[1]); o.w = pk2(bflo(y.w) * rstd * g1[2], bfhi(y.w) * rstd * g1[3]);
    *yp = o;
}

__device__ __forceinline__ void conv_fix_item(int item, gcf HALO, gcf RAW01, gcf cw, gcf cb, gbp H) {
    const int j = item % DFF, rr = (item / DFF) & 1, pm = item / (2 * DFF);
    if (pm % (SEQ / 256) == 0) return;
    const int tc = 256 * (j / 128) + (j % 128);
    gcf r0 = RAW01 + (size_t)(pm * 2) * UPN, r1 = r0 + UPN, h0 = HALO + (size_t)((pm - 1) * 2) * UPN, h1 = h0 + UPN;
    float g0, g1, g2, v0, v1, v2;
    if (rr == 0) { g2 = r0[tc]; g1 = h1[tc]; g0 = h0[tc]; v2 = r0[tc + 128]; v1 = h1[tc + 128]; v0 = h0[tc + 128]; }
    else { g2 = r1[tc]; g1 = r0[tc]; g0 = h1[tc]; v2 = r1[tc + 128]; v1 = r0[tc + 128]; v0 = h1[tc + 128]; }
    const float cg = cb[j] + cw[j] * g0 + cw[UPN + j] * g1 + cw[2 * UPN + j] * g2;
    const float cv = cb[DFF + j] + cw[DFF + j] * v0 + cw[UPN + DFF + j] * v1 + cw[2 * UPN + DFF + j] * v2;
    H[(size_t)(pm * 256 + rr) * DFF + j] = (bf16)f2bf(pg8::gelu_tanh_fast(cg) * cv);
}

typedef const __attribute__((address_space(4))) unsigned long long* kargs_t;
__device__ __forceinline__ kargs_t kargs() { kargs_t ka = (kargs_t)__builtin_amdgcn_kernarg_segment_ptr(); asm volatile("" : "+s"(ka)); return ka; }
#define KIN(i) ((gcf)ka[i])
#define KOUT ((gfp)ka[29])
#define KWS ((GAS unsigned char*)ka[30])
constexpr size_t AS_ = (size_t)MTOK * RWID;
__device__ __forceinline__ int lane_id() { int l; asm volatile("v_mbcnt_lo_u32_b32 %0, -1, 0\n\tv_mbcnt_hi_u32_b32 %0, -1, %0" : "=v"(l)); return l; }
#define PH_IDS const int lane = lane_id(); const int tid = wave * 64 + lane; (void)tid
#define GBAR() do { const int lane_b = lane_id(); kargs_t kb = kargs(); XcdBarrier bb; bb.bar = (unsigned*)((GAS unsigned*)((GAS unsigned char*)kb[30] + WS_CTL) + CW_BAR); bb.x = xb_xcc_id(); \
    bb.st = (volatile LAS unsigned*)(lds + MISC_OFF) + 8; xcd_barrier(bb, wave * 64 + lane_b); } while (0)

__global__ void __launch_bounds__(NTHR, 2) mega_fwd(Params p) {
    extern __shared__ __attribute__((aligned(16))) unsigned char lds_raw[];
    LAS unsigned char* lds = (LAS unsigned char*)lds_raw;
    const int wave = __builtin_amdgcn_readfirstlane((int)threadIdx.x >> 6);
    const int G = gridDim.x, gw = blockIdx.x * NWAVES + wave, ngw = G * NWAVES;
    { PH_IDS; kargs_t ka = kargs();
      for (int u = tid; u < (LDS_BYTES - LDSCTL_OFF) / 4; u += NTHR) ((LAS unsigned*)(lds + LDSCTL_OFF))[u] = 0u;
      __syncthreads();
      (void)xcd_barrier_post((unsigned*)((GAS unsigned*)(KWS + WS_CTL) + CW_BAR), (volatile LAS unsigned*)(lds + MISC_OFF) + 8, tid); }

    {
        PH_IDS; kargs_t ka = kargs(); GAS unsigned char* ws = KWS;
        LAS float* scr = (LAS float* )(lds + wave * 16384);
        for (int l = 0; l < DEPTH; ++l) {
            for (int it = gw; it < (DM / 64) * (INCOLS / 32); it += ngw) p0_transpose_item(KIN(6) + (size_t)l * DM * INCOLS, DM, INCOLS, (gbp)(ws + WS_WIN) + (size_t)l * INCOLS * DM, 0, scr, it, lane);
            for (int it = gw; it < (DM / 64) * (DM / 32); it += ngw) p0_transpose_item(KIN(24) + (size_t)l * DM * DM, DM, DM, (gbp)(ws + WS_WOUT) + (size_t)l * DM * DM, 0, scr, it, lane);
            for (int it = gw; it < (DM / 64) * (UPN / 32); it += ngw) p0_transpose_item(KIN(25) + (size_t)l * DM * UPN, DM, UPN, (gbp)(ws + WS_WUP) + (size_t)l * UPN * DM, -1, scr, it, lane);
            for (int it = gw; it < (DFF / 64) * (DM / 32); it += ngw) p0_transpose_item(KIN(28) + (size_t)l * DFF * DM, DFF, DM, (gbp)(ws + WS_WDN) + (size_t)l * DM * DFF, 0, scr, it, lane);
        }
        {
            gbp SW = (gbp)(ws + WS_SGW);
            for (int i = blockIdx.x * NTHR + tid; i < DEPTH * 8 * 128 * 128; i += G * NTHR) { const int jj = i & 127, ii = (i >> 7) & 127; SW[i] = (bf16)f2bf(jj <= ii ? KIN(21)[i] : 0.f); } }
        {
            gbp LW = (gbp)(ws + WS_LORA);
            for (int i = blockIdx.x * NTHR + tid; i < DEPTH * LORA_L; i += G * NTHR) { const int l = i / LORA_L, rr = i % LORA_L;
                float v; if (rr < RWID * 64) { const int n = rr / 64, k = rr % 64; v = KIN(9)[(size_t)l * 64 * RWID + k * RWID + n]; }
                else if (rr < RWID * 128) { const int q = rr - RWID * 64, n = q / 64, k = q % 64; v = KIN(11)[(size_t)l * 64 * RWID + k * RWID + n]; }
                else { const int q = rr - RWID * 128, n = q / 128, k = q % 128; v = KIN(12)[(size_t)l * 128 * RWID + k * RWID + n]; }
                LW[i] = (bf16)f2bf(v); } }
        rowpass(KIN(0), nullptr, nullptr, nullptr, KIN(2), (gbp)(ws + WS_HN), gw, ngw, lane);
    }
    GBAR();

    for (int l = 0; l < DEPTH; ++l) {
        { PH_IDS; kargs_t ka = kargs(); GAS unsigned char* ws = KWS;
          pg8::Gemm g{(gbp)(ws + WS_HN), (gbp)(ws + WS_WIN) + (size_t)l * INCOLS * DM, MTOK, INCOLS, DM}; pg8::StaticOrder S; S.init(MTOK, INCOLS, G, (int)blockIdx.x);
          pg8::EpiBf16<0> E{(gbp)(ws + WS_PROJ), INCOLS, nullptr, 0, 0, 1.f};
          pg8::gemm_phase<pg8::EpiBf16<0>, pg8::StaticOrder, true, true>(lds, g, S, E, tid); }
        GBAR();
        { PH_IDS; kargs_t ka = kargs(); GAS unsigned char* ws = KWS;
          gcb LW = (gcb)(ws + WS_LORA) + (size_t)l * LORA_L;
          RPW rw{KIN(7) + (size_t)l * RCOLS, KIN(8) + (size_t)l * RWID, KIN(10) + (size_t)l * RWID, KIN(13) + (size_t)l * RWID, KIN(14) + (size_t)l * RWID, KIN(15) + (size_t)l * RWID, LW, LW + RWID * 64, LW + RWID * 128};
          for (int u = blockIdx.x; u < MTOK / 32; u += G) rwkv_prep_unit(u, (gcb)(ws + WS_PROJ), rw, (gfp)(ws + WS_RW), (gfp)(ws + WS_BON), lds, tid, wave, lane);
          PrepW w{KIN(19) + (size_t)l * GWID, KIN(20) + (size_t)l * GWID, (gci)KIN(1)};
          gbp SU = (gbp)(ws + WS_SGU);
          for (int tok = gw; tok < MTOK; tok += ngw) prep_token(tok, (gcb)(ws + WS_PROJ), w, (gbp)(ws + WS_QKR), SU, SU + (size_t)MTOK * GWID, lane); }
        GBAR();
        { PH_IDS; kargs_t ka = kargs(); GAS unsigned char* ws = KWS;
          LAS float* ops = (LAS float*)(lds + wave * 4096);
          gfp RWb = (gfp)(ws + WS_RW); gfp PT = (gfp)(ws + WS_CHK);
          for (int task = blockIdx.x + G * wave; task < NTASK_SCAN; task += G * NWAVES) scan_chunk(task, RWb, RWb + 7 * AS_, RWb + 8 * AS_, (gbp)PT, (gbp)(PT + (size_t)NTASK_SCAN * 4096), ops, lane); }
        GBAR();
        if (blockIdx.x < BATCH * RH) { PH_IDS; kargs_t ka = kargs(); GAS unsigned char* ws = KWS; gfp PT = (gfp)(ws + WS_CHK);
              scan_carry_ring((int)blockIdx.x, (gcb)PT, (gcb)(PT + (size_t)NTASK_SCAN * 4096), PT + 2 * (size_t)NTASK_SCAN * 4096, lds, wave, lane); }
        { PH_IDS; kargs_t ka = kargs(); GAS unsigned char* ws = KWS;
          volatile LAS unsigned* MISC = (volatile LAS unsigned*)(lds + MISC_OFF);
          gu32* ctr = (gu32*)(ws + WS_CTL) + CW_ATT + 64 * l;
          for (;;) {
              if (tid == 0) MISC[16] = __hip_atomic_fetch_add(ctr, 1u, __ATOMIC_RELAXED, __HIP_MEMORY_SCOPE_AGENT);
              __syncthreads();
              const int u = (int)MISC[16];
              if (u >= ATT_UNITS + SGU_UNITS) break;
              if (u < ATT_UNITS) attn_unit(u, (gcb)(ws + WS_QKR), (gcb)(ws + WS_PROJ), (gfp)(ws + WS_AO), (gfp)(ws + WS_LSE), lds, tid, wave, lane);
              else { gcb SU = (gcb)(ws + WS_SGU); sgu_unit(u - ATT_UNITS, SU, SU + (size_t)MTOK * GWID, (gcb)(ws + WS_SGW) + (size_t)l * 8 * 128 * 128, KIN(22) + (size_t)l * 8 * 128, (gbp)(ws + WS_Y), (gfp)(ws + WS_SSQ), lds, tid, wave, lane); }
          }
        }
        GBAR();
        { PH_IDS; kargs_t ka = kargs(); GAS unsigned char* ws = KWS;
          LAS float* zb = (LAS float*)(lds + wave * 1024);
          gfp RWb = (gfp)(ws + WS_RW); gfp PT = (gfp)(ws + WS_CHK);
          for (int task = gw; task < NTASK_SCAN; task += ngw) scan_out(task, RWb, RWb + 7 * AS_, RWb + 8 * AS_, PT + 2 * (size_t)NTASK_SCAN * 4096, (gfp)(ws + WS_BON), KIN(16) + (size_t)l * RWID, KIN(17) + (size_t)l * RWID, (gbp)(ws + WS_Y), zb, lane);
          for (int tok = gw; tok < MTOK; tok += ngw) { attn_norm_token(tok, (gcf)(ws + WS_AO), (gcf)(ws + WS_LSE), KIN(18) + (size_t)l * AWID, (gbp)(ws + WS_Y), lane);
              sgu_norm_token(tok, (gcf)(ws + WS_SSQ), KIN(23) + (size_t)l * GWID, (gbp)(ws + WS_Y), lane); } }
        GBAR();
        { PH_IDS; kargs_t ka = kargs(); GAS unsigned char* ws = KWS;
          pg8::Gemm g{(gbp)(ws + WS_Y), (gbp)(ws + WS_WOUT) + (size_t)l * DM * DM, MTOK, DM, DM}; pg8::StaticOrder S; S.init(MTOK, DM, G, (int)blockIdx.x);
          pg8::EpiF32 E{(gfp)(ws + WS_O), DM};
          pg8::gemm_phase<pg8::EpiF32, pg8::StaticOrder, true, true>(lds, g, S, E, tid); }
        GBAR();
        { PH_IDS; kargs_t ka = kargs(); GAS unsigned char* ws = KWS;
          rowpass(l == 0 ? KIN(0) : (gcf)KOUT, (gfp)(ws + WS_O), KIN(3) + (size_t)l * DM, KOUT, KIN(4) + (size_t)l * DM, (gbp)(ws + WS_HN), gw, ngw, lane); }
        GBAR();
        { PH_IDS; kargs_t ka = kargs(); GAS unsigned char* ws = KWS;
          pg8::Gemm g{(gbp)(ws + WS_HN), (gbp)(ws + WS_WUP) + (size_t)l * UPN * DM, MTOK, UPN, DM}; pg8::StaticOrder S; S.init(MTOK, UPN, G, (int)blockIdx.x);
          pg8::EpiConvGlu E{(gbp)(ws + WS_H), DFF, KIN(26) + (size_t)l * 3 * UPN, KIN(27) + (size_t)l * UPN, UPN, DFF, (gfp)(ws + WS_HALO), (gfp)(ws + WS_RAW01), (LAS float*)(lds + RING_BYTES + 4096), SEQ / 256};
          pg8::gemm_phase<pg8::EpiConvGlu, pg8::StaticOrder, true, true>(lds, g, S, E, tid); }
        GBAR();
        { PH_IDS; kargs_t ka = kargs(); GAS unsigned char* ws = KWS;
          for (int it = blockIdx.x * NTHR + tid; it < (MTOK / 256) * 2 * DFF; it += G * NTHR) conv_fix_item(it, (gcf)(ws + WS_HALO), (gcf)(ws + WS_RAW01), KIN(26) + (size_t)l * 3 * UPN, KIN(27) + (size_t)l * UPN, (gbp)(ws + WS_H)); }
        GBAR();
        { PH_IDS; kargs_t ka = kargs(); GAS unsigned char* ws = KWS;
          pg8::Gemm g{(gbp)(ws + WS_H), (gbp)(ws + WS_WDN) + (size_t)l * DM * DFF, MTOK, DM, DFF}; pg8::StaticOrder S; S.init(MTOK, DM, G, (int)blockIdx.x);
          pg8::EpiF32 E{(gfp)(ws + WS_O), DM};
          pg8::gemm_phase<pg8::EpiF32, pg8::StaticOrder, true, true>(lds, g, S, E, tid); }
        GBAR();
        { PH_IDS; kargs_t ka = kargs(); GAS unsigned char* ws = KWS;
          rowpass(KOUT, (gfp)(ws + WS_O), KIN(5) + (size_t)l * DM, KOUT, l + 1 < DEPTH ? KIN(2) + (size_t)(l + 1) * DM : nullptr, (gbp)(ws + WS_HN), gw, ngw, lane); }
        if (l + 1 < DEPTH) GBAR();
    }
}

extern "C" void kernel_launch(void* const* d_in, const int* in_sizes, int n_in, void* d_out, int out_size, void* d_ws, size_t ws_size, hipStream_t stream) {
    static int grid = 0;
    if (grid == 0) {
        if (n_in != 29 || out_size != MTOK * DM || ws_size < WS_END) { fprintf(stderr, "kernel_launch: unexpected shapes (n_in %d out %d ws %zu need %zu)\n", n_in, out_size, ws_size, (size_t)WS_END); grid = -1; return; }
        int dev = 0, cus = 0, per_cu = 0;
        if (hipGetDevice(&dev) != hipSuccess || hipDeviceGetAttribute(&cus, hipDeviceAttributeMultiprocessorCount, dev) != hipSuccess) { grid = -1; return; }
        if (hipFuncSetAttribute((const void*)mega_fwd, hipFuncAttributeMaxDynamicSharedMemorySize, LDS_BYTES) != hipSuccess) { fprintf(stderr, "kernel_launch: hipFuncSetAttribute failed\n"); grid = -1; return; }
        if (hipOccupancyMaxActiveBlocksPerMultiprocessor(&per_cu, (const void*)mega_fwd, NTHR, LDS_BYTES) != hipSuccess || per_cu < 1) fprintf(stderr, "kernel_launch: occupancy query says %d\n", per_cu);
        (void)hipGetLastError();
        grid = cus;
    }
    if (grid < 0) return;
    if (hipMemsetAsync((char*)d_ws + WS_CTL, 0, CTL_ZERO_BYTES, stream) != hipSuccess) return;
    Params prm{};
    for (int i = 0; i < 29; ++i) prm.in[i] = (const float*)d_in[i];
    prm.out = (float*)d_out; prm.ws = (unsigned char*)d_ws;
    hipLaunchKernelGGL(mega_fwd, dim3(grid), dim3(NTHR), LDS_BYTES, stream, prm);
}
```

```cpp
#include <hip/hip_runtime.h>
#include <cstdio>
#include <cstdint>
namespace pg8 {
#define PG8_LAS __attribute__((address_space(3)))
#define PG8_GAS __attribute__((address_space(1)))
typedef unsigned short bf16_t;
typedef short bf16x8 __attribute__((ext_vector_type(8)));
typedef float f32x4 __attribute__((ext_vector_type(4)));
typedef unsigned u32x4 __attribute__((ext_vector_type(4)));
constexpr int BM = 256, BK = 64, HALF = 128, HTB = HALF * BK * 2  , STAGE_BYTES = 8 * HTB, NXCD = 8, WGM = 8;

__host__ __device__ __forceinline__ int lds_byte(int r, int c) { const int st = (r >> 4) * 2 + (c >> 5), rr = r & 15, cc = c & 31, ob = rr * 64 + cc * 2; return st * 1024 + (ob ^ (((ob >> 9) & 1) << 5)); }
__host__ __device__ __forceinline__ void stage_rc(int b, int& R, int& C) { const int st = b / 1024, sb = b % 1024, swz = sb ^ (((sb >> 9) & 1) << 5); R = (st >> 1) * 16 + swz / 64; C = (st & 1) * 32 + (swz % 64) / 2; }
__host__ __device__ __forceinline__ int perm32(int rho) { const int n = rho >> 4, i = rho & 15; return 8 * (i >> 2) + 4 * n + (i & 3); }

struct Unit { int pm, pn; };
struct Gemm { const PG8_GAS bf16_t* A; const PG8_GAS bf16_t* Bt; int M, N, K; };

struct StaticOrder {
    int nM, nN, nwg, G, c;
    __host__ __device__ void init(int M, int N, int G_, int c_) { nM = M / BM; nN = N / BM; nwg = nM * nN; G = G_; c = c_; }
    __host__ __device__ bool next(int i, Unit& u) const {
        const long L = (long)i * G + c; if (L >= nwg) return false;
        int wgid = (int)L; { const int q = nwg / NXCD, r = nwg % NXCD, xcd = wgid % NXCD, off = wgid / NXCD; wgid = (xcd < r ? xcd * (q + 1) : r * (q + 1) + (xcd - r) * q) + off; }
        const int nig = WGM * nN, gid = wgid / nig, fm = gid * WGM, gsz = (nM - fm) < WGM ? (nM - fm) : WGM;
        u.pm = fm + ((wgid % nig) % gsz); u.pn = (wgid % nig) / gsz; return true;
    }
    __device__ __forceinline__ void a_ready(const Unit&) const {}
    __device__ __forceinline__ void done(const Unit&) const {}
};

__device__ __forceinline__ unsigned cvt_pk_bf16(float lo, float hi) { unsigned r; asm volatile("v_cvt_pk_bf16_f32 %0, %1, %2" : "=v"(r) : "v"(lo), "v"(hi)); return r; }
typedef float f32x2 __attribute__((ext_vector_type(2)));
__device__ __forceinline__ f32x2 gelu_pk(f32x2 v) {
    const f32x2 av = __builtin_elementwise_abs(v), d = av * 0.2316418882f + 1.0f;
    f32x2 t; t.x = __builtin_amdgcn_rcpf(d.x); t.y = __builtin_amdgcn_rcpf(d.y);
    f32x2 q = t * 0.5307027145f + (-0.7265760135f); q = q * t + 0.7107068705f; q = q * t + (-0.142248368f); q = q * t + 0.127414796f; q = q * t;
    const f32x2 s = (v * v) * (-0.72134752044f);
    f32x2 e; e.x = __builtin_amdgcn_exp2f(s.x); e.y = __builtin_amdgcn_exp2f(s.y);
    const f32x2 m = v * (q * e), r = v - m;
    f32x2 o; o.x = v.x < 0.f ? m.x : r.x; o.y = v.y < 0.f ? m.y : r.y; return o;
}

template <int ACT  > struct EpiBf16 {
    static constexpr bool PERM = true, AFTER_DRAIN = false; static_assert(ACT == 0 || ACT == 1, "EpiBf16: ACT is 0 (none) or 1 (gelu_pk)");
    PG8_GAS bf16_t* O; int ldc; const PG8_GAS float* bias; int split_cols; size_t split_stride; float scale0;
    __device__ __forceinline__ void operator()(const f32x4 (&acc)[2][2][4][2], const Unit& u, int wr, int wc, int fr, int fq) const {
        const int row0 = u.pm * BM + wr * 64 + fr; int colt = u.pn * BM; PG8_GAS bf16_t* base = O;
        float sc = 1.f; if (split_cols) { const int t = colt / split_cols; base += (size_t)t * split_stride; colt -= t * split_cols; if (t == 0) sc = scale0; }
        const int col0 = colt + wc * 32 + 8 * fq, bcol0 = u.pn * BM + wc * 32 + 8 * fq;
        f32x4 bv[2][2];
#pragma unroll
        for (int bj = 0; bj < 2; ++bj)
#pragma unroll
            for (int n = 0; n < 2; ++n) bv[bj][n] = bias ? *(const PG8_GAS f32x4*)(bias + bcol0 + bj * HALF + 4 * n) : (f32x4){0.f, 0.f, 0.f, 0.f};
#pragma unroll
        for (int ai = 0; ai < 2; ++ai)
#pragma unroll
            for (int m = 0; m < 4; ++m) { PG8_GAS bf16_t* rowp = base + (size_t)(row0 + ai * HALF + m * 16) * ldc + col0;
#pragma unroll
                for (int bj = 0; bj < 2; ++bj) { f32x4 v0 = acc[ai][bj][m][0] + bv[bj][0], v1 = acc[ai][bj][m][1] + bv[bj][1];
                    if (ACT == 1) { f32x2 a = gelu_pk((f32x2){v0[0], v0[1]}), b = gelu_pk((f32x2){v0[2], v0[3]}), c = gelu_pk((f32x2){v1[0], v1[1]}), d = gelu_pk((f32x2){v1[2], v1[3]});
                        v0 = (f32x4){a.x, a.y, b.x, b.y}; v1 = (f32x4){c.x, c.y, d.x, d.y}; }
                    v0 = v0 * sc; v1 = v1 * sc; u32x4 w; w.x = cvt_pk_bf16(v0[0], v0[1]); w.y = cvt_pk_bf16(v0[2], v0[3]); w.z = cvt_pk_bf16(v1[0], v1[1]); w.w = cvt_pk_bf16(v1[2], v1[3]);
                    *(PG8_GAS u32x4*)(rowp + bj * HALF) = w; } }
    }
};
struct EpiF32 {
    static constexpr bool PERM = true, AFTER_DRAIN = false;
    PG8_GAS float* O; int ldc;
    __device__ __forceinline__ void operator()(const f32x4 (&acc)[2][2][4][2], const Unit& u, int wr, int wc, int fr, int fq) const {
        const int row0 = u.pm * BM + wr * 64 + fr, col0 = u.pn * BM + wc * 32 + 8 * fq;
#pragma unroll
        for (int ai = 0; ai < 2; ++ai)
#pragma unroll
            for (int m = 0; m < 4; ++m) { PG8_GAS float* rowp = O + (size_t)(row0 + ai * HALF + m * 16) * ldc + col0;
#pragma unroll
                for (int bj = 0; bj < 2; ++bj) { *(PG8_GAS f32x4*)(rowp + bj * HALF) = acc[ai][bj][m][0]; *(PG8_GAS f32x4*)(rowp + bj * HALF + 4) = acc[ai][bj][m][1]; } }
    }
};

__device__ __forceinline__ float dpp_ror1(float x) { return __builtin_bit_cast(float, __builtin_amdgcn_update_dpp(0, __builtin_bit_cast(int, x), 0x121, 0xF, 0xF, false)); }
__device__ __forceinline__ float dpp_ror2(float x) { return __builtin_bit_cast(float, __builtin_amdgcn_update_dpp(0, __builtin_bit_cast(int, x), 0x122, 0xF, 0xF, false)); }
__device__ __forceinline__ float gelu_tanh_fast(float x) { const float u2 = x * (1.5957691216f + 0.0713548162f * x * x); return x * __builtin_amdgcn_rcpf(1.f + __expf(-u2)); }
struct EpiConvGlu {
    static constexpr bool PERM = true, AFTER_DRAIN = false;
    PG8_GAS bf16_t* H; int ldh; const PG8_GAS float* cw; const PG8_GAS float* cb; int upn, dff;
    PG8_GAS float* halo; PG8_GAS float* raw01; PG8_LAS float* xch; int tiles_per_seq;
    __device__ __forceinline__ void operator()(const f32x4 (&acc)[2][2][4][2], const Unit& u, int wr, int wc, int fr, int fq) const {
        const int colt = 32 * wc + 8 * fq;
        const bool first_seq = (u.pm % tiles_per_seq) == 0;
        if (fr >= 14) {
#pragma unroll
            for (int ai = 0; ai < 2; ++ai)
#pragma unroll
                for (int bj = 0; bj < 2; ++bj)
#pragma unroll
                    for (int n = 0; n < 2; ++n) *(PG8_LAS f32x4*)(xch + ((2 * ai + wr) * 2 + (fr - 14)) * 256 + 128 * bj + colt + 4 * n) = acc[ai][bj][3][n];
            if (wr == 1) {
#pragma unroll
                for (int bj = 0; bj < 2; ++bj)
#pragma unroll
                    for (int n = 0; n < 2; ++n) *(PG8_GAS f32x4*)(halo + ((size_t)u.pm * 2 + (fr - 14)) * upn + 256 * u.pn + 128 * bj + colt + 4 * n) = acc[1][bj][3][n]; }
        }
        if (fr < 2 && wr == 0 && !first_seq) {
#pragma unroll
            for (int bj = 0; bj < 2; ++bj)
#pragma unroll
                for (int n = 0; n < 2; ++n) *(PG8_GAS f32x4*)(raw01 + ((size_t)u.pm * 2 + fr) * upn + 256 * u.pn + 128 * bj + colt + 4 * n) = acc[0][bj][0][n]; }
        asm volatile("s_waitcnt lgkmcnt(0)" ::: "memory");
        __builtin_amdgcn_s_barrier();
        const int jcol = 128 * u.pn + colt;
#pragma unroll
        for (int ai = 0; ai < 2; ++ai) { const int seg = 2 * ai + wr;
            unsigned hp[4][2][2];
#pragma unroll
            for (int n = 0; n < 2; ++n) {
                f32x4 vg = {0.f, 0.f, 0.f, 0.f}, vv = vg;
                if (seg > 0 && fr >= 14) { vg = *(const PG8_LAS f32x4*)(xch + ((seg - 1) * 2 + (fr - 14)) * 256 + colt + 4 * n); vv = *(const PG8_LAS f32x4*)(xch + ((seg - 1) * 2 + (fr - 14)) * 256 + 128 + colt + 4 * n); }
                const int j = jcol + 4 * n;
                const f32x4 w0g = *(const PG8_GAS f32x4*)(cw + j), w1g = *(const PG8_GAS f32x4*)(cw + upn + j), w2g = *(const PG8_GAS f32x4*)(cw + 2 * upn + j), bg = *(const PG8_GAS f32x4*)(cb + j);
                const f32x4 w0v = *(const PG8_GAS f32x4*)(cw + dff + j), w1v = *(const PG8_GAS f32x4*)(cw + upn + dff + j), w2v = *(const PG8_GAS f32x4*)(cw + 2 * upn + dff + j), bv = *(const PG8_GAS f32x4*)(cb + dff + j);
                f32x4 pg1, pg2, pv1, pv2;
#pragma unroll
                for (int e = 0; e < 4; ++e) { pg1[e] = dpp_ror1(vg[e]); pg2[e] = dpp_ror2(vg[e]); pv1[e] = dpp_ror1(vv[e]); pv2[e] = dpp_ror2(vv[e]); }
#pragma unroll
                for (int m = 0; m < 4; ++m) { const f32x4 xg = acc[ai][0][m][n], xv = acc[ai][1][m][n]; f32x4 ag1, ag2, av1, av2, hv;
#pragma unroll
                    for (int e = 0; e < 4; ++e) { ag1[e] = dpp_ror1(xg[e]); ag2[e] = dpp_ror2(xg[e]); av1[e] = dpp_ror1(xv[e]); av2[e] = dpp_ror2(xv[e]);
                        const float g1 = fr >= 1 ? ag1[e] : pg1[e], g2 = fr >= 2 ? ag2[e] : pg2[e], v1 = fr >= 1 ? av1[e] : pv1[e], v2 = fr >= 2 ? av2[e] : pv2[e];
                        const float cg = bg[e] + w0g[e] * g2 + w1g[e] * g1 + w2g[e] * xg[e], cv = bv[e] + w0v[e] * v2 + w1v[e] * v1 + w2v[e] * xv[e];
                        hv[e] = gelu_tanh_fast(cg) * cv; }
                    hp[m][n][0] = cvt_pk_bf16(hv[0], hv[1]); hp[m][n][1] = cvt_pk_bf16(hv[2], hv[3]);
                    pg1 = ag1; pg2 = ag2; pv1 = av1; pv2 = av2; }
            }
#pragma unroll
            for (int m = 0; m < 4; ++m) { const int row = u.pm * BM + ai * HALF + wr * 64 + m * 16 + fr;
                const bool skip = !first_seq && ai == 0 && wr == 0 && m == 0 && fr < 2;
                if (!skip) { u32x4 w; w.x = hp[m][0][0]; w.y = hp[m][0][1]; w.z = hp[m][1][0]; w.w = hp[m][1][1]; *(PG8_GAS u32x4*)(H + (size_t)row * ldh + jcol) = w; } }
        }
    }
};

struct EpiProj {
    static constexpr bool PERM = true, AFTER_DRAIN = false;
    PG8_GAS bf16_t* O; int ldc; const PG8_GAS float* rope; int pn_q, pn_k, pn_v, pn_g;
    __device__ __forceinline__ void operator()(const f32x4 (&acc)[2][2][4][2], const Unit& u, int wr, int wc, int fr, int fq) const {
        const int row0 = u.pm * BM + wr * 64 + fr, col0 = u.pn * BM + wc * 32 + 8 * fq;
        const int cls = u.pn >= pn_g ? 3 : (u.pn >= pn_v ? 0 : (u.pn >= pn_k ? 2 : (u.pn >= pn_q ? 1 : 0)));
        const bool rot = (cls == 1 || cls == 2) && ((wc & 1) == 0);
        const float sgn = fq == 0 ? -1.f : 1.f, qs = cls == 1 ? 0.18033688011112042f : 1.f;
#pragma unroll
        for (int ai = 0; ai < 2; ++ai)
#pragma unroll
            for (int m = 0; m < 4; ++m) { const int row = row0 + ai * HALF + m * 16; PG8_GAS bf16_t* rowp = O + (size_t)row * ldc + col0;
                f32x4 c0 = {1.f, 1.f, 1.f, 1.f}, c1 = c0, s0 = {0.f, 0.f, 0.f, 0.f}, s1 = s0;
                if (rot && fq < 2) { const PG8_GAS float* rp = rope + (size_t)row * 16; c0 = *(const PG8_GAS f32x4*)rp; c1 = *(const PG8_GAS f32x4*)(rp + 4); s0 = *(const PG8_GAS f32x4*)(rp + 8) * sgn; s1 = *(const PG8_GAS f32x4*)(rp + 12) * sgn; }
#pragma unroll
                for (int bj = 0; bj < 2; ++bj) { f32x4 v0 = acc[ai][bj][m][0], v1 = acc[ai][bj][m][1];
                    if (rot) { f32x4 p0, p1;
#pragma unroll
                        for (int e = 0; e < 4; ++e) { p0[e] = __shfl_xor(v0[e], 16); p1[e] = __shfl_xor(v1[e], 16); }
                        v0 = v0 * c0 + p0 * s0; v1 = v1 * c1 + p1 * s1; }
                    if (cls == 3) {
#pragma unroll
                        for (int e = 0; e < 4; ++e) { v0[e] = gelu_tanh_fast(v0[e]); v1[e] = gelu_tanh_fast(v1[e]); } }
                    v0 = v0 * qs; v1 = v1 * qs;
                    u32x4 w; w.x = cvt_pk_bf16(v0[0], v0[1]); w.y = cvt_pk_bf16(v0[2], v0[3]); w.z = cvt_pk_bf16(v1[0], v1[1]); w.w = cvt_pk_bf16(v1[2], v1[3]);
                    *(PG8_GAS u32x4*)(rowp + bj * HALF) = w; } }
    }
};

template <class Epi, class Sched, bool ALIGN_EPI = false, bool SP2 = false>
__device__ __forceinline__ void gemm_phase(PG8_LAS unsigned char* lds, const Gemm g, const Sched& S, const Epi& E, const int tid) {
    const int wid = __builtin_amdgcn_readfirstlane(tid >> 6), lane = tid & 63, wr = wid >> 2, wc = wid & 3, fr = lane & 15, fq = lane >> 4;
    const int K = g.K, nt = K / BK;
    unsigned voffA[2], voffB[2];
#pragma unroll
    for (int i = 0; i < 2; ++i) { int R, C; stage_rc(tid * 16 + i * 8192, R, C); const int Rb = Epi::PERM ? ((R & ~31) + perm32(R & 31)) : R;
        voffA[i] = (unsigned)(R * K + C) * 2u; voffB[i] = (unsigned)(Rb * K + C) * 2u; }
    const size_t kstep = (size_t)(BK * 2);
    const size_t hstep = (size_t)HALF * K * 2;
    const size_t tstep = 2 * hstep;
    const unsigned ldsw = (unsigned)wid * 1024u;
    const int aoff = lds_byte(wr * 64 + fr, fq * 8), boff = lds_byte(wc * 32 + fr, fq * 8);
#define PG8_SA(b, h) (((b) * 2 + (h)) * HTB)
#define PG8_SB(b, h) ((4 + (b) * 2 + (h)) * HTB)
#define PG8_STAGE(bufoff, gbase, voff) do { _Pragma("unroll") for (int _i = 0; _i < 2; ++_i) \
        __builtin_amdgcn_global_load_lds((const PG8_GAS unsigned*)((const PG8_GAS char*)(gbase) + (voff)[_i]), (PG8_LAS unsigned*)(lds + (bufoff) + ldsw + _i * 8192), 16, 0, 0); } while (0)
#define PG8_LDA(dst, b, h) do { _Pragma("unroll") for (int m = 0; m < 4; ++m) _Pragma("unroll") for (int k = 0; k < 2; ++k) dst[m][k] = *(const PG8_LAS bf16x8*)(lds + PG8_SA(b, h) + aoff + m * 2048 + k * 1024); } while (0)
#define PG8_LDB(dst, b, h) do { _Pragma("unroll") for (int n = 0; n < 2; ++n) _Pragma("unroll") for (int k = 0; k < 2; ++k) dst[n][k] = *(const PG8_LAS bf16x8*)(lds + PG8_SB(b, h) + boff + n * 2048 + k * 1024); } while (0)
#define PG8_MMA(ai, bj, At, Bt) do { __builtin_amdgcn_s_setprio(1); _Pragma("unroll") for (int m = 0; m < 4; ++m) _Pragma("unroll") for (int n = 0; n < 2; ++n) _Pragma("unroll") for (int k = 0; k < 2; ++k) \
        acc[ai][bj][m][n] = __builtin_amdgcn_mfma_f32_16x16x32_bf16(Bt[n][k], At[m][k], acc[ai][bj][m][n], 0, 0, 0); __builtin_amdgcn_s_setprio(0); } while (0)
#define PG8_WAIT_V(n) asm volatile("s_waitcnt vmcnt(" #n ")" ::: "memory")
#define PG8_WAIT_L(n) asm volatile("s_waitcnt lgkmcnt(" #n ")" ::: "memory")
#define PG8_BAR __builtin_amdgcn_s_barrier()
#define PG8_SCHED __builtin_amdgcn_sched_barrier(0)
    Unit cur, nxt; int ui = 0;
    if (!S.next(0, cur)) return;
    f32x4 acc[2][2][4][2];
#pragma unroll
    for (int a = 0; a < 2; ++a)
#pragma unroll
        for (int b = 0; b < 2; ++b)
#pragma unroll
            for (int m = 0; m < 4; ++m)
#pragma unroll
                for (int n = 0; n < 2; ++n) acc[a][b][m][n] = (f32x4){0.f, 0.f, 0.f, 0.f};
    bf16x8 At[4][2], B0[2][2], B1[2][2];
    const PG8_GAS char* cA = (const PG8_GAS char*)g.A + (size_t)cur.pm * tstep; const PG8_GAS char* cB = (const PG8_GAS char*)g.Bt + (size_t)cur.pn * tstep;
    S.a_ready(cur);
    if constexpr (SP2) {
        PG8_STAGE(PG8_SB(0, 0), cB, voffB); PG8_STAGE(PG8_SB(0, 1), cB + hstep, voffB); PG8_STAGE(PG8_SA(0, 0), cA, voffA); PG8_STAGE(PG8_SA(0, 1), cA + hstep, voffA);
        if (wr == 1) PG8_BAR;
        PG8_WAIT_V(2); PG8_BAR;
        PG8_STAGE(PG8_SB(1, 0), cB + kstep, voffB); PG8_STAGE(PG8_SA(1, 0), cA + kstep, voffA); PG8_STAGE(PG8_SB(1, 1), cB + hstep + kstep, voffB);
        PG8_WAIT_V(6); PG8_BAR;
    } else {
        PG8_STAGE(PG8_SB(0, 0), cB, voffB); PG8_STAGE(PG8_SA(0, 0), cA, voffA); PG8_STAGE(PG8_SB(0, 1), cB + hstep, voffB); PG8_STAGE(PG8_SA(0, 1), cA + hstep, voffA);
        if (wr == 1) PG8_BAR;
        PG8_WAIT_V(4); PG8_BAR;
        PG8_STAGE(PG8_SB(1, 0), cB + kstep, voffB); PG8_STAGE(PG8_SA(1, 0), cA + kstep, voffA); PG8_STAGE(PG8_SB(1, 1), cB + hstep + kstep, voffB);
        PG8_WAIT_V(6); PG8_BAR;
    }
    for (;;) {
        const bool has_next = S.next(ui + 1, nxt);
        const PG8_GAS char* nA = has_next ? (const PG8_GAS char*)g.A + (size_t)nxt.pm * tstep : cA; const PG8_GAS char* nB = has_next ? (const PG8_GAS char*)g.Bt + (size_t)nxt.pn * tstep : cB;
        for (int t = 0; t < nt; t += 2) {
            const bool last = (t == nt - 2);
            const PG8_GAS char* a1 = cA + (size_t)(t + 1) * kstep;
            const PG8_GAS char* a2 = last ? nA : cA + (size_t)(t + 2) * kstep; const PG8_GAS char* b2 = last ? nB : cB + (size_t)(t + 2) * kstep;
            const PG8_GAS char* a3 = a2 + kstep; const PG8_GAS char* b3 = b2 + kstep;
            if (last && has_next) S.a_ready(nxt);
            if constexpr (SP2) {
            PG8_LDB(B0, 0, 0); PG8_LDB(B1, 0, 1); PG8_SCHED; PG8_LDA(At, 0, 0); PG8_STAGE(PG8_SA(1, 1), a1 + hstep, voffA);
            PG8_WAIT_V(8); PG8_WAIT_L(0); PG8_BAR; PG8_MMA(0, 0, At, B0); PG8_MMA(0, 1, At, B1); PG8_BAR; PG8_SCHED;
            PG8_LDA(At, 0, 1); PG8_STAGE(PG8_SB(0, 0), b2, voffB); PG8_STAGE(PG8_SB(0, 1), b2 + hstep, voffB); PG8_STAGE(PG8_SA(0, 0), a2, voffA);
            PG8_WAIT_V(8); PG8_WAIT_L(0); PG8_BAR; PG8_MMA(1, 0, At, B0); PG8_MMA(1, 1, At, B1); PG8_BAR; PG8_SCHED;
            PG8_LDB(B0, 1, 0); PG8_LDB(B1, 1, 1); PG8_SCHED; PG8_LDA(At, 1, 0); PG8_STAGE(PG8_SA(0, 1), a2 + hstep, voffA);
            PG8_WAIT_V(8); PG8_WAIT_L(0); PG8_BAR; PG8_MMA(0, 0, At, B0); PG8_MMA(0, 1, At, B1); PG8_BAR; PG8_SCHED;
            PG8_LDA(At, 1, 1); PG8_STAGE(PG8_SB(1, 0), b3, voffB); PG8_STAGE(PG8_SB(1, 1), b3 + hstep, voffB); PG8_STAGE(PG8_SA(1, 0), a3, voffA);
            PG8_WAIT_V(8); PG8_WAIT_L(0); PG8_BAR; PG8_MMA(1, 0, At, B0); PG8_MMA(1, 1, At, B1); PG8_BAR; PG8_SCHED;
            } else {
            PG8_LDB(B0, 0, 0); PG8_SCHED; PG8_LDA(At, 0, 0); PG8_STAGE(PG8_SA(1, 1), a1 + hstep, voffA);
            PG8_WAIT_L(8); PG8_BAR; PG8_WAIT_L(0); PG8_MMA(0, 0, At, B0); PG8_BAR; PG8_SCHED;
            PG8_LDB(B1, 0, 1); PG8_STAGE(PG8_SB(0, 0), b2, voffB);
            PG8_BAR; PG8_WAIT_L(0); PG8_MMA(0, 1, At, B1); PG8_BAR;
            PG8_LDA(At, 0, 1); PG8_STAGE(PG8_SA(0, 0), a2, voffA);
            PG8_BAR; PG8_WAIT_L(0); PG8_MMA(1, 0, At, B0); PG8_BAR; PG8_SCHED;
            PG8_STAGE(PG8_SB(0, 1), b2 + hstep, voffB);
            PG8_WAIT_V(6); PG8_BAR; PG8_MMA(1, 1, At, B1); PG8_BAR;
            PG8_LDB(B0, 1, 0); PG8_SCHED; PG8_LDA(At, 1, 0); PG8_STAGE(PG8_SA(0, 1), a2 + hstep, voffA);
            PG8_WAIT_L(8); PG8_BAR; PG8_WAIT_L(0); PG8_MMA(0, 0, At, B0); PG8_BAR; PG8_SCHED;
            PG8_LDB(B1, 1, 1); PG8_STAGE(PG8_SB(1, 0), b3, voffB);
            PG8_BAR; PG8_WAIT_L(0); PG8_MMA(0, 1, At, B1); PG8_BAR;
            PG8_LDA(At, 1, 1); PG8_STAGE(PG8_SA(1, 0), a3, voffA);
            PG8_BAR; PG8_WAIT_L(0); PG8_MMA(1, 0, At, B0); PG8_BAR; PG8_SCHED;
            PG8_STAGE(PG8_SB(1, 1), b3 + hstep, voffB);
            PG8_WAIT_V(6); PG8_BAR; PG8_MMA(1, 1, At, B1); PG8_BAR;
            }
        }
        if constexpr (ALIGN_EPI) { if (wr == 0) PG8_BAR; }
        if constexpr (!Epi::AFTER_DRAIN) { E(acc, cur, wr, wc, fr, fq); S.done(cur); }
        if (!has_next) break;
#pragma unroll
        for (int a = 0; a < 2; ++a)
#pragma unroll
            for (int b = 0; b < 2; ++b)
#pragma unroll
                for (int m = 0; m < 4; ++m)
#pragma unroll
                    for (int n = 0; n < 2; ++n) acc[a][b][m][n] = (f32x4){0.f, 0.f, 0.f, 0.f};
        cur = nxt; cA = nA; cB = nB; ++ui;
        if constexpr (ALIGN_EPI) { if (wr == 1) PG8_BAR; }
    }
    PG8_WAIT_V(0);
    if constexpr (!ALIGN_EPI) { if (wr == 0) PG8_BAR; }
    PG8_BAR;
    if constexpr (Epi::AFTER_DRAIN) { E.fused(acc, cur, wr, wc, fr, fq, lds, wid, lane); S.done(cur); }
#undef PG8_SA
#undef PG8_SB
#undef PG8_STAGE
#undef PG8_LDA
#undef PG8_LDB
#undef PG8_MMA
#undef PG8_WAIT_V
#undef PG8_WAIT_L
#undef PG8_BAR
#undef PG8_SCHED
}
}
#define GAS __attribute__((address_space(1)))
#define LAS __attribute__((address_space(3)))
typedef unsigned short bf16;
typedef unsigned v4u __attribute__((ext_vector_type(4)));
typedef float f32x4 __attribute__((ext_vector_type(4)));
typedef short bf16x8 __attribute__((ext_vector_type(8)));
typedef GAS unsigned gu32;
typedef GAS unsigned long long gu64;
#define RLX_AGENT __ATOMIC_RELAXED, __HIP_MEMORY_SCOPE_AGENT
#define LDS_WAIT() asm volatile("s_waitcnt lgkmcnt(0)" ::: "memory")
#define VM_WAIT() asm volatile("s_waitcnt vmcnt(0)" ::: "memory")
__device__ __forceinline__ unsigned long long rt() { return __builtin_amdgcn_s_memrealtime(); }
__device__ __forceinline__ unsigned f2bf(float f) { unsigned u = __builtin_bit_cast(unsigned, f); return (u + 0x7fffu + ((u >> 16) & 1u)) >> 16; }
__device__ __forceinline__ unsigned pk2(float lo, float hi) { return f2bf(lo) | (f2bf(hi) << 16); }

#define XB_TMO      128
#define XB_XCNT(j)  (256  + 64 * (j))
#define XB_XSUB(j)  (1280 + 64 * (j))
#define XB_XGEN(j)  (2304 + 64 * (j))
#define XB_TOP      3328
#define XB_TOPGEN   3392
#define XCD_BAR_WORDS 3456
#define XB_SPIN_CAP (1u << 18)

__device__ __forceinline__ unsigned xb_ld(unsigned* p)              { return __hip_atomic_load(p, __ATOMIC_RELAXED, __HIP_MEMORY_SCOPE_AGENT); }
__device__ __forceinline__ unsigned xb_add(unsigned* p, unsigned v) { return __hip_atomic_fetch_add(p, v, __ATOMIC_RELAXED, __HIP_MEMORY_SCOPE_AGENT); }
__device__ __forceinline__ unsigned xb_xcc_id() { return (unsigned)__builtin_amdgcn_s_getreg((3 << 11) | 20) & 0xFu; }
#define XB_SPIN(cond, bar) do { unsigned _sp = 0; while (cond) { __builtin_amdgcn_s_sleep(1); \
    if ((++_sp & 255u) == 0u) { if (xb_ld(&(bar)[XB_TMO])) break; if (_sp > XB_SPIN_CAP) { atomicAdd(&(bar)[XB_TMO], 1u); break; } } } } while (0)

struct XcdBarrier {
    unsigned* bar; unsigned x;
    volatile LAS unsigned* st;
};

__device__ __forceinline__ XcdBarrier xcd_barrier_post(unsigned* bar, volatile LAS unsigned* st, const int tid) {
    XcdBarrier b; b.bar = bar; b.x = xb_xcc_id(); b.st = st;
    if (tid == 0) (void)xb_add(&bar[XB_XCNT(b.x)], 1u);
    return b;
}
__device__ __forceinline__ void xcd_barrier_complete(unsigned* bar, unsigned x, unsigned& nloc, unsigned& nx) {
    const unsigned G = gridDim.x * gridDim.y * gridDim.z;
    unsigned sum, cnt, mine, sp = 0u;
    for (;;) {
        sum = 0u; cnt = 0u; mine = 0u;
#pragma unroll
        for (unsigned j = 0; j < 16; ++j) { const unsigned c = xb_ld(&bar[XB_XCNT(j)]); sum += c; cnt += (c > 0u) ? 1u : 0u; mine = (j == x) ? c : mine; }
        if (sum == G) break;
        __builtin_amdgcn_s_sleep(1);
        if ((++sp & 255u) == 0u) { if (xb_ld(&bar[XB_TMO])) break; if (sp > XB_SPIN_CAP) { atomicAdd(&bar[XB_TMO], 1u); break; } }
    }
    nloc = mine > 0u ? mine : 1u; nx = cnt > 0u ? cnt : 1u;
}

__device__ __forceinline__ void xcd_barrier(const XcdBarrier& b, const int tid) {
    asm volatile("s_waitcnt vmcnt(0)" ::: "memory");
    __syncthreads();
    if (tid == 0) {
        unsigned* bar = b.bar;
        __builtin_amdgcn_s_waitcnt(0);
        unsigned nloc = b.st[0], nx = b.st[1];
        if (nloc == 0u) { xcd_barrier_complete(bar, b.x, nloc, nx); b.st[0] = nloc; b.st[1] = nx; }
        const unsigned old = xb_add(&bar[XB_XSUB(b.x)], 1u);
        const unsigned gen = old / nloc;
        if (old + 1u == (gen + 1u) * nloc) {
            __builtin_amdgcn_fence(__ATOMIC_RELEASE, "agent");
            asm volatile("s_waitcnt vmcnt(0)" ::: "memory");
            const unsigned og = xb_add(&bar[XB_TOP], 1u);
            const unsigned tg = og / nx;
            if (og + 1u == (tg + 1u) * nx) xb_add(&bar[XB_TOPGEN], 1u);
            else XB_SPIN(xb_ld(&bar[XB_TOPGEN]) == tg, bar);
            __builtin_amdgcn_fence(__ATOMIC_ACQUIRE, "agent");
            xb_add(&bar[XB_XGEN(b.x)], 1u);
            asm volatile("s_waitcnt vmcnt(0)" ::: "memory");
        } else {
            XB_SPIN(xb_ld(&bar[XB_XGEN(b.x)]) == gen, bar);
            __builtin_amdgcn_fence(__ATOMIC_ACQUIRE, "agent");
            asm volatile("s_waitcnt vmcnt(0)" ::: "memory");
        }
    }
    __syncthreads();
}
constexpr int BATCH = 2, SEQ = 4096, DM = 2048, DEPTH = 4, MTOK = BATCH * SEQ;
constexpr int HD = 64, RH = 12, AH = 12, GGRP = 8, RWID = 768, AWID = 768, GWID = 512;
constexpr int RCOLS = 2560, ACOLS = 2304, GCOLS = 1024, INCOLS = 5888, DFF = 5632, UPN = 2 * DFF;
constexpr int QOFF = RCOLS, KOFF = RCOLS + AWID, VOFF = RCOLS + 2 * AWID, GOFF = RCOLS + ACOLS;
constexpr int TCH = 64, NCH = SEQ / TCH;
constexpr int NTASK_SCAN = BATCH * RH * NCH;
constexpr float NORM_EPS = 1e-6f, GN_EPS = 1e-5f, RWKV_LN_EPS = 64e-5f;
constexpr float DECAY_SCALE = 0.6065306597126334f;
constexpr int NWAVES = 8, NTHR = NWAVES * 64;

constexpr size_t MiB = 1u << 20;
constexpr size_t WS_CTL = 0, CTL_ZERO_BYTES = 1 * MiB;
constexpr size_t WS_WIN = 2 * MiB, WS_WOUT = 94 * MiB, WS_WUP = 126 * MiB, WS_WDN = 302 * MiB;
constexpr size_t WS_HN = 390 * MiB, WS_Y = 422 * MiB, WS_O = 454 * MiB;
constexpr size_t WS_REG = 518 * MiB;
constexpr size_t WS_PROJ = WS_REG;
constexpr size_t WS_RW = WS_REG + 92 * MiB;
constexpr size_t WS_CHK = WS_RW + 216 * MiB;
constexpr size_t WS_QKR = WS_CHK + 72 * MiB;
constexpr size_t WS_AO = WS_QKR + 24 * MiB;
constexpr size_t WS_LSE = WS_AO + 72 * MiB;
constexpr size_t WS_SGU = WS_LSE + 2 * MiB;
constexpr size_t WS_BON = WS_SGU + 32 * MiB;
constexpr size_t WS_LORA = WS_BON + 1 * MiB;
constexpr size_t WS_SGW = WS_LORA + 2 * MiB;
constexpr size_t WS_SSQ = WS_SGW + 1 * MiB;
constexpr size_t WS_HALO = WS_SSQ + 1 * MiB;
constexpr size_t WS_RAW01 = WS_HALO + 3 * MiB;
constexpr size_t WS_ROPE = WS_RAW01 + 3 * MiB;
constexpr size_t WS_END_MIX = WS_ROPE + 1 * MiB;
constexpr size_t WS_UP = WS_REG;
constexpr size_t WS_H = WS_REG + 176 * MiB;
constexpr size_t WS_END = WS_END_MIX;
static_assert(WS_H + 88 * MiB <= WS_END, "map");
constexpr int LORA_L = RWID * 256;
constexpr int CW_BAR = 4096, CW_ATT = 8192;

constexpr int RING_BYTES = 131072, LDSCTL_OFF = RING_BYTES, MISC_OFF = LDSCTL_OFF + 320, LDS_BYTES = 147456;

struct Params { const float* in[29]; float* out; unsigned char* ws; };

typedef const GAS float* gcf; typedef GAS float* gfp; typedef const GAS bf16* gcb; typedef GAS bf16* gbp; typedef const GAS int* gci;
__device__ __forceinline__ float bf2f(unsigned short u) { return __builtin_bit_cast(float, (unsigned)u << 16); }
__device__ __forceinline__ float bflo(unsigned u) { return __builtin_bit_cast(float, u << 16); }
__device__ __forceinline__ float bfhi(unsigned u) { return __builtin_bit_cast(float, u & 0xffff0000u); }
__device__ __forceinline__ float wave_sum(float v) {
#pragma unroll
    for (int o = 1; o < 64; o <<= 1) v += __shfl_xor(v, o);
    return v;
}
__device__ __forceinline__ float wave_max(float v) {
#pragma unroll
    for (int o = 1; o < 64; o <<= 1) v = fmaxf(v, __shfl_xor(v, o));
    return v;
}
__device__ __forceinline__ float sigmoidf_(float x) { return 1.f / (1.f + __expf(-x)); }
__device__ __forceinline__ float gelu_tanh(float x) { const float u = 0.7978845608028654f * (x + 0.044715f * x * x * x); return 0.5f * x * (1.f + tanhf(u)); }

typedef float f32x16 __attribute__((ext_vector_type(16)));
typedef float f32x2_t __attribute__((ext_vector_type(2))); typedef __bf16 bf16x2_t __attribute__((ext_vector_type(2)));
typedef short s16x4 __attribute__((ext_vector_type(4)));
__device__ __forceinline__ unsigned cvtpk(float lo, float hi) { f32x2_t v = {lo, hi}; bf16x2_t b = __builtin_convertvector(v, bf16x2_t); return __builtin_bit_cast(unsigned, b); }
__device__ __forceinline__ bf16x8 pack8(float a0, float a1, float a2, float a3, float a4, float a5, float a6, float a7) { v4u p; p.x = cvtpk(a0, a1); p.y = cvtpk(a2, a3); p.z = cvtpk(a4, a5); p.w = cvtpk(a6, a7); return __builtin_bit_cast(bf16x8, p); }
#define MFMA16(a, b, c) __builtin_amdgcn_mfma_f32_16x16x32_bf16((a), (b), (c), 0, 0, 0)
#define MFMA32(a, b, c) __builtin_amdgcn_mfma_f32_32x32x16_bf16((a), (b), (c), 0, 0, 0)
__device__ __forceinline__ int crow(int reg, int h) { return (reg & 3) + 8 * (reg >> 2) + 4 * h; }

__device__ __forceinline__ void p0_transpose_item(gcf W, int K, int N, gbp WT, int row_off, LAS float* scr, int item, int lane) {
    const int nblk = N / 32, kb = item / nblk, nb = item % nblk, k0 = 64 * kb, n0 = 32 * nb;
    const int rb = row_off >= 0 ? row_off + n0 : (n0 < DFF ? (n0 / 128) * 256 + (n0 % 128) : ((n0 - DFF) / 128) * 256 + 128 + ((n0 - DFF) % 128));
#pragma unroll 8
    for (int i = 0; i < 32; ++i) { const int kk = 2 * i + (lane >> 5); scr[kk * 33 + (lane & 31)] = W[(size_t)(k0 + kk) * N + n0 + (lane & 31)]; }
    LDS_WAIT(); asm volatile("" ::: "memory");
    const int c = lane & 7;
#pragma unroll
    for (int j = 0; j < 4; ++j) { const int n = (lane >> 3) + 8 * j; const LAS float* s = scr + (8 * c) * 33 + n;
        v4u o; o.x = pk2(s[0 * 33], s[1 * 33]); o.y = pk2(s[2 * 33], s[3 * 33]); o.z = pk2(s[4 * 33], s[5 * 33]); o.w = pk2(s[6 * 33], s[7 * 33]);
        *(GAS v4u*)(WT + (size_t)(rb + n) * K + k0 + 8 * c) = o; }
    LDS_WAIT(); asm volatile("" ::: "memory");
}

__device__ __forceinline__ void rowpass(gcf xin, gcf delta, gcf gpost, gfp xout, gcf gnext, gbp hn, int gw, int ngw, int lane) {
    for (int m = gw; m < MTOK; m += ngw) {
        const GAS f32x4* xr = (const GAS f32x4*)(xin + (size_t)m * DM) + lane;
        f32x4 xv[8];
#pragma unroll
        for (int j = 0; j < 8; ++j) xv[j] = xr[64 * j];
        if (delta) {
            const GAS f32x4* dr = (const GAS f32x4*)(delta + (size_t)m * DM) + lane;
            f32x4 dv[8]; float ss = 0.f;
#pragma unroll
            for (int j = 0; j < 8; ++j) { dv[j] = dr[64 * j]; ss += dv[j].x * dv[j].x + dv[j].y * dv[j].y + dv[j].z * dv[j].z + dv[j].w * dv[j].w; }
            const float rstd = rsqrtf(wave_sum(ss) * (1.f / DM) + NORM_EPS);
            GAS f32x4* xo = (GAS f32x4*)(xout + (size_t)m * DM) + lane;
#pragma unroll
            for (int j = 0; j < 8; ++j) { const f32x4 g = ((const GAS f32x4*)gpost)[lane + 64 * j]; xv[j] = xv[j] + dv[j] * rstd * g; xo[64 * j] = xv[j]; }
        }
        if (gnext) {
            float ss = 0.f;
#pragma unroll
            for (int j = 0; j < 8; ++j) ss += xv[j].x * xv[j].x + xv[j].y * xv[j].y + xv[j].z * xv[j].z + xv[j].w * xv[j].w;
            const float rstd = rsqrtf(wave_sum(ss) * (1.f / DM) + NORM_EPS);
            GAS unsigned long long* o8 = (GAS unsigned long long*)(hn + (size_t)m * DM) + lane;
#pragma unroll
            for (int j = 0; j < 8; ++j) { const f32x4 g = ((const GAS f32x4*)gnext)[lane + 64 * j]; const f32x4 v = xv[j] * rstd * g;
                o8[64 * j] = (unsigned long long)pk2(v.x, v.y) | ((unsigned long long)pk2(v.z, v.w) << 32); }
        }
    }
}

constexpr int LIN_ROW = 264;
struct RPW { gcf mu, w0, a0, kk_, ka_, rk; gcb w2t, a2t, g2t; };
__device__ __forceinline__ f32x4 ld4bf(gcb p) { const unsigned long long u = *(const GAS unsigned long long*)p; const unsigned lo = (unsigned)u, hi = (unsigned)(u >> 32); return (f32x4){bflo(lo), bfhi(lo), bflo(hi), bfhi(hi)}; }
__device__ __forceinline__ void rwkv_prep_unit(int unit, gcb PROJ, const RPW& w, gfp RWb, gfp BON, LAS unsigned char* lds, int tid, int wave, int lane) {
    constexpr size_t AS = (size_t)MTOK * RWID;
    gfp R = RWb; gfp Wd = RWb + AS; gfp K2 = RWb + 2 * AS; gfp V = RWb + 3 * AS; gfp KK = RWb + 4 * AS; gfp KKA = RWb + 5 * AS; gfp Gt = RWb + 6 * AS;
    const int tok0 = unit * 32;
    LAS bf16* lin = (LAS bf16*)lds;
    {
        const int tk = tid >> 4, c0 = (tid & 15) * 16, tokA = tok0 + tk, tA = tokA % SEQ;
        gcb pr = PROJ + (size_t)tokA * INCOLS + 2304 + c0;
        unsigned ob[8];
#pragma unroll
        for (int q4 = 0; q4 < 4; ++q4) { const f32x4 cu = ld4bf(pr + 4 * q4); f32x4 pv = {0.f, 0.f, 0.f, 0.f}; if (tA > 0) pv = ld4bf(pr + 4 * q4 - INCOLS);
            const f32x4 mu = *(const GAS f32x4*)(w.mu + 2304 + c0 + 4 * q4); f32x4 x = cu + (pv - cu) * mu;
#pragma unroll
            for (int e = 0; e < 4; ++e) { const int c = c0 + 4 * q4 + e; x[e] = c < 64 ? tanhf(x[e]) : (c < 128 ? x[e] : sigmoidf_(x[e])); }
            ob[2 * q4] = pk2(x[0], x[1]); ob[2 * q4 + 1] = pk2(x[2], x[3]); }
        LAS v4u* dst = (LAS v4u*)(lin + tk * LIN_ROW + c0);
        dst[0] = (v4u){ob[0], ob[1], ob[2], ob[3]}; dst[1] = (v4u){ob[4], ob[5], ob[6], ob[7]};
    }
    __syncthreads();
    const int tt = wave & 1, hq = wave >> 1, tl = lane & 15, g = lane >> 4;
    const int tok = tok0 + 16 * tt + tl, t = tok % SEQ;
    bf16x8 bfr[8];
#pragma unroll
    for (int ks = 0; ks < 8; ++ks) bfr[ks] = *(const LAS bf16x8*)(lin + (16 * tt + tl) * LIN_ROW + 32 * ks + 8 * g);
    gcb prow = PROJ + (size_t)tok * INCOLS;
    for (int hi = 0; hi < 3; ++hi) { const int h = hq + 4 * hi;
        f32x4 kr[4], aa[4]; float ss = 0.f, bon = 0.f;
#pragma unroll
        for (int nt = 0; nt < 4; ++nt) { const int n0 = h * 64 + 16 * nt;
            f32x4 cw = {0.f, 0.f, 0.f, 0.f}, ca = cw, cg = cw;
#pragma unroll
            for (int ks = 0; ks < 2; ++ks) { cw = MFMA16(*(const GAS bf16x8*)(w.w2t + (n0 + tl) * 64 + 32 * ks + 8 * g), bfr[ks], cw);
                                             ca = MFMA16(*(const GAS bf16x8*)(w.a2t + (n0 + tl) * 64 + 32 * ks + 8 * g), bfr[2 + ks], ca); }
#pragma unroll
            for (int ks = 0; ks < 4; ++ks) cg = MFMA16(*(const GAS bf16x8*)(w.g2t + (n0 + tl) * 128 + 32 * ks + 8 * g), bfr[4 + ks], cg);
            const int c = n0 + 4 * g;
            const f32x4 pr_ = ld4bf(prow + c), pk_ = ld4bf(prow + 768 + c), pv_ = ld4bf(prow + 1536 + c);
            f32x4 qr_ = {0.f, 0.f, 0.f, 0.f}, qk_ = qr_, qv_ = qr_;
            if (t > 0) { qr_ = ld4bf(prow - INCOLS + c); qk_ = ld4bf(prow - INCOLS + 768 + c); qv_ = ld4bf(prow - INCOLS + 1536 + c); }
            const f32x4 r4 = pr_ + (qr_ - pr_) * *(const GAS f32x4*)(w.mu + c), k4 = pk_ + (qk_ - pk_) * *(const GAS f32x4*)(w.mu + 768 + c), v4 = pv_ + (qv_ - pv_) * *(const GAS f32x4*)(w.mu + 1536 + c);
            const f32x4 w04 = *(const GAS f32x4*)(w.w0 + c), a04 = *(const GAS f32x4*)(w.a0 + c), kk4 = *(const GAS f32x4*)(w.kk_ + c), ka4 = *(const GAS f32x4*)(w.ka_ + c), rk4 = *(const GAS f32x4*)(w.rk + c);
            f32x4 dec, a_;
#pragma unroll
            for (int e = 0; e < 4; ++e) { dec[e] = __expf(-DECAY_SCALE * sigmoidf_(w04[e] + cw[e])); a_[e] = sigmoidf_(a04[e] + ca[e]); }
            const f32x4 kkr = k4 * kk4, k2 = k4 * (1.f + (a_ - 1.f) * ka4);
            ss += kkr[0] * kkr[0] + kkr[1] * kkr[1] + kkr[2] * kkr[2] + kkr[3] * kkr[3];
            const f32x4 bb = r4 * k2 * rk4; bon += bb[0] + bb[1] + bb[2] + bb[3];
            { const size_t o = (size_t)tok * RWID + c; *(GAS f32x4*)(R + o) = r4; *(GAS f32x4*)(Wd + o) = dec; *(GAS f32x4*)(K2 + o) = k2; *(GAS f32x4*)(V + o) = v4; *(GAS f32x4*)(Gt + o) = cg; }
            kr[nt] = kkr; aa[nt] = a_; }
        ss += __shfl_xor(ss, 16); ss += __shfl_xor(ss, 32); bon += __shfl_xor(bon, 16); bon += __shfl_xor(bon, 32);
        const float rn = 1.f / fmaxf(sqrtf(ss), 1e-12f);
#pragma unroll
        for (int nt = 0; nt < 4; ++nt) { const size_t o = (size_t)tok * RWID + h * 64 + 16 * nt + 4 * g; const f32x4 kk = kr[nt] * rn;
            *(GAS f32x4*)(KK + o) = kk; *(GAS f32x4*)(KKA + o) = kk * aa[nt]; }
        if (g == 0) BON[tok * 12 + h] = bon; }
    __syncthreads();
}

typedef float f32x2 __attribute__((ext_vector_type(2)));
#define SCHED_FENCE() __builtin_amdgcn_sched_barrier(0)
__device__ __forceinline__ void scan_step(f32x2 (&st)[64], const LAS f32x4* o4, float vcur, float& yo, float& zo) {
    f32x2 sk = {0.f, 0.f};
    f32x4 qa[2][2];
    qa[0][0] = o4[16]; qa[0][1] = o4[17];
#pragma unroll
    for (int g = 0; g < 8; ++g) {
        if (g < 7) { qa[(g + 1) & 1][0] = o4[16 + 2 * (g + 1)]; qa[(g + 1) & 1][1] = o4[17 + 2 * (g + 1)]; }
        SCHED_FENCE();
#pragma unroll
        for (int e = 0; e < 2; ++e) { const f32x4 q = qa[g & 1][e]; const int k = 8 * g + 4 * e;
            sk += st[k] * q.x; sk += st[k + 1] * q.y; sk += st[k + 2] * q.z; sk += st[k + 3] * q.w; }
        SCHED_FENCE();
    }
    const f32x2 vk = {vcur, 0.f};
    f32x2 y = {0.f, 0.f};
    f32x4 ob[2][4];
    ob[0][0] = o4[0]; ob[0][1] = o4[32]; ob[0][2] = o4[48]; ob[0][3] = o4[64];
#pragma unroll
    for (int k4 = 0; k4 < 16; ++k4) {
        if (k4 < 15) { ob[(k4 + 1) & 1][0] = o4[k4 + 1]; ob[(k4 + 1) & 1][1] = o4[33 + k4]; ob[(k4 + 1) & 1][2] = o4[49 + k4]; ob[(k4 + 1) & 1][3] = o4[65 + k4]; }
        SCHED_FENCE();
        { const f32x4 w4 = ob[k4 & 1][0], a4 = ob[k4 & 1][1], kv = ob[k4 & 1][2], r4 = ob[k4 & 1][3];
#pragma unroll
          for (int j = 0; j < 4; ++j) { const int k = 4 * k4 + j; st[k] = st[k] * w4[j] - sk * a4[j] + vk * kv[j]; y += st[k] * r4[j]; } }
        SCHED_FENCE();
    }
    yo = y.x; zo = y.y;
}
__device__ __forceinline__ void scan_chunk(int task, gcf RWb, gfp YL, gfp Z, gbp PT, gbp SLT, LAS float* ops, int lane) {
    constexpr unsigned AS = (unsigned)MTOK * RWID;
    gcf R = RWb; gcf Wd = RWb + AS; gcf K2 = RWb + 2 * AS; gcf V = RWb + 3 * AS; gcf KK = RWb + 4 * AS; gcf KKA = RWb + 5 * AS;
    const int bh = task / NCH, c = task % NCH, b = bh / RH, h = bh % RH;
    const unsigned base = (unsigned)((b * SEQ + c * TCH) * RWID + h * 64 + lane);
    f32x2 st[64];
    int lane_o = lane; asm volatile("" : "+v"(lane_o));
#pragma unroll
    for (int k = 0; k < 64; ++k) st[k] = (f32x2){0.f, (k == lane_o) ? 1.f : 0.f};
    LAS float* b0 = ops; LAS float* b1 = ops + 320;
    float ew = Wd[base], ekk = KK[base], eka = KKA[base], ek = K2[base], er = R[base], ev = V[base];
    float ow = Wd[base + RWID], okk = KK[base + RWID], oka = KKA[base + RWID], ok = K2[base + RWID], orr = R[base + RWID], ov = V[base + RWID];
    b0[lane] = ew; b0[64 + lane] = ekk; b0[128 + lane] = eka; b0[192 + lane] = ek; b0[256 + lane] = er;
    for (int i = 0; i < TCH; i += 2) {
        const float v0 = ev; float y, z;
        if (i + 2 < TCH) { const unsigned o = base + (unsigned)(i + 2) * RWID; ew = Wd[o]; ekk = KK[o]; eka = KKA[o]; ek = K2[o]; er = R[o]; ev = V[o]; }
        scan_step(st, (const LAS f32x4*)b0, v0, y, z);
        { const unsigned o = base + (unsigned)i * RWID; YL[o] = y; Z[o] = z; }
        b1[lane] = ow; b1[64 + lane] = okk; b1[128 + lane] = oka; b1[192 + lane] = ok; b1[256 + lane] = orr;
        const float v1 = ov;
        if (i + 3 < TCH) { const unsigned o = base + (unsigned)(i + 3) * RWID; ow = Wd[o]; okk = KK[o]; oka = KKA[o]; ok = K2[o]; orr = R[o]; ov = V[o]; }
        scan_step(st, (const LAS f32x4*)b1, v1, y, z);
        { const unsigned o = base + (unsigned)(i + 1) * RWID; YL[o] = y; Z[o] = z; }
        b0[lane] = ew; b0[64 + lane] = ekk; b0[128 + lane] = eka; b0[192 + lane] = ek; b0[256 + lane] = er;
    }
    gbp pm = PT + (unsigned)(task * 4096 + lane); gbp sl = SLT + (unsigned)(task * 4096 + lane);
#pragma unroll
    for (int k = 0; k < 64; ++k) { pm[k * 64] = (bf16)f2bf(st[k].y); sl[k * 64] = (bf16)f2bf(st[k].x); }
}

constexpr int S2_SLOT = 16384, S2_NSLOT = 7, S2_DEPTH = S2_NSLOT - 1, S2_NL = NCH - 1;
__device__ __forceinline__ void s2_issue(int task, gcb PT, gcb SL16, LAS unsigned char* slot, int lw, int lane) {
#pragma unroll
    for (int jj = 0; jj < 4; ++jj) { const int j = 4 * lw + jj;
        gcb src = (lw < 2) ? PT + (unsigned)(task * 4096 + (8 * j + (lane >> 3)) * 64 + (((lane & 7) ^ ((lane >> 3) & 7)) << 3))
                           : SL16 + (unsigned)(task * 4096 + (j - 8) * 512 + lane * 8);
        __builtin_amdgcn_global_load_lds((const GAS unsigned*)src, (LAS unsigned*)(slot + j * 1024), 16, 0, 0); }
}
__device__ __forceinline__ void scan_carry_ring(int bh, gcb PT, gcb SL16, gfp SST, LAS unsigned char* lds, int wave, int lane) {
    if (wave >= 4) {
        const int lw = wave - 4;
        for (int cc = 0; cc < S2_DEPTH; ++cc) s2_issue(bh * NCH + cc, PT, SL16, lds + (cc % S2_NSLOT) * S2_SLOT, lw, lane);
        for (int c = 0; c < S2_NL; ++c) {
            if (c + S2_DEPTH <= S2_NL) asm volatile("s_waitcnt vmcnt(20)" ::: "memory"); else asm volatile("s_waitcnt vmcnt(0)" ::: "memory");
            __builtin_amdgcn_s_barrier();
            if (c + S2_DEPTH < S2_NL) s2_issue(bh * NCH + c + S2_DEPTH, PT, SL16, lds + ((c + S2_DEPTH) % S2_NSLOT) * S2_SLOT, lw, lane);
        }
    } else if (wave < 2) {
        const int r = lane & 31, h = lane >> 5, vt = wave;
        f32x16 acc[2];
#pragma unroll
        for (int i = 0; i < 16; ++i) { acc[0][i] = 0.f; acc[1][i] = 0.f; }
        for (int c = 0; c < NCH; ++c) {
            const unsigned tb = (unsigned)(bh * NCH + c) * 4096u;
#pragma unroll
            for (int mt = 0; mt < 2; ++mt)
#pragma unroll
                for (int g = 0; g < 4; ++g) { const f32x4 v = {acc[mt][4 * g], acc[mt][4 * g + 1], acc[mt][4 * g + 2], acc[mt][4 * g + 3]};
                    *(GAS f32x4*)(SST + tb + (unsigned)((32 * vt + r) * 64 + 32 * mt + 8 * g + 4 * h)) = v; }
            if (c == NCH - 1) break;
            __builtin_amdgcn_s_barrier();
            const LAS unsigned char* sb = lds + (c % S2_NSLOT) * S2_SLOT;
            bf16x8 bfr[2][2];
#pragma unroll
            for (int kt = 0; kt < 2; ++kt)
#pragma unroll
                for (int sx = 0; sx < 2; ++sx) bfr[kt][sx] = pack8(acc[kt][8 * sx], acc[kt][8 * sx + 1], acc[kt][8 * sx + 2], acc[kt][8 * sx + 3], acc[kt][8 * sx + 4], acc[kt][8 * sx + 5], acc[kt][8 * sx + 6], acc[kt][8 * sx + 7]);
#pragma unroll
            for (int mt = 0; mt < 2; ++mt) {
#pragma unroll
                for (int i = 0; i < 16; ++i) acc[mt][i] = bf2f(*(const LAS unsigned short*)(sb + 8192 + (32 * mt + crow(i, h)) * 128 + (32 * vt + r) * 2));
                const int row = 32 * mt + r; const LAS unsigned char* rp = sb + row * 128 + 8 * h;
#pragma unroll
                for (int kt = 0; kt < 2; ++kt)
#pragma unroll
                    for (int sx = 0; sx < 2; ++sx) { const int q = 4 * kt + 2 * sx;
                        const s16x4 lo = *(const LAS s16x4*)(rp + ((q ^ (row & 7)) << 4)), hi = *(const LAS s16x4*)(rp + (((q + 1) ^ (row & 7)) << 4));
                        acc[mt] = MFMA32(__builtin_shufflevector(lo, hi, 0, 1, 2, 3, 4, 5, 6, 7), bfr[kt][sx], acc[mt]); } }
            asm volatile("s_waitcnt lgkmcnt(0)" ::: "memory");
        }
    } else { for (int c = 0; c < S2_NL; ++c) __builtin_amdgcn_s_barrier(); }
}

__device__ __forceinline__ void scan_out_mfma(int wtask, gcf RWb, gcf YL, gcf Z, gcf SST, gcf BON, gcf ln_g, gcf ln_b, gbp Y, int lane) {
    constexpr unsigned AS = (unsigned)MTOK * RWID;
    gcf V = RWb + 3 * AS; gcf Gt = RWb + 6 * AS;
    const int task = wtask >> 1, th = wtask & 1, bh = task / NCH, c = task % NCH, b = bh / RH, h = bh % RH;
    const int r = lane & 31, hh = lane >> 5;
    const int tok = b * SEQ + c * TCH + 32 * th + r;
    const unsigned ob = (unsigned)(tok * RWID + h * 64);
    bf16x8 zf[4];
#pragma unroll
    for (int ks = 0; ks < 4; ++ks) { const f32x4 a = *(const GAS f32x4*)(Z + ob + 16 * ks + 8 * hh), bq = *(const GAS f32x4*)(Z + ob + 16 * ks + 8 * hh + 4); zf[ks] = pack8(a[0], a[1], a[2], a[3], bq[0], bq[1], bq[2], bq[3]); }
    f32x16 acc[2];
#pragma unroll
    for (int mt = 0; mt < 2; ++mt) {
#pragma unroll
        for (int g = 0; g < 4; ++g) { const f32x4 yv = *(const GAS f32x4*)(YL + ob + 32 * mt + 8 * g + 4 * hh); acc[mt][4 * g] = yv[0]; acc[mt][4 * g + 1] = yv[1]; acc[mt][4 * g + 2] = yv[2]; acc[mt][4 * g + 3] = yv[3]; }
#pragma unroll
        for (int ks = 0; ks < 4; ++ks) { gcf sp = SST + (unsigned)(task * 4096 + (32 * mt + r) * 64 + 16 * ks + 8 * hh); const f32x4 a = *(const GAS f32x4*)sp, bq = *(const GAS f32x4*)(sp + 4);
            acc[mt] = MFMA32(pack8(a[0], a[1], a[2], a[3], bq[0], bq[1], bq[2], bq[3]), zf[ks], acc[mt]); } }
    float s1 = 0.f;
#pragma unroll
    for (int i = 0; i < 16; ++i) s1 += acc[0][i] + acc[1][i];
    s1 += __shfl_xor(s1, 32);
    const float mu = s1 * (1.f / 64.f);
    float s2 = 0.f;
#pragma unroll
    for (int i = 0; i < 16; ++i) { const float d0 = acc[0][i] - mu, d1 = acc[1][i] - mu; s2 += d0 * d0 + d1 * d1; }
    s2 += __shfl_xor(s2, 32);
    const float rstd = rsqrtf(s2 * (1.f / 64.f) + RWKV_LN_EPS), bon = BON[tok * 12 + h];
#pragma unroll
    for (int mt = 0; mt < 2; ++mt)
#pragma unroll
        for (int g = 0; g < 4; ++g) { const int vv = 32 * mt + 8 * g + 4 * hh;
            const f32x4 lg = *(const GAS f32x4*)(ln_g + h * 64 + vv), lb = *(const GAS f32x4*)(ln_b + h * 64 + vv), v4 = *(const GAS f32x4*)(V + ob + vv), g4 = *(const GAS f32x4*)(Gt + ob + vv);
            f32x4 o;
#pragma unroll
            for (int e = 0; e < 4; ++e) o[e] = ((acc[mt][4 * g + e] - mu) * rstd * lg[e] + lb[e] + bon * v4[e]) * g4[e];
            *(GAS unsigned long long*)(Y + (size_t)tok * DM + h * 64 + vv) = (unsigned long long)pk2(o[0], o[1]) | ((unsigned long long)pk2(o[2], o[3]) << 32); }
}

constexpr int ATT_UNITS_PER_BH = 48, ATT_UNITS = BATCH * AH * ATT_UNITS_PER_BH, ATT_KROW = 144, ATT_VROW = 776, ATT_VOFF = 384 * ATT_KROW;
__device__ __forceinline__ void attn_unit(int unit, gcb PROJ, gfp AOP, gfp LSE, LAS unsigned char* lds, int tid, int wave, int lane) {
    const int bh = unit / ATT_UNITS_PER_BH, uu = unit % ATT_UNITS_PER_BH, b = bh / AH, h = bh % AH;
    int p, d, rho, qb;
    if (uu < 16) { p = 0; d = 1; rho = 0; qb = uu; } else if (uu < 32) { p = 1; d = 4; rho = (uu - 16) >> 2; qb = (uu - 16) & 3; } else { p = 2; d = 16; rho = uu - 32; qb = 0; }
    const int i0 = qb * 256;
    LAS unsigned char* Kl = lds; LAS unsigned char* Vl = lds + ATT_VOFF;
#pragma unroll
    for (int it = 0; it < 6; ++it) { const int idx = tid + 512 * it, key = idx % 384, piece = idx / 384; const int ki = i0 - 128 + key;
        v4u kv = {0u, 0u, 0u, 0u}, vv = {0u, 0u, 0u, 0u};
        if (ki >= 0) { const unsigned tokk = (unsigned)(b * SEQ + rho + d * ki);
            kv = *(const GAS v4u*)(PROJ + (size_t)tokk * INCOLS + KOFF + h * 64 + piece * 8);
            vv = *(const GAS v4u*)(PROJ + (size_t)tokk * INCOLS + VOFF + h * 64 + piece * 8); }
        *(LAS v4u*)(Kl + key * ATT_KROW + piece * 16) = kv;
        LAS unsigned short* vd = (LAS unsigned short*)(Vl + (piece * 8) * ATT_VROW + key * 2);
        vd[0 * (ATT_VROW / 2)] = (unsigned short)(vv.x & 0xffffu); vd[1 * (ATT_VROW / 2)] = (unsigned short)(vv.x >> 16);
        vd[2 * (ATT_VROW / 2)] = (unsigned short)(vv.y & 0xffffu); vd[3 * (ATT_VROW / 2)] = (unsigned short)(vv.y >> 16);
        vd[4 * (ATT_VROW / 2)] = (unsigned short)(vv.z & 0xffffu); vd[5 * (ATT_VROW / 2)] = (unsigned short)(vv.z >> 16);
        vd[6 * (ATT_VROW / 2)] = (unsigned short)(vv.w & 0xffffu); vd[7 * (ATT_VROW / 2)] = (unsigned short)(vv.w >> 16); }
    __syncthreads();
    const int r = lane & 31, hh = lane >> 5;
    const int iq0 = i0 + 32 * wave;
    const unsigned tokq = (unsigned)(b * SEQ + rho + d * (iq0 + r));
    bf16x8 qf[4];
#pragma unroll
    for (int sx = 0; sx < 4; ++sx) qf[sx] = *(const GAS bf16x8*)(PROJ + (size_t)tokq * INCOLS + QOFF + h * 64 + 16 * sx + 8 * hh);
    float m = -1e30f, l = 0.f;
    f32x16 o[2];
#pragma unroll
    for (int i = 0; i < 16; ++i) { o[0][i] = 0.f; o[1][i] = 0.f; }
#pragma unroll
    for (int j = 0; j < 5; ++j) {
        const int kk0 = 32 * wave + 32 * j, kabs0 = iq0 - 128 + 32 * j;
        if (kabs0 + 31 < 0) continue;
        f32x16 st;
#pragma unroll
        for (int i = 0; i < 16; ++i) st[i] = 0.f;
#pragma unroll
        for (int sx = 0; sx < 4; ++sx) { const bf16x8 a = *(const LAS bf16x8*)(Kl + (kk0 + r) * ATT_KROW + (16 * sx + 8 * hh) * 2); st = MFMA32(a, qf[sx], st); }
        bool ok[16]; float tmax = -1e30f;
#pragma unroll
        for (int i = 0; i < 16; ++i) { const int row = crow(i, hh); ok[i] = (kabs0 + row >= 0) && (j != 0 || row >= r) && (j != 4 || row <= r); tmax = fmaxf(tmax, ok[i] ? st[i] : -1e30f); }
        tmax = fmaxf(tmax, __shfl_xor(tmax, 32));
        const float mnew = fmaxf(m, tmax), alpha = exp2f(m - mnew);
        float pr[16], ps = 0.f;
#pragma unroll
        for (int i = 0; i < 16; ++i) { pr[i] = ok[i] ? exp2f(st[i] - mnew) : 0.f; ps += pr[i]; }
        l = l * alpha + ps; m = mnew;
#pragma unroll
        for (int i = 0; i < 16; ++i) { o[0][i] *= alpha; o[1][i] *= alpha; }
#pragma unroll
        for (int s2 = 0; s2 < 2; ++s2) { const bf16x8 bfrag = pack8(pr[8 * s2], pr[8 * s2 + 1], pr[8 * s2 + 2], pr[8 * s2 + 3], pr[8 * s2 + 4], pr[8 * s2 + 5], pr[8 * s2 + 6], pr[8 * s2 + 7]);
#pragma unroll
            for (int mt = 0; mt < 2; ++mt) { const LAS unsigned char* ap = Vl + (32 * mt + r) * ATT_VROW + (kk0 + 16 * s2 + 4 * hh) * 2;
                const s16x4 lo = *(const LAS s16x4*)ap, hi = *(const LAS s16x4*)(ap + 16);
                const bf16x8 a = __builtin_shufflevector(lo, hi, 0, 1, 2, 3, 4, 5, 6, 7);
                o[mt] = MFMA32(a, bfrag, o[mt]); } }
    }
    const float ltot = l + __shfl_xor(l, 32), inv = 1.f / ltot;
    gfp op = AOP + (size_t)p * MTOK * AWID + (size_t)tokq * AWID + h * 64;
#pragma unroll
    for (int mt = 0; mt < 2; ++mt)
#pragma unroll
        for (int g = 0; g < 4; ++g) { const f32x4 v = {o[mt][4 * g] * inv, o[mt][4 * g + 1] * inv, o[mt][4 * g + 2] * inv, o[mt][4 * g + 3] * inv};
            *(GAS f32x4*)(op + 32 * mt + 8 * g + 4 * hh) = v; }
    if (hh == 0) LSE[(size_t)p * MTOK * AH + tokq * AH + h] = (m + log2f(ltot)) * 0.6931471805599453f;
    __syncthreads();
}

__device__ __forceinline__ void attn_norm_token(int tok, gcf AOP, gcf LSE, gcf g, gbp Y, int lane) {
    float v[12], ss = 0.f;
#pragma unroll
    for (int i = 0; i < 12; ++i) { const float l0 = LSE[(size_t)tok * AH + i], l1 = LSE[(size_t)MTOK * AH + (size_t)tok * AH + i], l2 = LSE[2 * (size_t)MTOK * AH + (size_t)tok * AH + i];
        const float mx = fmaxf(fmaxf(l0, l1), l2), w0 = __expf(l0 - mx), w1 = __expf(l1 - mx), w2 = __expf(l2 - mx);
        const size_t o = (size_t)tok * AWID + lane + 64 * i;
        v[i] = (w0 * AOP[o] + w1 * AOP[(size_t)MTOK * AWID + o] + w2 * AOP[2 * (size_t)MTOK * AWID + o]) / (w0 + w1 + w2); ss += v[i] * v[i]; }
    const float rstd = rsqrtf(wave_sum(ss) * (1.f / AWID) + NORM_EPS);
#pragma unroll
    for (int i = 0; i < 12; ++i) Y[(size_t)tok * DM + RWID + lane + 64 * i] = (bf16)f2bf(v[i] * rstd * g[lane + 64 * i]);
}

constexpr int SGU_ROW = 272, SGU_UNITS = (MTOK / 128) * GGRP;
__device__ __forceinline__ void sgu_unit(int unit, gcb PROJ, gcf lng, gcf lnb, gcb W16  , gcf bs  , gbp Y, gfp SSQ, LAS unsigned char* lds, int tid, int wave, int lane) {
    const int g = unit & 7, bc = unit >> 3, b = bc / (SEQ / 128), c = bc % (SEQ / 128), tok0 = b * SEQ + c * 128;
    const int tl = lane & 15, g4 = lane >> 4, tok = tok0 + 16 * wave + tl, nks = (wave >> 1) + 1;
    bf16x8 bw[4];
#pragma unroll
    for (int ks = 0; ks < 4; ++ks) bw[ks] = *(const GAS bf16x8*)(W16 + (unsigned)((g * 128 + 16 * wave + tl) * 128 + 32 * (ks < nks ? ks : 0) + 8 * g4));
    const float bias = bs[g * 128 + 16 * wave + tl];
    f32x4 u4[4];
#pragma unroll
    for (int nt = 0; nt < 4; ++nt) u4[nt] = ld4bf(PROJ + (size_t)tok * INCOLS + GOFF + g * 64 + 16 * nt + 4 * g4);
#pragma unroll
    for (int it = 0; it < 2; ++it) { const int idx = tid + 512 * it, tj = idx >> 3, piece = idx & 7;
        const v4u vv = *(const GAS v4u*)(PROJ + (size_t)(tok0 + tj) * INCOLS + GOFF + GWID + g * 64 + piece * 8);
        float x[8] = {bflo(vv.x), bfhi(vv.x), bflo(vv.y), bfhi(vv.y), bflo(vv.z), bfhi(vv.z), bflo(vv.w), bfhi(vv.w)};
        float s1 = 0.f;
#pragma unroll
        for (int e = 0; e < 8; ++e) s1 += x[e];
        s1 += __shfl_xor(s1, 1); s1 += __shfl_xor(s1, 2); s1 += __shfl_xor(s1, 4);
        const float mu = s1 * (1.f / 64.f); float s2 = 0.f;
#pragma unroll
        for (int e = 0; e < 8; ++e) { x[e] -= mu; s2 += x[e] * x[e]; }
        s2 += __shfl_xor(s2, 1); s2 += __shfl_xor(s2, 2); s2 += __shfl_xor(s2, 4);
        const float rstd = rsqrtf(s2 * (1.f / 64.f) + GN_EPS);
        const f32x4 ga = *(const GAS f32x4*)(lng + g * 64 + piece * 8), gb = *(const GAS f32x4*)(lng + g * 64 + piece * 8 + 4), ba = *(const GAS f32x4*)(lnb + g * 64 + piece * 8), bb = *(const GAS f32x4*)(lnb + g * 64 + piece * 8 + 4);
        LAS unsigned short* vd = (LAS unsigned short*)(lds + (piece * 8) * SGU_ROW + tj * 2);
#pragma unroll
        for (int e = 0; e < 8; ++e) vd[e * (SGU_ROW / 2)] = (unsigned short)f2bf(x[e] * rstd * (e < 4 ? ga[e & 3] : gb[e & 3]) + (e < 4 ? ba[e & 3] : bb[e & 3])); }
    __syncthreads();
    f32x4 acc[4];
#pragma unroll
    for (int nt = 0; nt < 4; ++nt) acc[nt] = (f32x4){0.f, 0.f, 0.f, 0.f};
#pragma unroll
    for (int ks = 0; ks < 4; ++ks) if (ks < nks) {
#pragma unroll
        for (int nt = 0; nt < 4; ++nt) acc[nt] = MFMA16(*(const LAS bf16x8*)(lds + (16 * nt + tl) * SGU_ROW + (32 * ks + 8 * g4) * 2), bw[ks], acc[nt]); }
    float ss = 0.f;
#pragma unroll
    for (int nt = 0; nt < 4; ++nt) { const f32x4 qv = u4[nt] * (acc[nt] + bias);
        ss += qv[0] * qv[0] + qv[1] * qv[1] + qv[2] * qv[2] + qv[3] * qv[3];
        *(GAS unsigned long long*)(Y + (unsigned)(tok * DM + RWID + AWID + g * 64 + 16 * nt + 4 * g4)) = (unsigned long long)pk2(qv[0], qv[1]) | ((unsigned long long)pk2(qv[2], qv[3]) << 32); }
    ss += __shfl_xor(ss, 16); ss += __shfl_xor(ss, 32);
    if (g4 == 0) SSQ[tok * 8 + g] = ss;
    __syncthreads();
}
__device__ __forceinline__ void sgu_norm_token(int tok, gcf SSQ, gcf ng, gbp Y, int lane) {
    const f32x4 s0 = *(const GAS f32x4*)(SSQ + tok * 8), s1 = *(const GAS f32x4*)(SSQ + tok * 8 + 4);
    const float rstd = rsqrtf((s0[0] + s0[1] + s0[2] + s0[3] + s1[0] + s1[1] + s1[2] + s1[3]) * (1.f / GWID) + NORM_EPS);
    GAS v4u* yp = (GAS v4u*)(Y + (size_t)tok * DM + RWID + AWID + 8 * lane);
    const v4u y = *yp; const f32x4 g0 = *(const GAS f32x4*)(ng + 8 * lane), g1 = *(const GAS f32x4*)(ng + 8 * lane + 4);
    v4u o; o.x = pk2(bflo(y.x) * rstd * g0[0], bfhi(y.x) * rstd * g0[1]); o.y = pk2(bflo(y.y) * rstd * g0[2], bfhi(y.y) * rstd * g0[3]);
    o.z = pk2(bflo(y.z) * rstd * g1[0], bfhi(y.z) * rstd * g1[1]); o.w = pk2(bflo(y.w) * rstd * g1[2], bfhi(y.w) * rstd * g1[3]);
    *yp = o;
}

__device__ __forceinline__ void conv_fix_item(int item, gcf HALO, gcf RAW01, gcf cw, gcf cb, gbp H) {
    const int j = item % DFF, rr = (item / DFF) & 1, pm = item / (2 * DFF);
    if (pm % (SEQ / 256) == 0) return;
    const int tc = 256 * (j / 128) + (j % 128);
    gcf r0 = RAW01 + (size_t)(pm * 2) * UPN, r1 = r0 + UPN, h0 = HALO + (size_t)((pm - 1) * 2) * UPN, h1 = h0 + UPN;
    float g0, g1, g2, v0, v1, v2;
    if (rr == 0) { g2 = r0[tc]; g1 = h1[tc]; g0 = h0[tc]; v2 = r0[tc + 128]; v1 = h1[tc + 128]; v0 = h0[tc + 128]; }
    else { g2 = r1[tc]; g1 = r0[tc]; g0 = h1[tc]; v2 = r1[tc + 128]; v1 = r0[tc + 128]; v0 = h1[tc + 128]; }
    const float cg = cb[j] + cw[j] * g0 + cw[UPN + j] * g1 + cw[2 * UPN + j] * g2;
    const float cv = cb[DFF + j] + cw[DFF + j] * v0 + cw[UPN + DFF + j] * v1 + cw[2 * UPN + DFF + j] * v2;
    H[(size_t)(pm * 256 + rr) * DFF + j] = (bf16)f2bf(pg8::gelu_tanh_fast(cg) * cv);
}

typedef const __attribute__((address_space(4))) unsigned long long* kargs_t;
__device__ __forceinline__ kargs_t kargs() { kargs_t ka = (kargs_t)__builtin_amdgcn_kernarg_segment_ptr(); asm volatile("" : "+s"(ka)); return ka; }
#define KIN(i) ((gcf)ka[i])
#define KOUT ((gfp)ka[29])
#define KWS ((GAS unsigned char*)ka[30])
constexpr size_t AS_ = (size_t)MTOK * RWID;
__device__ __forceinline__ int lane_id() { int l; asm volatile("v_mbcnt_lo_u32_b32 %0, -1, 0\n\tv_mbcnt_hi_u32_b32 %0, -1, %0" : "=v"(l)); return l; }
#define PH_IDS const int lane = lane_id(); const int tid = wave * 64 + lane; (void)tid
#define GBAR() do { const int lane_b = lane_id(); kargs_t kb = kargs(); XcdBarrier bb; bb.bar = (unsigned*)((GAS unsigned*)((GAS unsigned char*)kb[30] + WS_CTL) + CW_BAR); bb.x = xb_xcc_id(); \
    bb.st = (volatile LAS unsigned*)(lds + MISC_OFF) + 8; xcd_barrier(bb, wave * 64 + lane_b); } while (0)

__global__ void __launch_bounds__(NTHR, 2) mega_fwd(Params p) {
    extern __shared__ __attribute__((aligned(16))) unsigned char lds_raw[];
    LAS unsigned char* lds = (LAS unsigned char*)lds_raw;
    const int wave = __builtin_amdgcn_readfirstlane((int)threadIdx.x >> 6);
    const int G = gridDim.x, gw = blockIdx.x * NWAVES + wave, ngw = G * NWAVES;
    { PH_IDS; kargs_t ka = kargs();
      for (int u = tid; u < (LDS_BYTES - LDSCTL_OFF) / 4; u += NTHR) ((LAS unsigned*)(lds + LDSCTL_OFF))[u] = 0u;
      __syncthreads();
      (void)xcd_barrier_post((unsigned*)((GAS unsigned*)(KWS + WS_CTL) + CW_BAR), (volatile LAS unsigned*)(lds + MISC_OFF) + 8, tid); }

    {
        PH_IDS; kargs_t ka = kargs(); GAS unsigned char* ws = KWS;
        LAS float* scr = (LAS float* )(lds + wave * 16384);
        for (int l = 0; l < DEPTH; ++l) {
            for (int it = gw; it < (DM / 64) * (INCOLS / 32); it += ngw) p0_transpose_item(KIN(6) + (size_t)l * DM * INCOLS, DM, INCOLS, (gbp)(ws + WS_WIN) + (size_t)l * INCOLS * DM, 0, scr, it, lane);
            for (int it = gw; it < (DM / 64) * (DM / 32); it += ngw) p0_transpose_item(KIN(24) + (size_t)l * DM * DM, DM, DM, (gbp)(ws + WS_WOUT) + (size_t)l * DM * DM, 0, scr, it, lane);
            for (int it = gw; it < (DM / 64) * (UPN / 32); it += ngw) p0_transpose_item(KIN(25) + (size_t)l * DM * UPN, DM, UPN, (gbp)(ws + WS_WUP) + (size_t)l * UPN * DM, -1, scr, it, lane);
            for (int it = gw; it < (DFF / 64) * (DM / 32); it += ngw) p0_transpose_item(KIN(28) + (size_t)l * DFF * DM, DFF, DM, (gbp)(ws + WS_WDN) + (size_t)l * DM * DFF, 0, scr, it, lane);
        }
        {
            gfp RT = (gfp)(ws + WS_ROPE); gci pos = (gci)KIN(1);
            for (int i = blockIdx.x * NTHR + tid; i < MTOK * 8; i += G * NTHR) { const int tok = i >> 3, f = i & 7; const float inv = exp2f(-(float)f * (18.931568569324174f / 8.f)); const float ang = (float)pos[tok] * inv;
                RT[tok * 16 + f] = cosf(ang); RT[tok * 16 + 8 + f] = sinf(ang); } }
        {
            gbp SW = (gbp)(ws + WS_SGW);
            for (int i = blockIdx.x * NTHR + tid; i < DEPTH * 8 * 128 * 128; i += G * NTHR) { const int jj = i & 127, ii = (i >> 7) & 127; SW[i] = (bf16)f2bf(jj <= ii ? KIN(21)[i] : 0.f); } }
        {
            gbp LW = (gbp)(ws + WS_LORA);
            for (int i = blockIdx.x * NTHR + tid; i < DEPTH * LORA_L; i += G * NTHR) { const int l = i / LORA_L, rr = i % LORA_L;
                float v; if (rr < RWID * 64) { const int n = rr / 64, k = rr % 64; v = KIN(9)[(size_t)l * 64 * RWID + k * RWID + n]; }
                else if (rr < RWID * 128) { const int q = rr - RWID * 64, n = q / 64, k = q % 64; v = KIN(11)[(size_t)l * 64 * RWID + k * RWID + n]; }
                else { const int q = rr - RWID * 128, n = q / 128, k = q % 128; v = KIN(12)[(size_t)l * 128 * RWID + k * RWID + n]; }
                LW[i] = (bf16)f2bf(v); } }
        rowpass(KIN(0), nullptr, nullptr, nullptr, KIN(2), (gbp)(ws + WS_HN), gw, ngw, lane);
    }
    GBAR();

    for (int l = 0; l < DEPTH; ++l) {
        { PH_IDS; kargs_t ka = kargs(); GAS unsigned char* ws = KWS;
          pg8::Gemm g{(gbp)(ws + WS_HN), (gbp)(ws + WS_WIN) + (size_t)l * INCOLS * DM, MTOK, INCOLS, DM}; pg8::StaticOrder S; S.init(MTOK, INCOLS, G, (int)blockIdx.x);
          pg8::EpiProj E{(gbp)(ws + WS_PROJ), INCOLS, (gcf)(ws + WS_ROPE), QOFF / 256, KOFF / 256, VOFF / 256, GOFF / 256};
          pg8::gemm_phase<pg8::EpiProj, pg8::StaticOrder, true, true>(lds, g, S, E, tid); }
        GBAR();
        { PH_IDS; kargs_t ka = kargs(); GAS unsigned char* ws = KWS;
          gcb LW = (gcb)(ws + WS_LORA) + (size_t)l * LORA_L;
          RPW rw{KIN(7) + (size_t)l * RCOLS, KIN(8) + (size_t)l * RWID, KIN(10) + (size_t)l * RWID, KIN(13) + (size_t)l * RWID, KIN(14) + (size_t)l * RWID, KIN(15) + (size_t)l * RWID, LW, LW + RWID * 64, LW + RWID * 128};
          for (int u = blockIdx.x; u < MTOK / 32; u += G) rwkv_prep_unit(u, (gcb)(ws + WS_PROJ), rw, (gfp)(ws + WS_RW), (gfp)(ws + WS_BON), lds, tid, wave, lane);
        }
        GBAR();
        { PH_IDS; kargs_t ka = kargs(); GAS unsigned char* ws = KWS;
          LAS float* ops = (LAS float*)(lds + wave * 4096);
          gfp RWb = (gfp)(ws + WS_RW); gfp PT = (gfp)(ws + WS_CHK);
          for (int task = blockIdx.x + G * wave; task < NTASK_SCAN; task += G * NWAVES) scan_chunk(task, RWb, RWb + 7 * AS_, RWb + 8 * AS_, (gbp)PT, (gbp)(PT + (size_t)NTASK_SCAN * 4096), ops, lane); }
        GBAR();
        if (blockIdx.x < BATCH * RH) { PH_IDS; kargs_t ka = kargs(); GAS unsigned char* ws = KWS; gfp PT = (gfp)(ws + WS_CHK);
              scan_carry_ring((int)blockIdx.x, (gcb)PT, (gcb)(PT + (size_t)NTASK_SCAN * 4096), PT + 2 * (size_t)NTASK_SCAN * 4096, lds, wave, lane); }
        { PH_IDS; kargs_t ka = kargs(); GAS unsigned char* ws = KWS;
          volatile LAS unsigned* MISC = (volatile LAS unsigned*)(lds + MISC_OFF);
          gu32* ctr = (gu32*)(ws + WS_CTL) + CW_ATT + 64 * l;
          for (;;) {
              if (tid == 0) MISC[16] = __hip_atomic_fetch_add(ctr, 1u, __ATOMIC_RELAXED, __HIP_MEMORY_SCOPE_AGENT);
              __syncthreads();
              const int u = (int)MISC[16];
              if (u >= ATT_UNITS + SGU_UNITS) break;
              if (u < ATT_UNITS) attn_unit(u, (gcb)(ws + WS_PROJ), (gfp)(ws + WS_AO), (gfp)(ws + WS_LSE), lds, tid, wave, lane);
              else sgu_unit(u - ATT_UNITS, (gcb)(ws + WS_PROJ), KIN(19) + (size_t)l * GWID, KIN(20) + (size_t)l * GWID, (gcb)(ws + WS_SGW) + (size_t)l * 8 * 128 * 128, KIN(22) + (size_t)l * 8 * 128, (gbp)(ws + WS_Y), (gfp)(ws + WS_SSQ), lds, tid, wave, lane);
          }
        }
        GBAR();
        { PH_IDS; kargs_t ka = kargs(); GAS unsigned char* ws = KWS;
          gfp RWb = (gfp)(ws + WS_RW); gfp PT = (gfp)(ws + WS_CHK);
          for (int wt = gw; wt < 2 * NTASK_SCAN; wt += ngw) scan_out_mfma(wt, RWb, RWb + 7 * AS_, RWb + 8 * AS_, PT + 2 * (size_t)NTASK_SCAN * 4096, (gfp)(ws + WS_BON), KIN(16) + (size_t)l * RWID, KIN(17) + (size_t)l * RWID, (gbp)(ws + WS_Y), lane);
          for (int tok = gw; tok < MTOK; tok += ngw) { attn_norm_token(tok, (gcf)(ws + WS_AO), (gcf)(ws + WS_LSE), KIN(18) + (size_t)l * AWID, (gbp)(ws + WS_Y), lane);
              sgu_norm_token(tok, (gcf)(ws + WS_SSQ), KIN(23) + (size_t)l * GWID, (gbp)(ws + WS_Y), lane); } }
        GBAR();
        { PH_IDS; kargs_t ka = kargs(); GAS unsigned char* ws = KWS;
          pg8::Gemm g{(gbp)(ws + WS_Y), (gbp)(ws + WS_WOUT) + (size_t)l * DM * DM, MTOK, DM, DM}; pg8::StaticOrder S; S.init(MTOK, DM, G, (int)blockIdx.x);
          pg8::EpiF32 E{(gfp)(ws + WS_O), DM};
          pg8::gemm_phase<pg8::EpiF32, pg8::StaticOrder, true, true>(lds, g, S, E, tid); }
        GBAR();
        { PH_IDS; kargs_t ka = kargs(); GAS unsigned char* ws = KWS;
          rowpass(l == 0 ? KIN(0) : (gcf)KOUT, (gfp)(ws + WS_O), KIN(3) + (size_t)l * DM, KOUT, KIN(4) + (size_t)l * DM, (gbp)(ws + WS_HN), gw, ngw, lane); }
        GBAR();
        { PH_IDS; kargs_t ka = kargs(); GAS unsigned char* ws = KWS;
          pg8::Gemm g{(gbp)(ws + WS_HN), (gbp)(ws + WS_WUP) + (size_t)l * UPN * DM, MTOK, UPN, DM}; pg8::StaticOrder S; S.init(MTOK, UPN, G, (int)blockIdx.x);
          pg8::EpiConvGlu E{(gbp)(ws + WS_H), DFF, KIN(26) + (size_t)l * 3 * UPN, KIN(27) + (size_t)l * UPN, UPN, DFF, (gfp)(ws + WS_HALO), (gfp)(ws + WS_RAW01), (LAS float*)(lds + RING_BYTES + 4096), SEQ / 256};
          pg8::gemm_phase<pg8::EpiConvGlu, pg8::StaticOrder, true, true>(lds, g, S, E, tid); }
        GBAR();
        { PH_IDS; kargs_t ka = kargs(); GAS unsigned char* ws = KWS;
          for (int it = blockIdx.x * NTHR + tid; it < (MTOK / 256) * 2 * DFF; it += G * NTHR) conv_fix_item(it, (gcf)(ws + WS_HALO), (gcf)(ws + WS_RAW01), KIN(26) + (size_t)l * 3 * UPN, KIN(27) + (size_t)l * UPN, (gbp)(ws + WS_H)); }
        GBAR();
        { PH_IDS; kargs_t ka = kargs(); GAS unsigned char* ws = KWS;
          pg8::Gemm g{(gbp)(ws + WS_H), (gbp)(ws + WS_WDN) + (size_t)l * DM * DFF, MTOK, DM, DFF}; pg8::StaticOrder S; S.init(MTOK, DM, G, (int)blockIdx.x);
          pg8::EpiF32 E{(gfp)(ws + WS_O), DM};
          pg8::gemm_phase<pg8::EpiF32, pg8::StaticOrder, true, true>(lds, g, S, E, tid); }
        GBAR();
        { PH_IDS; kargs_t ka = kargs(); GAS unsigned char* ws = KWS;
          rowpass(KOUT, (gfp)(ws + WS_O), KIN(5) + (size_t)l * DM, KOUT, l + 1 < DEPTH ? KIN(2) + (size_t)(l + 1) * DM : nullptr, (gbp)(ws + WS_HN), gw, ngw, lane); }
        if (l + 1 < DEPTH) GBAR();
    }
}

extern "C" void kernel_launch(void* const* d_in, const int* in_sizes, int n_in, void* d_out, int out_size, void* d_ws, size_t ws_size, hipStream_t stream) {
    static int grid = 0;
    if (grid == 0) {
        if (n_in != 29 || out_size != MTOK * DM || ws_size < WS_END) { fprintf(stderr, "kernel_launch: unexpected shapes (n_in %d out %d ws %zu need %zu)\n", n_in, out_size, ws_size, (size_t)WS_END); grid = -1; return; }
        int dev = 0, cus = 0, per_cu = 0;
        if (hipGetDevice(&dev) != hipSuccess || hipDeviceGetAttribute(&cus, hipDeviceAttributeMultiprocessorCount, dev) != hipSuccess) { grid = -1; return; }
        if (hipFuncSetAttribute((const void*)mega_fwd, hipFuncAttributeMaxDynamicSharedMemorySize, LDS_BYTES) != hipSuccess) { fprintf(stderr, "kernel_launch: hipFuncSetAttribute failed\n"); grid = -1; return; }
        if (hipOccupancyMaxActiveBlocksPerMultiprocessor(&per_cu, (const void*)mega_fwd, NTHR, LDS_BYTES) != hipSuccess || per_cu < 1) fprintf(stderr, "kernel_launch: occupancy query says %d\n", per_cu);
        (void)hipGetLastError();
        grid = cus;
    }
    if (grid < 0) return;
    if (hipMemsetAsync((char*)d_ws + WS_CTL, 0, CTL_ZERO_BYTES, stream) != hipSuccess) return;
    Params prm{};
    for (int i = 0; i < 29; ++i) prm.in[i] = (const float*)d_in[i];
    prm.out = (float*)d_out; prm.ws = (unsigned char*)d_ws;
    hipLaunchKernelGGL(mega_fwd, dim3(grid), dim3(NTHR), LDS_BYTES, stream, prm);
}
```
